# Optimizing an MI355X kernel written in HIP

```python
import math
import jax, jax.numpy as jnp
from jax import lax
import numpy as np

D_MODEL = 1024
BATCH = 16
SEQ = 256
DEPTH = 2
DEC_BATCH = 8
DEC_SEQ = 1024
PAST_LEN = 512

GRID_W = 64
HG_WIDTH = D_MODEL // 2
HG_DK = 128
HG_HEADS = HG_WIDTH // HG_DK
HG_DV = HG_WIDTH // HG_HEADS
HY_WIDTH = D_MODEL - HG_WIDTH
N_IN = 5 * HG_WIDTH + 3 * HY_WIDTH
CHUNK = 64
CONV_W = 3
D_FF = 2816
HY_BANDS = 16
HY_EMB = 1 + 2 * HY_BANDS
HY_ORDER = 64
HY_TARGET = 1e-2
HY_FAST = 0.3
HY_SLOW = 1.5
EPS = 1e-6

kernel_name = "hybrid_hgrn2_hyena_diffusion_step"

F32 = jnp.float32


def _rmsnorm(x, w):
    xf = x.astype(F32)
    y = xf * lax.rsqrt(jnp.mean(xf * xf, axis=-1, keepdims=True) + EPS)
    return (y * w.astype(F32)).astype(x.dtype)


def _dwconv3(x, w, rows):
    B, L, C = x.shape
    xr = x.reshape(B, rows, L // rows, C)
    xp = jnp.pad(xr, ((0, 0), (0, 0), (1, 1), (0, 0)))
    y = w[0] * xp[:, :, :-2] + w[1] * xp[:, :, 1:-1] + w[2] * xp[:, :, 2:]
    return y.reshape(B, L, C)


def _lower_bounds(p):
    s = jax.nn.softmax(p.astype(F32), axis=0)
    cs = jnp.cumsum(s, axis=0)
    return cs - cs[0:1]


def _log_forget(x, lb):
    return jnp.logaddexp(jnp.log(lb), jnp.log1p(-lb) + jax.nn.log_sigmoid(x.astype(F32)))


def _chunk_scan(q, k, v, log_f, s0):
    B, L, H, DK = q.shape
    DV = v.shape[-1]
    nc = L // CHUNK

    def to_chunks(a):
        return a.reshape(B, nc, CHUNK, H, a.shape[-1]).transpose(1, 0, 3, 2, 4)

    qc, kc, vc, gc = to_chunks(q), to_chunks(k), to_chunks(v), to_chunks(log_f)
    mask = jnp.tril(jnp.ones((CHUNK, CHUNK), dtype=bool))[None, None, :, :, None]

    def step(S, inp):
        qi, ki, vi, gi = inp
        b = jnp.cumsum(gi, axis=2)
        diff = b[:, :, :, None, :] - b[:, :, None, :, :]
        decay = jnp.exp(jnp.where(mask, diff, -jnp.inf))
        scores = jnp.einsum('bhjd,bhid,bhjid->bhji', qi, ki, decay)
        o = jnp.einsum('bhji,bhiv->bhjv', scores, vi) + jnp.einsum('bhjd,bhdv->bhjv', qi * jnp.exp(b), S)
        b_last = b[:, :, -1:, :]
        S_new = jnp.exp(b_last[:, :, 0, :, None]) * S + jnp.einsum('bhid,bhiv->bhdv', ki * jnp.exp(b_last - b), vi)
        return S_new, o

    s_fin, oc = lax.scan(step, s0.astype(F32), (qc, kc, vc, gc))
    o = oc.transpose(1, 0, 3, 2, 4).reshape(B, L, H, DV)
    return o, s_fin


def _hyena_filter(L, w1, b1, fr1, w2, b2, fr2, w3):
    t = jnp.linspace(0.0, 1.0, L, dtype=F32)[:, None]
    pos = jnp.arange(L, dtype=F32)[:, None]
    bands = jnp.linspace(1e-4, HY_BANDS - 1, HY_BANDS, dtype=F32)[None, :]
    ang = 2.0 * math.pi * pos * bands / L
    feats = jnp.concatenate([t, jnp.cos(ang), jnp.sin(ang)], axis=-1)
    h = jnp.sin(fr1.astype(F32) * (feats @ w1.astype(F32) + b1.astype(F32)))
    h = jnp.sin(fr2.astype(F32) * (h @ w2.astype(F32) + b2.astype(F32)))
    h = h @ w3.astype(F32)
    min_decay = math.log(HY_TARGET) / HY_SLOW
    max_decay = math.log(HY_TARGET) / HY_FAST
    deltas = jnp.abs(jnp.linspace(min_decay, max_decay, HY_WIDTH, dtype=F32))
    deltas = jnp.concatenate([deltas, deltas])
    h = h * jnp.exp(-t * deltas[None, :])
    h_f, h_b = h[:, :HY_WIDTH], h[:, HY_WIDTH:]
    kern = jnp.concatenate([h_f, jnp.zeros((1, HY_WIDTH), F32), h_b[1:][::-1]], axis=0)
    return kern / (jnp.sum(jnp.abs(kern), axis=0, keepdims=True) + EPS)


def _long_conv(u, kern):
    L = u.shape[1]
    uf = jnp.fft.rfft(u.astype(F32), n=2 * L, axis=1)
    kf = jnp.fft.rfft(kern, n=2 * L, axis=0)
    return jnp.fft.irfft(uf * kf[None], n=2 * L, axis=1)[:, :L]


def _mixer(h, rows, s0, l, p):
    B, L, _ = h.shape
    proj = jnp.einsum('bld,de->ble', h, p['w_in'][l])
    cuts = [HG_WIDTH * i for i in range(1, 6)]
    q, ff, fb, iv, g, hy = jnp.split(proj, cuts, axis=-1)

    def heads(a):
        return a.reshape(B, L, HG_HEADS, -1)

    qh = heads(jax.nn.silu(q.astype(F32)) * (HG_DK ** -0.5))
    vh = heads(iv.astype(F32))
    logf_f = heads(_log_forget(ff, _lower_bounds(p['hg_lb_fwd'])[l]))
    logf_b = heads(_log_forget(fb, _lower_bounds(p['hg_lb_bwd'])[l]))
    k_f = -jnp.expm1(logf_f)
    k_b = -jnp.expm1(logf_b)
    o_f, s_f = _chunk_scan(qh, k_f, vh, logf_f, s0[:, 0])
    rev = lambda a: a[:, ::-1]
    o_b, s_b = _chunk_scan(rev(qh), rev(k_b), rev(vh), rev(logf_b), s0[:, 1])
    o = o_f + rev(o_b)
    o = o * lax.rsqrt(jnp.mean(o * o, axis=-1, keepdims=True) + EPS)
    o = o * p['hg_norm_w'][l].astype(F32).reshape(HG_HEADS, HG_DV)
    o_hg = o.reshape(B, L, HG_WIDTH) * jax.nn.silu(g.astype(F32))

    hyc = _dwconv3(hy, p['hy_conv_w'][l], rows).astype(F32)
    v, x1, x2 = jnp.split(hyc, [HY_WIDTH, 2 * HY_WIDTH], axis=-1)
    kern = _hyena_filter(L, p['hy_w1'][l], p['hy_b1'][l], p['hy_freq1'][l],
                         p['hy_w2'][l], p['hy_b2'][l], p['hy_freq2'][l], p['hy_w3'][l])
    u = x1 * v
    z = _long_conv(u, kern) + p['hy_d'][l].astype(F32) * u
    y_hy = x2 * z
    y_hy = y_hy * lax.rsqrt(jnp.mean(y_hy * y_hy, axis=-1, keepdims=True) + EPS) * p['hy_norm_w'][l].astype(F32)

    merged = jnp.concatenate([o_hg, y_hy], axis=-1).astype(h.dtype)
    out = jnp.einsum('ble,ed->bld', merged, p['w_out'][l])
    return out, jnp.stack([s_f, s_b], axis=1)


def _convffn(h, rows, l, p):
    up = jnp.einsum('bld,df->blf', h, p['ffn_w_up'][l])
    up = _dwconv3(up, p['ffn_conv_w'][l], rows)
    gate, val = jnp.split(up, 2, axis=-1)
    return jnp.einsum('blf,fd->bld', jax.nn.silu(gate) * val, p['ffn_w_down'][l])


def _layer(x, cvec, rows, s0, l, p):
    mod = jnp.einsum('bd,de->be', jax.nn.silu(cvec), p['ada_w'][l]) + p['ada_b'][l]
    sh1, sc1, g1, sh2, sc2, g2 = [m[:, None, :] for m in jnp.split(mod, 6, axis=-1)]
    h = _rmsnorm(x, p['norm1_w'][l]) * (1 + sc1) + sh1
    mix, s_fin = _mixer(h, rows, s0, l, p)
    x = x + g1 * mix
    h = _rmsnorm(x, p['norm2_w'][l]) * (1 + sc2) + sh2
    x = x + g2 * _convffn(h, rows, l, p)
    return x.astype(cvec.dtype), s_fin


def setup_inputs(seed: int = 0) -> dict:
    key = jax.random.key(seed)
    ks = jax.random.split(key, 32)
    n = lambda k, s, sc: jax.random.normal(k, s, F32) * sc
    D = D_MODEL
    return {
        "x_prompt": n(ks[0], (BATCH, SEQ, D), 1.0),
        "x_sample": n(ks[1], (DEC_BATCH, DEC_SEQ, D), 1.0),
        "state_hgrn": n(ks[2], (DEC_BATCH, DEPTH, 2, HG_HEADS, HG_DK, HG_DV), 0.5),
        "c": n(ks[3], (DEC_BATCH, D), 1.0),
        "c_ctx": n(ks[4], (D,), 1.0),
        "w_in": n(ks[5], (DEPTH, D, N_IN), D ** -0.5),
        "w_out": n(ks[6], (DEPTH, D, D), D ** -0.5),
        "ada_w": n(ks[7], (DEPTH, D, 6 * D), 0.5 * D ** -0.5),
        "ada_b": n(ks[8], (DEPTH, 6 * D), 0.02),
        "norm1_w": 1.0 + n(ks[9], (DEPTH, D), 0.05),
        "norm2_w": 1.0 + n(ks[10], (DEPTH, D), 0.05),
        "hg_lb_fwd": n(ks[11], (DEPTH, HG_WIDTH), 1.0),
        "hg_lb_bwd": n(ks[12], (DEPTH, HG_WIDTH), 1.0),
        "hg_norm_w": 1.0 + n(ks[13], (DEPTH, HG_WIDTH), 0.05),
        "hy_conv_w": n(ks[14], (DEPTH, CONV_W, 3 * HY_WIDTH), 0.6),
        "hy_w1": n(ks[15], (DEPTH, HY_EMB, HY_ORDER), HY_EMB ** -0.5),
        "hy_b1": n(ks[16], (DEPTH, HY_ORDER), 0.1),
        "hy_freq1": 1.0 + n(ks[17], (DEPTH, HY_ORDER), 0.05),
        "hy_w2": n(ks[18], (DEPTH, HY_ORDER, HY_ORDER), HY_ORDER ** -0.5),
        "hy_b2": n(ks[19], (DEPTH, HY_ORDER), 0.1),
        "hy_freq2": 1.0 + n(ks[20], (DEPTH, HY_ORDER), 0.05),
        "hy_w3": n(ks[21], (DEPTH, HY_ORDER, 2 * HY_WIDTH), HY_ORDER ** -0.5),
        "hy_d": n(ks[22], (DEPTH, HY_WIDTH), 1.0),
        "hy_norm_w": 1.0 + n(ks[23], (DEPTH, HY_WIDTH), 0.05),
        "ffn_w_up": n(ks[24], (DEPTH, D, 2 * D_FF), D ** -0.5),
        "ffn_conv_w": n(ks[25], (DEPTH, CONV_W, 2 * D_FF), 0.6),
        "ffn_w_down": n(ks[26], (DEPTH, D_FF, D), D_FF ** -0.5),
        "final_norm_w": 1.0 + n(ks[27], (D,), 0.05),
    }


def reference(x_prompt, x_sample, state_hgrn, c, c_ctx, w_in, w_out, ada_w, ada_b,
              norm1_w, norm2_w, hg_lb_fwd, hg_lb_bwd, hg_norm_w, hy_conv_w,
              hy_w1, hy_b1, hy_freq1, hy_w2, hy_b2, hy_freq2, hy_w3, hy_d, hy_norm_w,
              ffn_w_up, ffn_conv_w, ffn_w_down, final_norm_w):
    p = dict(w_in=w_in, w_out=w_out, ada_w=ada_w, ada_b=ada_b, norm1_w=norm1_w,
             norm2_w=norm2_w, hg_lb_fwd=hg_lb_fwd, hg_lb_bwd=hg_lb_bwd, hg_norm_w=hg_norm_w,
             hy_conv_w=hy_conv_w, hy_w1=hy_w1, hy_b1=hy_b1, hy_freq1=hy_freq1, hy_w2=hy_w2,
             hy_b2=hy_b2, hy_freq2=hy_freq2, hy_w3=hy_w3, hy_d=hy_d, hy_norm_w=hy_norm_w,
             ffn_w_up=ffn_w_up, ffn_conv_w=ffn_conv_w, ffn_w_down=ffn_w_down)

    bp = x_prompt.shape[0]
    zero_state = jnp.zeros((bp, 2, HG_HEADS, HG_DK, HG_DV), F32)
    cvec_ctx = jnp.broadcast_to(c_ctx[None, :], (bp, c_ctx.shape[0])).astype(x_prompt.dtype)
    xp = x_prompt
    ctx_states = []
    for l in range(DEPTH):
        xp, st = _layer(xp, cvec_ctx, 1, zero_state, l, p)
        ctx_states.append(st)
    y_prompt = _rmsnorm(xp, final_norm_w)
    new_state_hgrn = jnp.stack(ctx_states, axis=1)

    rows = x_sample.shape[1] // GRID_W
    xs = x_sample
    for l in range(DEPTH):
        xs, _ = _layer(xs, c.astype(x_sample.dtype), rows, state_hgrn[:, l], l, p)
    y_sample = _rmsnorm(xs, final_norm_w)
    return (y_prompt, y_sample, new_state_hgrn)
```

```cpp
#include <hip/hip_runtime.h>
#include <cstdio>
#include <cstdint>

#define DI __device__ __forceinline__
#define LAS __attribute__((address_space(3)))
#define GAS __attribute__((address_space(1)))
typedef unsigned short bf16_t;
typedef short bf16x8 __attribute__((ext_vector_type(8)));
typedef float f32x4 __attribute__((ext_vector_type(4)));
typedef float f32x16 __attribute__((ext_vector_type(16)));
typedef unsigned u32x4 __attribute__((ext_vector_type(4)));
typedef unsigned u32x2 __attribute__((ext_vector_type(2)));
typedef float f32x2_t __attribute__((ext_vector_type(2)));
typedef __bf16 bf16x2_t __attribute__((ext_vector_type(2)));
typedef LAS unsigned char lds_t;

#ifndef MK_N_LAUNCHES
#define MK_N_LAUNCHES 1
#endif

constexpr int DM = 1024, TP = 4096, TS = 8192, TT = 12288, NIN = 4096, DFF = 2816, NUP = 5632, NMOD = 6144;
constexpr int NPH = 17;
constexpr float EPS = 1e-6f;

constexpr size_t MiB = 1u << 20;
constexpr size_t WS_CTL = 0, CTL_BYTES = 1 * MiB;
constexpr size_t WS_LBT = 1 * MiB;
constexpr size_t WS_BIAS = 1 * MiB + 64 * 1024;
constexpr size_t BIAS2_OFF = 2 * 9 * 4096 * 4;
constexpr size_t WS_RSP = 2 * MiB;
constexpr size_t WS_GF = 3 * MiB;
constexpr size_t GF_LSTRIDE = 2560 * 1024, GF_SAMPLE_OFF = 512 * 1024;
constexpr size_t WS_WIN = 10 * MiB, WS_WOUT = 26 * MiB, WS_WUP = 30 * MiB, WS_WDN = 52 * MiB;
constexpr size_t WS_H = 64 * MiB;
constexpr size_t WS_MERGED = 88 * MiB;
constexpr size_t WS_P = 112 * MiB;
constexpr size_t WS_UT = 208 * MiB, WS_X2T = 220 * MiB;
constexpr size_t WS_END = 232 * MiB;
constexpr int CW_BAR = 4096;
constexpr int CW_QUEUE = 8192;
constexpr int CW_HYABS = 9216;
constexpr int CW_MOD = 16384;
static_assert((CW_MOD + 2 * 9 * NMOD) * 4 <= (int)CTL_BYTES, "ctl");

constexpr int LDS_BYTES = 163840;
constexpr int RING_BYTES = 131072;
constexpr int XCH_OFF = 131072;
constexpr int MISC_OFF = 163840 - 256;

DI unsigned pkbf(float lo, float hi) { f32x2_t v = {lo, hi}; bf16x2_t b = __builtin_convertvector(v, bf16x2_t); return __builtin_bit_cast(unsigned, b); }
DI float bflo(unsigned u) { return __uint_as_float(u << 16); }
DI float bfhi(unsigned u) { return __uint_as_float(u & 0xffff0000u); }
DI float bf1(bf16_t h) { return __uint_as_float(((unsigned)h) << 16); }
DI float silu_f(float x) { return x * __builtin_amdgcn_rcpf(1.0f + __expf(-x)); }
DI float wave_sum(float v) {
#pragma unroll
    for (int o = 1; o < 64; o <<= 1) v += __shfl_xor(v, o);
    return v;
}
DI int ltid() { int t = threadIdx.x; asm volatile("" : "+v"(t)); return t; }
DI int crow(int reg, int hh) { return (reg & 3) + 8 * (reg >> 2) + 4 * hh; }
DI int cid_of_tile(int pm) { return pm < 16 ? 0 : 1 + ((pm - 16) >> 2); }
DI int cid_of_row(int m) { return m < TP ? 0 : 1 + ((m - TP) >> 10); }
#define MFMA32(a, b, c) __builtin_amdgcn_mfma_f32_32x32x16_bf16((a), (b), (c), 0, 0, 0)
#define LDS_WAIT() asm volatile("s_waitcnt lgkmcnt(0)" ::: "memory")
#define VM_WAIT() asm volatile("s_waitcnt vmcnt(0)" ::: "memory")

namespace pg8 {
#define PG8_LAS __attribute__((address_space(3)))
constexpr int BM = 256, BK = 64, HALF = 128, HTB = HALF * BK * 2, STAGE_BYTES = 8 * HTB, NXCD = 8, WGM = 8;
__host__ __device__ __forceinline__ int lds_byte(int r, int c) { const int st = (r >> 4) * 2 + (c >> 5), rr = r & 15, cc = c & 31, ob = rr * 64 + cc * 2; return st * 1024 + (ob ^ (((ob >> 9) & 1) << 5)); }
__host__ __device__ __forceinline__ void stage_rc(int b, int& R, int& C) { const int st = b / 1024, sb = b % 1024, swz = sb ^ (((sb >> 9) & 1) << 5); R = (st >> 1) * 16 + swz / 64; C = (st & 1) * 32 + (swz % 64) / 2; }
__host__ __device__ __forceinline__ int perm32(int rho) { const int n = rho >> 4, i = rho & 15; return 8 * (i >> 2) + 4 * n + (i & 3); }
struct Unit { int pm, pn; };
struct Gemm { const bf16_t* A; const bf16_t* Bt; int M, N, K; };
struct StaticOrder {
    int nM, nN, nwg, G, c;
    __host__ __device__ void init(int M, int N, int G_, int c_) { nM = M / BM; nN = N / BM; nwg = nM * nN; G = G_; c = c_; }
    __host__ __device__ bool next(int i, Unit& u) const {
        const long L = (long)i * G + c; if (L >= nwg) return false;
        int wgid = (int)L; { const int q = nwg / NXCD, r = nwg % NXCD, xcd = wgid % NXCD, off = wgid / NXCD; wgid = (xcd < r ? xcd * (q + 1) : r * (q + 1) + (xcd - r) * q) + off; }
        const int nig = WGM * nN, gid = wgid / nig, fm = gid * WGM, gsz = (nM - fm) < WGM ? (nM - fm) : WGM;
        u.pm = fm + ((wgid % nig) % gsz); u.pn = (wgid % nig) / gsz; return true;
    }
    __device__ __forceinline__ void a_ready(const Unit&) const {}
    __device__ __forceinline__ void done(const Unit&) const {}
};


__device__ __forceinline__ void rtable(PG8_LAS float* R, const float* rsp, int pm, int tid) {
    if (tid < 256) { const f32x4* p = (const f32x4*)(rsp + (size_t)(pm * BM + tid) * 16); const f32x4 a = p[0], b = p[1], c = p[2], d = p[3];
        const float sm = ((a.x + a.y) + (a.z + a.w)) + ((b.x + b.y) + (b.z + b.w)) + ((c.x + c.y) + (c.z + c.w)) + ((d.x + d.y) + (d.z + d.w));
        R[tid] = 1.0f / sqrtf(sm * (1.0f / 1024.0f) + 1e-6f); }
    asm volatile("s_waitcnt lgkmcnt(0)" ::: "memory"); __builtin_amdgcn_s_barrier(); asm volatile("" ::: "memory");
}
struct EpiProj {
    static constexpr bool PERM = true, AFTER_DRAIN = false;
    bf16_t* P; const float* lbt; const float* rsp; const float* bias; PG8_LAS float* R;
    __device__ __forceinline__ void operator()(f32x4 (&acc)[2][2][4][2], const Unit& u, int wr, int wc, int fr, int fq) const {
        rtable(R, rsp, u.pm, (wr * 4 + wc) * 64 + fq * 16 + fr);
        const int row0 = u.pm * BM + wr * 64 + fr, typ = u.pn >> 1, col0 = u.pn * BM + wc * 32 + 8 * fq;
        const float* bp = bias + cid_of_tile(u.pm) * NIN + col0;
        float rr[2][4];
#pragma unroll
        for (int ai = 0; ai < 2; ++ai)
#pragma unroll
            for (int m = 0; m < 4; ++m) rr[ai][m] = R[ai * HALF + wr * 64 + m * 16 + fr];
#pragma unroll
        for (int bj = 0; bj < 2; ++bj) {
            float lb[8], bs[8];
            { const f32x4 b0 = *(const f32x4*)(bp + bj * HALF), b1 = *(const f32x4*)(bp + bj * HALF + 4); bs[0] = b0.x; bs[1] = b0.y; bs[2] = b0.z; bs[3] = b0.w; bs[4] = b1.x; bs[5] = b1.y; bs[6] = b1.z; bs[7] = b1.w; }
#pragma unroll
            for (int i = 0; i < 8; ++i) lb[i] = 0.f;
            if (typ == 1 || typ == 2) {
                const float* lp = lbt + (typ - 1) * 512 + (col0 + bj * HALF - 512 * typ);
#pragma unroll
                for (int i = 0; i < 8; ++i) lb[i] = lp[i];
            }
#pragma unroll
            for (int ai = 0; ai < 2; ++ai)
#pragma unroll
                for (int m = 0; m < 4; ++m) {
                    float x[8];
#pragma unroll
                    for (int n = 0; n < 2; ++n)
#pragma unroll
                        for (int e = 0; e < 4; ++e) x[4 * n + e] = acc[ai][bj][m][n][e] * rr[ai][m] + bs[4 * n + e];
                    if (typ == 0) {
#pragma unroll
                        for (int i = 0; i < 8; ++i) x[i] = silu_f(x[i]) * 0.08838834764831845f;
                    } else if (typ == 1 || typ == 2) {
#pragma unroll
                        for (int i = 0; i < 8; ++i) { const float sg = __builtin_amdgcn_rcpf(1.0f + __expf(-x[i])); x[i] = __logf(lb[i] + (1.0f - lb[i]) * sg); }
                    } else if (typ == 4) {
#pragma unroll
                        for (int i = 0; i < 8; ++i) x[i] = silu_f(x[i]);
                    }
                    u32x4 w; w.x = pkbf(x[0], x[1]); w.y = pkbf(x[2], x[3]); w.z = pkbf(x[4], x[5]); w.w = pkbf(x[6], x[7]);
                    *(u32x4*)(P + (size_t)(row0 + ai * HALF + m * 16) * NIN + col0 + bj * HALF) = w;
                }
        }
    }
};

struct EpiResid {
    static constexpr bool PERM = false, AFTER_DRAIN = false;
    const float* bp; const float* bs; float* out; const float* gate;
    bf16_t* Hn; const float* nw; const float* sc; float* rsp;
    __device__ __forceinline__ void operator()(f32x4 (&acc)[2][2][4][2], const Unit& u, int wr, int wc, int fr, int fq) const {
        const int row0 = u.pm * BM + wr * 64 + fr, col0 = u.pn * BM + wc * 32 + 4 * fq, cid = cid_of_tile(u.pm);
        const float* base = (u.pm < 16) ? bp : (bs - (size_t)TP * DM);
        f32x4 gv[2][2], cv[2][2];
#pragma unroll
        for (int bj = 0; bj < 2; ++bj)
#pragma unroll
            for (int n = 0; n < 2; ++n) { gv[bj][n] = *(const f32x4*)(gate + cid * NMOD + col0 + bj * HALF + n * 16);
                cv[bj][n] = (f32x4){0.f, 0.f, 0.f, 0.f};
                if (Hn) cv[bj][n] = *(const f32x4*)(nw + col0 + bj * HALF + n * 16) * (1.0f + *(const f32x4*)(sc + cid * NMOD + col0 + bj * HALF + n * 16)); }
#pragma unroll
        for (int ai = 0; ai < 2; ++ai)
#pragma unroll
            for (int m = 0; m < 4; ++m) { const int row = row0 + ai * HALF + m * 16; const size_t off = (size_t)row * DM + col0; float ps = 0.f;
#pragma unroll
                for (int bj = 0; bj < 2; ++bj)
#pragma unroll
                    for (int n = 0; n < 2; ++n) { const f32x4 b = *(const f32x4*)(base + off + bj * HALF + n * 16); const f32x4 o = b + gv[bj][n] * acc[ai][bj][m][n]; *(f32x4*)(out + off + bj * HALF + n * 16) = o;
                        if (Hn) { ps += (o.x * o.x + o.y * o.y) + (o.z * o.z + o.w * o.w); const f32x4 a = o * cv[bj][n]; u32x2 pk; pk.x = pkbf(a.x, a.y); pk.y = pkbf(a.z, a.w); *(u32x2*)(Hn + off + bj * HALF + n * 16) = pk; } }
                if (Hn) { ps += __shfl_xor(ps, 16); ps += __shfl_xor(ps, 32); if (fq == 0) rsp[(size_t)row * 16 + u.pn * 4 + wc] = ps; } }
    }
};

struct EpiFfn {
    static constexpr bool PERM = true, AFTER_DRAIN = false;
    bf16_t* ACT; const float* cw; PG8_LAS float* X; const float* rsp; const float* bias; PG8_LAS float* R;
    __device__ __forceinline__ void operator()(f32x4 (&acc)[2][2][4][2], const Unit& u, int wr, int wc, int fr, int fq) const {
        const bool prompt = u.pm < 16;
        const int lane = fq * 16 + fr;
        const int cc0 = wc * 32 + 8 * fq, fbase = u.pn * HALF + cc0;
        rtable(R, rsp, u.pm, (wr * 4 + wc) * 64 + lane);
        {
            const float* bp = bias + cid_of_tile(u.pm) * NUP + u.pn * BM + cc0;
#pragma unroll
            for (int bj = 0; bj < 2; ++bj)
#pragma unroll
                for (int n = 0; n < 2; ++n) { const f32x4 bv = *(const f32x4*)(bp + bj * HALF + 4 * n);
#pragma unroll
                    for (int ai = 0; ai < 2; ++ai)
#pragma unroll
                        for (int m = 0; m < 4; ++m) acc[ai][bj][m][n] = acc[ai][bj][m][n] * R[ai * HALF + wr * 64 + m * 16 + fr] + bv; }
        }
        const int src_prev = (lane & 48) | ((fr + 15) & 15), src_next = (lane & 48) | ((fr + 1) & 15);
        if (prompt) {
#pragma unroll
            for (int ai = 0; ai < 2; ++ai) { const int slab = 2 * ai + wr;
#pragma unroll
                for (int bj = 0; bj < 2; ++bj)
#pragma unroll
                    for (int n = 0; n < 2; ++n) {
                        if (fr == 0) *(PG8_LAS f32x4*)(X + (slab * 2 + 0) * 256 + bj * HALF + cc0 + 4 * n) = acc[ai][bj][0][n];
                        if (fr == 15) *(PG8_LAS f32x4*)(X + (slab * 2 + 1) * 256 + bj * HALF + cc0 + 4 * n) = acc[ai][bj][3][n];
                    } }
            asm volatile("s_waitcnt lgkmcnt(0)" ::: "memory"); __builtin_amdgcn_s_barrier(); asm volatile("" ::: "memory");
        }
#pragma unroll
        for (int n = 0; n < 2; ++n) {
            f32x4 wg[3], wv[3];
#pragma unroll
            for (int j = 0; j < 3; ++j) { wg[j] = *(const f32x4*)(cw + j * NUP + fbase + 4 * n); wv[j] = *(const f32x4*)(cw + j * NUP + DFF + fbase + 4 * n); }
#pragma unroll
            for (int ai = 0; ai < 2; ++ai) {
                const int slab = 2 * ai + wr;
                f32x4 hp[2], hn[2];
#pragma unroll
                for (int bj = 0; bj < 2; ++bj) { hp[bj] = (f32x4){0.f, 0.f, 0.f, 0.f}; hn[bj] = (f32x4){0.f, 0.f, 0.f, 0.f}; }
                if (prompt) {
#pragma unroll
                    for (int bj = 0; bj < 2; ++bj) {
                        if (fr == 0 && slab > 0) hp[bj] = *(PG8_LAS f32x4*)(X + ((slab - 1) * 2 + 1) * 256 + bj * HALF + cc0 + 4 * n);
                        if (fr == 15 && slab < 3) hn[bj] = *(PG8_LAS f32x4*)(X + ((slab + 1) * 2 + 0) * 256 + bj * HALF + cc0 + 4 * n);
                    }
                }
#pragma unroll
                for (int m = 0; m < 4; ++m) {
                    float cv[2][4];
#pragma unroll
                    for (int bj = 0; bj < 2; ++bj)
#pragma unroll
                        for (int e = 0; e < 4; ++e) {
                            const float c = acc[ai][bj][m][n][e];
                            const float r1 = __shfl(c, src_prev), r15 = __shfl(c, src_next);
                            float pm1, pn1;
                            if (m > 0) pm1 = __shfl(acc[ai][bj][m > 0 ? m - 1 : 0][n][e], src_prev); else pm1 = hp[bj][e];
                            if (m < 3) pn1 = __shfl(acc[ai][bj][m < 3 ? m + 1 : 3][n][e], src_next); else pn1 = hn[bj][e];
                            const float p = (fr == 0) ? pm1 : r1, nx = (fr == 15) ? pn1 : r15;
                            const float w0 = bj ? wv[0][e] : wg[0][e], w1 = bj ? wv[1][e] : wg[1][e], w2 = bj ? wv[2][e] : wg[2][e];
                            cv[bj][e] = w0 * p + w1 * c + w2 * nx;
                        }
                    u32x2 w; w.x = pkbf(silu_f(cv[0][0]) * cv[1][0], silu_f(cv[0][1]) * cv[1][1]); w.y = pkbf(silu_f(cv[0][2]) * cv[1][2], silu_f(cv[0][3]) * cv[1][3]);
                    *(u32x2*)(ACT + (size_t)(u.pm * BM + ai * HALF + wr * 64 + m * 16 + fr) * DFF + fbase + 4 * n) = w;
                }
            }
        }
    }
};

template <class Epi, class Sched, bool ALIGN_EPI = false, bool SP2 = false>
__device__ __forceinline__ void gemm_phase(PG8_LAS unsigned char* lds, const Gemm g, const Sched& S, const Epi& E) {
    const int tid = threadIdx.x, wid = __builtin_amdgcn_readfirstlane(tid >> 6), lane = tid & 63, wr = wid >> 2, wc = wid & 3, fr = lane & 15, fq = lane >> 4;
    const int K = g.K, nt = K / BK;
    unsigned voffA[2], voffB[2];
#pragma unroll
    for (int i = 0; i < 2; ++i) { int R, C; stage_rc(tid * 16 + i * 8192, R, C); const int Rb = Epi::PERM ? ((R & ~31) + perm32(R & 31)) : R;
        voffA[i] = (unsigned)(R * K + C) * 2u; voffB[i] = (unsigned)(Rb * K + C) * 2u; }
    const size_t kstep = (size_t)(BK * 2);
    const size_t hstep = (size_t)HALF * K * 2;
    const size_t tstep = 2 * hstep;
    const unsigned ldsw = (unsigned)wid * 1024u;
    const int aoff = lds_byte(wr * 64 + fr, fq * 8), boff = lds_byte(wc * 32 + fr, fq * 8);
#define PG8_SA(b, h) (((b) * 2 + (h)) * HTB)
#define PG8_SB(b, h) ((4 + (b) * 2 + (h)) * HTB)
#define PG8_STAGE(bufoff, gbase, voff) do { _Pragma("unroll") for (int _i = 0; _i < 2; ++_i) \
        __builtin_amdgcn_global_load_lds((const unsigned*)((const char*)(gbase) + (voff)[_i]), (PG8_LAS unsigned*)(lds + (bufoff) + ldsw + _i * 8192), 16, 0, 0); } while (0)
#define PG8_LDA(dst, b, h) do { _Pragma("unroll") for (int m = 0; m < 4; ++m) _Pragma("unroll") for (int k = 0; k < 2; ++k) dst[m][k] = *(const PG8_LAS bf16x8*)(lds + PG8_SA(b, h) + aoff + m * 2048 + k * 1024); } while (0)
#define PG8_LDB(dst, b, h) do { _Pragma("unroll") for (int n = 0; n < 2; ++n) _Pragma("unroll") for (int k = 0; k < 2; ++k) dst[n][k] = *(const PG8_LAS bf16x8*)(lds + PG8_SB(b, h) + boff + n * 2048 + k * 1024); } while (0)
#define PG8_MMA(ai, bj, At, Bt) do { __builtin_amdgcn_s_setprio(1); _Pragma("unroll") for (int m = 0; m < 4; ++m) _Pragma("unroll") for (int n = 0; n < 2; ++n) _Pragma("unroll") for (int k = 0; k < 2; ++k) \
        acc[ai][bj][m][n] = __builtin_amdgcn_mfma_f32_16x16x32_bf16(Bt[n][k], At[m][k], acc[ai][bj][m][n], 0, 0, 0); __builtin_amdgcn_s_setprio(0); } while (0)
#define PG8_WAIT_V(n) asm volatile("s_waitcnt vmcnt(" #n ")" ::: "memory")
#define PG8_WAIT_L(n) asm volatile("s_waitcnt lgkmcnt(" #n ")" ::: "memory")
#define PG8_BAR __builtin_amdgcn_s_barrier()
#define PG8_SCHED __builtin_amdgcn_sched_barrier(0)
    Unit cur, nxt; int ui = 0;
    if (!S.next(0, cur)) return;
    f32x4 acc[2][2][4][2];
#pragma unroll
    for (int a = 0; a < 2; ++a)
#pragma unroll
        for (int b = 0; b < 2; ++b)
#pragma unroll
            for (int m = 0; m < 4; ++m)
#pragma unroll
                for (int n = 0; n < 2; ++n) acc[a][b][m][n] = (f32x4){0.f, 0.f, 0.f, 0.f};
    bf16x8 At[4][2], B0[2][2], B1[2][2];
    const char* cA = (const char*)g.A + (size_t)cur.pm * tstep; const char* cB = (const char*)g.Bt + (size_t)cur.pn * tstep;
    S.a_ready(cur);
    if constexpr (SP2) {
        PG8_STAGE(PG8_SB(0, 0), cB, voffB); PG8_STAGE(PG8_SB(0, 1), cB + hstep, voffB); PG8_STAGE(PG8_SA(0, 0), cA, voffA); PG8_STAGE(PG8_SA(0, 1), cA + hstep, voffA);
        if (wr == 1) PG8_BAR;
        PG8_WAIT_V(2); PG8_BAR;
        PG8_STAGE(PG8_SB(1, 0), cB + kstep, voffB); PG8_STAGE(PG8_SA(1, 0), cA + kstep, voffA); PG8_STAGE(PG8_SB(1, 1), cB + hstep + kstep, voffB);
        PG8_WAIT_V(6); PG8_BAR;
    } else {
        PG8_STAGE(PG8_SB(0, 0), cB, voffB); PG8_STAGE(PG8_SA(0, 0), cA, voffA); PG8_STAGE(PG8_SB(0, 1), cB + hstep, voffB); PG8_STAGE(PG8_SA(0, 1), cA + hstep, voffA);
        if (wr == 1) PG8_BAR;
        PG8_WAIT_V(4); PG8_BAR;
        PG8_STAGE(PG8_SB(1, 0), cB + kstep, voffB); PG8_STAGE(PG8_SA(1, 0), cA + kstep, voffA); PG8_STAGE(PG8_SB(1, 1), cB + hstep + kstep, voffB);
        PG8_WAIT_V(6); PG8_BAR;
    }
    for (;;) {
        const bool has_next = S.next(ui + 1, nxt);
        const char* nA = has_next ? (const char*)g.A + (size_t)nxt.pm * tstep : cA; const char* nB = has_next ? (const char*)g.Bt + (size_t)nxt.pn * tstep : cB;
        for (int t = 0; t < nt; t += 2) {
            const bool last = (t == nt - 2);
            const char* a1 = cA + (size_t)(t + 1) * kstep;
            const char* a2 = last ? nA : cA + (size_t)(t + 2) * kstep; const char* b2 = last ? nB : cB + (size_t)(t + 2) * kstep;
            const char* a3 = a2 + kstep; const char* b3 = b2 + kstep;
            if (last && has_next) S.a_ready(nxt);
            if constexpr (SP2) {
            PG8_LDB(B0, 0, 0); PG8_LDB(B1, 0, 1); PG8_SCHED; PG8_LDA(At, 0, 0); PG8_STAGE(PG8_SA(1, 1), a1 + hstep, voffA);
            PG8_WAIT_V(8); PG8_WAIT_L(0); PG8_BAR; PG8_MMA(0, 0, At, B0); PG8_MMA(0, 1, At, B1); PG8_BAR; PG8_SCHED;
            PG8_LDA(At, 0, 1); PG8_STAGE(PG8_SB(0, 0), b2, voffB); PG8_STAGE(PG8_SB(0, 1), b2 + hstep, voffB); PG8_STAGE(PG8_SA(0, 0), a2, voffA);
            PG8_WAIT_V(8); PG8_WAIT_L(0); PG8_BAR; PG8_MMA(1, 0, At, B0); PG8_MMA(1, 1, At, B1); PG8_BAR; PG8_SCHED;
            PG8_LDB(B0, 1, 0); PG8_LDB(B1, 1, 1); PG8_SCHED; PG8_LDA(At, 1, 0); PG8_STAGE(PG8_SA(0, 1), a2 + hstep, voffA);
            PG8_WAIT_V(8); PG8_WAIT_L(0); PG8_BAR; PG8_MMA(0, 0, At, B0); PG8_MMA(0, 1, At, B1); PG8_BAR; PG8_SCHED;
            PG8_LDA(At, 1, 1); PG8_STAGE(PG8_SB(1, 0), b3, voffB); PG8_STAGE(PG8_SB(1, 1), b3 + hstep, voffB); PG8_STAGE(PG8_SA(1, 0), a3, voffA);
            PG8_WAIT_V(8); PG8_WAIT_L(0); PG8_BAR; PG8_MMA(1, 0, At, B0); PG8_MMA(1, 1, At, B1); PG8_BAR; PG8_SCHED;
            } else {
            PG8_LDB(B0, 0, 0); PG8_SCHED; PG8_LDA(At, 0, 0); PG8_STAGE(PG8_SA(1, 1), a1 + hstep, voffA);
            PG8_WAIT_L(8); PG8_BAR; PG8_WAIT_L(0); PG8_MMA(0, 0, At, B0); PG8_BAR; PG8_SCHED;
            PG8_LDB(B1, 0, 1); PG8_STAGE(PG8_SB(0, 0), b2, voffB);
            PG8_BAR; PG8_WAIT_L(0); PG8_MMA(0, 1, At, B1); PG8_BAR;
            PG8_LDA(At, 0, 1); PG8_STAGE(PG8_SA(0, 0), a2, voffA);
            PG8_BAR; PG8_WAIT_L(0); PG8_MMA(1, 0, At, B0); PG8_BAR; PG8_SCHED;
            PG8_STAGE(PG8_SB(0, 1), b2 + hstep, voffB);
            PG8_WAIT_V(6); PG8_BAR; PG8_MMA(1, 1, At, B1); PG8_BAR;
            PG8_LDB(B0, 1, 0); PG8_SCHED; PG8_LDA(At, 1, 0); PG8_STAGE(PG8_SA(0, 1), a2 + hstep, voffA);
            PG8_WAIT_L(8); PG8_BAR; PG8_WAIT_L(0); PG8_MMA(0, 0, At, B0); PG8_BAR; PG8_SCHED;
            PG8_LDB(B1, 1, 1); PG8_STAGE(PG8_SB(1, 0), b3, voffB);
            PG8_BAR; PG8_WAIT_L(0); PG8_MMA(0, 1, At, B1); PG8_BAR;
            PG8_LDA(At, 1, 1); PG8_STAGE(PG8_SA(1, 0), a3, voffA);
            PG8_BAR; PG8_WAIT_L(0); PG8_MMA(1, 0, At, B0); PG8_BAR; PG8_SCHED;
            PG8_STAGE(PG8_SB(1, 1), b3 + hstep, voffB);
            PG8_WAIT_V(6); PG8_BAR; PG8_MMA(1, 1, At, B1); PG8_BAR;
            }
        }
        if constexpr (ALIGN_EPI) { if (wr == 0) PG8_BAR; }
        if constexpr (!Epi::AFTER_DRAIN) { E(acc, cur, wr, wc, fr, fq); S.done(cur); }
        if (!has_next) break;
#pragma unroll
        for (int a = 0; a < 2; ++a)
#pragma unroll
            for (int b = 0; b < 2; ++b)
#pragma unroll
                for (int m = 0; m < 4; ++m)
#pragma unroll
                    for (int n = 0; n < 2; ++n) acc[a][b][m][n] = (f32x4){0.f, 0.f, 0.f, 0.f};
        cur = nxt; cA = nA; cB = nB; ++ui;
        if constexpr (ALIGN_EPI) { if (wr == 1) PG8_BAR; }
    }
    PG8_WAIT_V(0);
    if constexpr (!ALIGN_EPI) { if (wr == 0) PG8_BAR; }
    PG8_BAR;
#undef PG8_SA
#undef PG8_SB
#undef PG8_STAGE
#undef PG8_LDA
#undef PG8_LDB
#undef PG8_MMA
#undef PG8_WAIT_V
#undef PG8_WAIT_L
#undef PG8_BAR
#undef PG8_SCHED
}
}

#define XB_TMO      128
#define XB_XCNT(j)  (256  + 64 * (j))
#define XB_XSUB(j)  (1280 + 64 * (j))
#define XB_XGEN(j)  (2304 + 64 * (j))
#define XB_TOP      3328
#define XB_TOPGEN   3392
#define XCD_BAR_WORDS 3456
#define XB_SPIN_CAP (1u << 18)
DI unsigned xb_ld(unsigned* p)              { return __hip_atomic_load(p, __ATOMIC_RELAXED, __HIP_MEMORY_SCOPE_AGENT); }
DI unsigned xb_add(unsigned* p, unsigned v) { return __hip_atomic_fetch_add(p, v, __ATOMIC_RELAXED, __HIP_MEMORY_SCOPE_AGENT); }
DI unsigned xb_xcc_id() { return (unsigned)__builtin_amdgcn_s_getreg((3 << 11) | 20) & 0xFu; }
#define XB_SPIN(cond, bar) do { unsigned _sp = 0; while (cond) { __builtin_amdgcn_s_sleep(1); \
    if ((++_sp & 255u) == 0u) { if (xb_ld(&(bar)[XB_TMO])) break; if (_sp > XB_SPIN_CAP) { atomicAdd(&(bar)[XB_TMO], 1u); break; } } } } while (0)
struct XcdBarrier { unsigned* bar; unsigned x; volatile LAS unsigned* st; };
DI XcdBarrier xcd_barrier_post(unsigned* bar, volatile LAS unsigned* st) {
    XcdBarrier b; b.bar = bar; b.x = xb_xcc_id(); b.st = st;
    if (threadIdx.x == 0) (void)xb_add(&bar[XB_XCNT(b.x)], 1u);
    return b;
}
DI void xcd_barrier_complete(unsigned* bar, unsigned x, unsigned& nloc, unsigned& nx) {
    const unsigned G = gridDim.x * gridDim.y * gridDim.z;
    unsigned sum, cnt, mine, sp = 0u;
    for (;;) {
        sum = 0u; cnt = 0u; mine = 0u;
#pragma unroll
        for (unsigned j = 0; j < 16; ++j) { const unsigned c = xb_ld(&bar[XB_XCNT(j)]); sum += c; cnt += (c > 0u) ? 1u : 0u; mine = (j == x) ? c : mine; }
        if (sum == G) break;
        __builtin_amdgcn_s_sleep(1);
        if ((++sp & 255u) == 0u) { if (xb_ld(&bar[XB_TMO])) break; if (sp > XB_SPIN_CAP) { atomicAdd(&bar[XB_TMO], 1u); break; } }
    }
    nloc = mine > 0u ? mine : 1u; nx = cnt > 0u ? cnt : 1u;
}
DI void xcd_barrier(const XcdBarrier& b) {
    asm volatile("s_waitcnt vmcnt(0)" ::: "memory");
    __syncthreads();
    if (threadIdx.x == 0) {
        unsigned* bar = b.bar;
        __builtin_amdgcn_s_waitcnt(0);
        unsigned nloc = b.st[0], nx = b.st[1];
        if (nloc == 0u) { xcd_barrier_complete(bar, b.x, nloc, nx); b.st[0] = nloc; b.st[1] = nx; }
        const unsigned old = xb_add(&bar[XB_XSUB(b.x)], 1u);
        const unsigned gen = old / nloc;
        if (old + 1u == (gen + 1u) * nloc) {
            __builtin_amdgcn_fence(__ATOMIC_RELEASE, "agent");
            asm volatile("s_waitcnt vmcnt(0)" ::: "memory");
            const unsigned og = xb_add(&bar[XB_TOP], 1u);
            const unsigned tg = og / nx;
            if (og + 1u == (tg + 1u) * nx) xb_add(&bar[XB_TOPGEN], 1u);
            else XB_SPIN(xb_ld(&bar[XB_TOPGEN]) == tg, bar);
            __builtin_amdgcn_fence(__ATOMIC_ACQUIRE, "agent");
            xb_add(&bar[XB_XGEN(b.x)], 1u);
            asm volatile("s_waitcnt vmcnt(0)" ::: "memory");
        } else {
            XB_SPIN(xb_ld(&bar[XB_XGEN(b.x)]) == gen, bar);
            __builtin_amdgcn_fence(__ATOMIC_ACQUIRE, "agent");
            asm volatile("s_waitcnt vmcnt(0)" ::: "memory");
        }
    }
    __syncthreads();
}

struct Args {
    const float* x_prompt; const float* x_sample; const float* state; const float* c; const float* c_ctx;
    const float* w_in; const float* w_out; const float* ada_w; const float* ada_b; const float* norm1_w; const float* norm2_w;
    const float* hg_lb_fwd; const float* hg_lb_bwd; const float* hg_norm_w; const float* hy_conv_w;
    const float* hy_w1; const float* hy_b1; const float* hy_f1; const float* hy_w2; const float* hy_b2; const float* hy_f2; const float* hy_w3; const float* hy_d; const float* hy_norm_w;
    const float* ffn_up; const float* ffn_conv_w; const float* ffn_down; const float* final_norm_w;
    float* out; unsigned char* ws; int ph_lo, ph_hi;
};

typedef const __attribute__((address_space(4))) Args* KArgs;
DI KArgs kargs() { unsigned long long p = (unsigned long long)__builtin_amdgcn_kernarg_segment_ptr(); asm volatile("" : "+s"(p)); return (KArgs)p; }

DI void transpose_item(const float* W, int K, int N, bf16_t* WT, int k0, int n0, int ns0, LAS float* scr, int lane) {
#pragma unroll 8
    for (int i = 0; i < 32; ++i) { const int kk = 2 * i + (lane >> 5); scr[kk * 33 + (lane & 31)] = W[(size_t)(k0 + kk) * N + ns0 + (lane & 31)]; }
    LDS_WAIT(); asm volatile("" ::: "memory");
    const int c = lane & 7;
#pragma unroll
    for (int j = 0; j < 4; ++j) { const int n = (lane >> 3) + 8 * j; const LAS float* s = scr + (8 * c) * 33 + n;
        u32x4 o; o.x = pkbf(s[0 * 33], s[1 * 33]); o.y = pkbf(s[2 * 33], s[3 * 33]); o.z = pkbf(s[4 * 33], s[5 * 33]); o.w = pkbf(s[6 * 33], s[7 * 33]);
        *(u32x4*)(WT + (size_t)(n0 + n) * K + k0 + 8 * c) = o; }
    LDS_WAIT(); asm volatile("" ::: "memory");
}

DI void phase_p0a(KArgs A, lds_t* lds) {
    const int tid = threadIdx.x, lane = tid & 63, wave = __builtin_amdgcn_readfirstlane(tid >> 6), G = gridDim.x, bx = blockIdx.x;
    unsigned char* ws = A->ws;
    float* MOD = (float*)(ws + WS_CTL) + CW_MOD;
    float* HYABS = (float*)(ws + WS_CTL) + CW_HYABS;
    if (bx == 0) {
        float* LBT = (float*)(ws + WS_LBT);
        for (int i = tid; i < 1024; i += 512) { const int dir = i >> 9, c = i & 511; const float* p = dir ? A->hg_lb_bwd : A->hg_lb_fwd;
            const float p0 = p[c], p1 = p[512 + c], mx = fmaxf(p0, p1), e0 = __expf(p0 - mx), e1 = __expf(p1 - mx);
            LBT[0 * 1024 + dir * 512 + c] = 0.f; LBT[1 * 1024 + dir * 512 + c] = e1 / (e0 + e1); }
    }
    for (int un = bx; un < 352; un += G) {
        if (un < 160) {
            const int l = un / 80, r = un % 80, cs = r < 16 ? 0 : 1, pb = cs ? r - 16 : r, L = cs ? 1024 : 256, p0 = pb * 16;
            LAS float* FE = (LAS float*)lds;
            LAS float* H1 = FE + 16 * 33;
            LAS float* H2 = H1 + 16 * 64;
            for (int i = tid; i < 16 * 33; i += 512) { const int p = i / 33, e = i % 33, pos = p0 + p; float v;
                if (e == 0) v = (float)pos / (float)(L - 1);
                else { const int k = (e - 1) & 15; const float band = 1e-4f + (float)k * ((15.0f - 1e-4f) / 15.0f); const float ang = 6.283185307179586f * (float)pos * band / (float)L; v = (e <= 16) ? cosf(ang) : sinf(ang); }
                FE[i] = v; }
            __syncthreads();
            for (int i = tid; i < 16 * 64; i += 512) { const int p = i >> 6, o = i & 63; float s = A->hy_b1[l * 64 + o];
                for (int e = 0; e < 33; ++e) s += FE[p * 33 + e] * A->hy_w1[(l * 33 + e) * 64 + o];
                H1[i] = sinf(A->hy_f1[l * 64 + o] * s); }
            __syncthreads();
            for (int i = tid; i < 16 * 64; i += 512) { const int p = i >> 6, o = i & 63; float s = A->hy_b2[l * 64 + o];
                for (int k = 0; k < 64; ++k) s += H1[p * 64 + k] * A->hy_w2[(l * 64 + k) * 64 + o];
                H2[i] = sinf(A->hy_f2[l * 64 + o] * s); }
            __syncthreads();
            float af[16], ab[16];
#pragma unroll
            for (int p = 0; p < 16; ++p) { af[p] = 0.f; ab[p] = 0.f; }
            const float* w3 = A->hy_w3 + (size_t)l * 64 * 1024;
            for (int k = 0; k < 64; ++k) { const float wf = w3[k * 1024 + tid], wb = w3[k * 1024 + 512 + tid];
#pragma unroll
                for (int p = 0; p < 16; ++p) { const float h = H2[p * 64 + k]; af[p] += h * wf; ab[p] += h * wb; } }
            const float mind = -3.0701134573253944f, maxd = -15.350567286626973f;
            const float delta = fabsf(mind + (float)tid * ((maxd - mind) / 511.0f));
            bf16_t* GF = (bf16_t*)(ws + WS_GF + (size_t)l * GF_LSTRIDE + (cs ? GF_SAMPLE_OFF : 0)) + (size_t)tid * (2 * L);
            float asum = 0.f;
#pragma unroll
            for (int p = 0; p < 16; ++p) { const int pos = p0 + p; const float tt = (float)pos / (float)(L - 1), dec = __expf(-tt * delta);
                const float hf = af[p] * dec, hb = ab[p] * dec;
                GF[L + pos] = (bf16_t)(pkbf(hf, 0.f) & 0xffffu); asum += fabsf(hf);
                if (pos >= 1) { GF[L - pos] = (bf16_t)(pkbf(hb, 0.f) & 0xffffu); asum += fabsf(hb); } else GF[0] = 0; }
            atomicAdd(&HYABS[(l * 2 + cs) * 512 + tid], asum);
            __syncthreads();
        } else {
            const int v = un - 160, l = v / 96, r = v % 96, jb = r >> 2, kq = r & 3;
            LAS float* SC = (LAS float*)lds;
            LAS float* PA = SC + 9 * 256;
            for (int i = tid; i < 9 * 256; i += 512) { const int cid = i >> 8, k = kq * 256 + (i & 255); const float cvv = cid == 0 ? A->c_ctx[k] : A->c[(cid - 1) * DM + k]; SC[i] = silu_f(cvv); }
            __syncthreads();
            f32x4 ac[9];
#pragma unroll
            for (int q = 0; q < 9; ++q) ac[q] = (f32x4){0.f, 0.f, 0.f, 0.f};
            const float* wp = A->ada_w + ((size_t)l * DM + kq * 256 + wave * 32) * NMOD + jb * 256 + 4 * lane;
#pragma unroll 8
            for (int kk = 0; kk < 32; ++kk) { const f32x4 wv = *(const f32x4*)(wp + (size_t)kk * NMOD);
#pragma unroll
                for (int q = 0; q < 9; ++q) ac[q] += SC[q * 256 + wave * 32 + kk] * wv; }
#pragma unroll
            for (int q = 0; q < 9; ++q) *(LAS f32x4*)(PA + (wave * 9 + q) * 256 + 4 * lane) = ac[q];
            __syncthreads();
            for (int i = tid; i < 9 * 256; i += 512) { float s = 0.f;
#pragma unroll
                for (int w = 0; w < 8; ++w) s += PA[w * 9 * 256 + i];
                const int cid = i >> 8, j = jb * 256 + (i & 255);
                if (kq == 0) s += A->ada_b[l * NMOD + j];
                atomicAdd(&MOD[(l * 9 + cid) * NMOD + j], s); }
            __syncthreads();
        }
    }
    {
        LAS float* scr = (LAS float*)(lds + wave * 16384);
        const int gw = bx * 8 + wave, NGW = G * 8;
        constexpr int I_IN = 16 * 128, I_OUT = 16 * 32, I_UP = 16 * 176, I_DN = 44 * 32, I_L = I_IN + I_OUT + I_UP + I_DN;
        for (int it = gw; it < 2 * I_L; it += NGW) {
            const int l = it / I_L; int r = it % I_L;
            if (r < I_IN) { const int kb = r / 128, nb = r % 128; transpose_item(A->w_in + (size_t)l * DM * NIN, DM, NIN, (bf16_t*)(ws + WS_WIN) + (size_t)l * NIN * DM, 64 * kb, 32 * nb, 32 * nb, scr, lane); continue; } r -= I_IN;
            if (r < I_OUT) { const int kb = r / 32, nb = r % 32; transpose_item(A->w_out + (size_t)l * DM * DM, DM, DM, (bf16_t*)(ws + WS_WOUT) + (size_t)l * DM * DM, 64 * kb, 32 * nb, 32 * nb, scr, lane); continue; } r -= I_OUT;
            if (r < I_UP) { const int kb = r / 176, nb = r % 176, n0 = 32 * nb, tj = n0 >> 8, cc = n0 & 255, ns0 = cc < 128 ? 128 * tj + cc : DFF + 128 * tj + (cc - 128);
                transpose_item(A->ffn_up + (size_t)l * DM * NUP, DM, NUP, (bf16_t*)(ws + WS_WUP) + (size_t)l * NUP * DM, 64 * kb, n0, ns0, scr, lane); continue; } r -= I_UP;
            { const int kb = r / 32, nb = r % 32; transpose_item(A->ffn_down + (size_t)l * DFF * DM, DFF, DM, (bf16_t*)(ws + WS_WDN) + (size_t)l * DM * DFF, 64 * kb, 32 * nb, 32 * nb, scr, lane); }
        }
    }
}

DI void phase_p0b(KArgs A, lds_t* lds) {
    const int tid = ltid(), lane = tid & 63, wave = __builtin_amdgcn_readfirstlane(tid >> 6), gw = blockIdx.x * 8 + wave, NGW = gridDim.x * 8;
    const float* MOD = (const float*)(A->ws + WS_CTL) + CW_MOD;
    bf16_t* H = (bf16_t*)(A->ws + WS_H); float* RSP = (float*)(A->ws + WS_RSP);
    for (int m = gw; m < TT; m += NGW) {
        const float* xr = (m < TP) ? A->x_prompt + (size_t)m * DM : A->x_sample + (size_t)(m - TP) * DM;
        const float* md = MOD + cid_of_row(m) * NMOD;
        f32x4 v[4]; float s = 0.f;
#pragma unroll
        for (int j = 0; j < 4; ++j) { v[j] = *(const f32x4*)(xr + 4 * lane + 256 * j); s += (v[j].x * v[j].x + v[j].y * v[j].y) + (v[j].z * v[j].z + v[j].w * v[j].w); }
        s = wave_sum(s);
        if (lane < 16) RSP[(size_t)m * 16 + lane] = lane == 0 ? s : 0.f;
#pragma unroll
        for (int j = 0; j < 4; ++j) { const int c = 4 * lane + 256 * j; const f32x4 w = *(const f32x4*)(A->norm1_w + c), sc = *(const f32x4*)(md + 1024 + c);
            const f32x4 o = v[j] * w * (1.0f + sc);
            u32x2 pk; pk.x = pkbf(o.x, o.y); pk.y = pkbf(o.z, o.w); *(u32x2*)(H + (size_t)m * DM + c) = pk; }
    }
    LAS float* SH = (LAS float*)lds;
    for (int seg = 0; seg < 4; ++seg) {
        const int l = seg >> 1, which = seg & 1, nrows = which ? NUP : NIN;
        const float* shp = MOD + (size_t)l * 9 * NMOD + (which ? 3072 : 0);
        __syncthreads();
        for (int i = tid; i < 9 * 1024; i += 512) SH[i] = shp[(i >> 10) * NMOD + (i & 1023)];
        __syncthreads();
        const bf16_t* W = which ? (const bf16_t*)(A->ws + WS_WUP) + (size_t)l * NUP * DM : (const bf16_t*)(A->ws + WS_WIN) + (size_t)l * NIN * DM;
        float* bo = (float*)(A->ws + WS_BIAS + (which ? BIAS2_OFF : 0)) + (size_t)l * 9 * nrows;
        for (int n = gw; n < nrows; n += NGW) {
            const u32x4 w0 = *(const u32x4*)(W + (size_t)n * DM + 16 * lane), w1 = *(const u32x4*)(W + (size_t)n * DM + 16 * lane + 8);
            const float wf[16] = {bflo(w0.x), bfhi(w0.x), bflo(w0.y), bfhi(w0.y), bflo(w0.z), bfhi(w0.z), bflo(w0.w), bfhi(w0.w), bflo(w1.x), bfhi(w1.x), bflo(w1.y), bfhi(w1.y), bflo(w1.z), bfhi(w1.z), bflo(w1.w), bfhi(w1.w)};
#pragma unroll
            for (int q = 0; q < 9; ++q) { float sm = 0.f;
#pragma unroll
                for (int j = 0; j < 4; ++j) { const f32x4 sv = *(const LAS f32x4*)(SH + q * 1024 + 16 * lane + 4 * j); sm += (wf[4 * j] * sv.x + wf[4 * j + 1] * sv.y) + (wf[4 * j + 2] * sv.z + wf[4 * j + 3] * sv.w); }
                sm = wave_sum(sm);
                if (lane == 0) bo[(size_t)q * nrows + n] = sm; }
        }
    }
}
DI void phase_final_norm(KArgs A) {
    const int tid = ltid(), lane = tid & 63, wave = __builtin_amdgcn_readfirstlane(tid >> 6), gw = blockIdx.x * 8 + wave, NGW = gridDim.x * 8;
    for (int m = gw; m < TT; m += NGW) {
        float* xr = A->out + (size_t)m * DM;
        f32x4 v[4]; float s = 0.f;
#pragma unroll
        for (int j = 0; j < 4; ++j) { v[j] = *(const f32x4*)(xr + 4 * lane + 256 * j); s += (v[j].x * v[j].x + v[j].y * v[j].y) + (v[j].z * v[j].z + v[j].w * v[j].w); }
        const float r = 1.0f / sqrtf(wave_sum(s) * (1.0f / DM) + EPS);
#pragma unroll
        for (int j = 0; j < 4; ++j) { const int c = 4 * lane + 256 * j; const f32x4 w = *(const f32x4*)(A->final_norm_w + c); *(f32x4*)(xr + c) = v[j] * r * w; }
    }
}

DI void phase_hyprep(KArgs A, int l, lds_t* lds) {
    const int tid = threadIdx.x;
    const bf16_t* P = (const bf16_t*)(A->ws + WS_P);
    bf16_t* UT = (bf16_t*)(A->ws + WS_UT); bf16_t* X2T = (bf16_t*)(A->ws + WS_X2T);
    constexpr int RS = 144;
    for (int un = blockIdx.x; un < 192 * 8; un += gridDim.x) {
        const int tb = un >> 3, cb = un & 7, m0 = 64 * tb;
        const bool pr = m0 < TP, has_prev = pr && ((m0 & 255) != 0), has_next = pr && (((m0 + 64) & 255) != 0);
        {
            const int row = tid >> 3, ch = tid & 7;
#pragma unroll
            for (int a = 0; a < 3; ++a) { const u32x4 v = *(const u32x4*)(P + (size_t)(m0 + row) * NIN + 2560 + a * 512 + cb * 64 + ch * 8); *(LAS u32x4*)(lds + a * 66 * RS + (row + 1) * RS + ch * 16) = v; }
            if (tid < 48) { const int a = tid >> 4, which = (tid >> 3) & 1, chh = tid & 7; const bool valid = which ? has_next : has_prev; const int mrow = which ? m0 + 64 : m0 - 1;
                u32x4 v = (u32x4){0u, 0u, 0u, 0u}; if (valid) v = *(const u32x4*)(P + (size_t)mrow * NIN + 2560 + a * 512 + cb * 64 + chh * 8);
                *(LAS u32x4*)(lds + a * 66 * RS + (which ? 65 : 0) * RS + chh * 16) = v; }
        }
        __syncthreads();
        {
            const int ch = tid >> 3, tq = tid & 7, cg = cb * 64 + ch;
            float w[3][3];
#pragma unroll
            for (int a = 0; a < 3; ++a)
#pragma unroll
                for (int j = 0; j < 3; ++j) w[a][j] = A->hy_conv_w[(l * 3 + j) * 1536 + a * 512 + cg];
            float uu[8], xx[8];
#pragma unroll
            for (int i = 0; i < 8; ++i) { const int rr = 8 * tq + i + 1; float val[3];
#pragma unroll
                for (int a = 0; a < 3; ++a) { const lds_t* b = lds + a * 66 * RS + 2 * ch;
                    const float xm = bf1(*(const LAS bf16_t*)(b + (rr - 1) * RS)), x0 = bf1(*(const LAS bf16_t*)(b + rr * RS)), xp = bf1(*(const LAS bf16_t*)(b + (rr + 1) * RS));
                    val[a] = w[a][0] * xm + w[a][1] * x0 + w[a][2] * xp; }
                uu[i] = val[1] * val[0]; xx[i] = val[2]; }
            u32x4 o; o.x = pkbf(uu[0], uu[1]); o.y = pkbf(uu[2], uu[3]); o.z = pkbf(uu[4], uu[5]); o.w = pkbf(uu[6], uu[7]);
            *(u32x4*)(UT + (size_t)cg * TT + m0 + 8 * tq) = o;
            o.x = pkbf(xx[0], xx[1]); o.y = pkbf(xx[2], xx[3]); o.z = pkbf(xx[4], xx[5]); o.w = pkbf(xx[6], xx[7]);
            *(u32x4*)(X2T + (size_t)cg * TT + m0 + 8 * tq) = o;
        }
        __syncthreads();
    }
}

constexpr int S_QE = 0, S_QS = 17408, S_KS = 34816, S_QB = 52224, S_KB = 60928, S_KT = 69632, S_VT = 88064, S_PP = 106496, S_ST = 115712, S_GT = 150528, S_DEC = 154624;
static_assert(S_DEC + 512 <= MISC_OFF, "scan lds");
DI void scan_item(KArgs A, int l, int seq, int head, int dir, lds_t* lds) {
    const int tid = threadIdx.x, lane = tid & 63, w = __builtin_amdgcn_readfirstlane(tid >> 6);
    const bool samp = seq >= 16;
    const int L = samp ? 1024 : 256, mbase = samp ? TP + (seq - 16) * 1024 : seq * 256, nch = L >> 6;
    const bf16_t* P = (const bf16_t*)(A->ws + WS_P);
    const bf16_t* Pq = P + (size_t)mbase * NIN + head * 128;
    const bf16_t* Pf = Pq + 512 + dir * 512;
    const bf16_t* Pv = Pq + 1536;
    bf16_t* Oo = (bf16_t*)(A->ws + WS_H) + (size_t)dir * TT * 512 + (size_t)mbase * 512 + head * 128;
    const int a = w >> 2, jv = w & 3, r = lane & 31, hh = lane >> 5;
    f32x16 Sa[2];
    if (samp) {
        const float* st = A->state + ((((size_t)(seq - 16) * 2 + l) * 2 + dir) * 4 + head) * 16384;
#pragma unroll
        for (int ii = 0; ii < 2; ++ii)
#pragma unroll
            for (int rg = 0; rg < 16; ++rg) Sa[ii][rg] = st[(size_t)(32 * (2 * a + ii) + crow(rg, hh)) * 128 + 32 * jv + r];
    } else {
#pragma unroll
        for (int ii = 0; ii < 2; ++ii)
#pragma unroll
            for (int rg = 0; rg < 16; ++rg) Sa[ii][rg] = 0.f;
    }
#pragma unroll
    for (int ii = 0; ii < 2; ++ii)
#pragma unroll
        for (int q4 = 0; q4 < 4; ++q4) { u32x2 pk; pk.x = pkbf(Sa[ii][4 * q4], Sa[ii][4 * q4 + 1]); pk.y = pkbf(Sa[ii][4 * q4 + 2], Sa[ii][4 * q4 + 3]);
            *(LAS u32x2*)(lds + S_ST + (32 * jv + r) * 272 + 2 * (32 * (2 * a + ii) + 8 * q4 + 4 * hh)) = pk; }
    unsigned rq[8], rf[8], rv[8];
#pragma unroll
    for (int i = 0; i < 8; ++i) { const int tau = 8 * w + i, t = dir ? L - 1 - tau : tau; const size_t off = (size_t)t * NIN + 2 * lane;
        rq[i] = *(const unsigned*)(Pq + off); rf[i] = *(const unsigned*)(Pf + off); rv[i] = *(const unsigned*)(Pv + off); }
    for (int ch = 0; ch < nch; ++ch) {
        float b0[8], b1[8];
        { float s0 = 0.f, s1 = 0.f;
#pragma unroll
          for (int i = 0; i < 8; ++i) { s0 += bflo(rf[i]); s1 += bfhi(rf[i]); b0[i] = s0; b1[i] = s1; }
          *(LAS f32x2_t*)(lds + S_GT + (w * 128 + 2 * lane) * 4) = (f32x2_t){s0, s1}; }
        __syncthreads();
        {
            float my0 = 0.f, my1 = 0.f, p2_0 = 0.f, p2_1 = 0.f, p4_0 = 0.f, p4_1 = 0.f, p6_0 = 0.f, p6_1 = 0.f, run0 = 0.f, run1 = 0.f;
#pragma unroll
            for (int g = 0; g < 8; ++g) {
                if (g == 2) { p2_0 = run0; p2_1 = run1; } if (g == 4) { p4_0 = run0; p4_1 = run1; } if (g == 6) { p6_0 = run0; p6_1 = run1; }
                if (g == w) { my0 = run0; my1 = run1; }
                const f32x2_t gt = *(const LAS f32x2_t*)(lds + S_GT + (g * 128 + 2 * lane) * 4); run0 += gt.x; run1 += gt.y; }
            const float p8_0 = run0, p8_1 = run1;
            const float rd0 = (w < 4) ? p2_0 : p6_0, rd1 = (w < 4) ? p2_1 : p6_1;
            if (w == 0) *(LAS f32x2_t*)(lds + S_DEC + 8 * lane) = (f32x2_t){__expf(p8_0), __expf(p8_1)};
            unsigned kt0[4], kt1[4], vt0[4], vt1[4];
            float kprev0 = 0.f, kprev1 = 0.f, vprev0 = 0.f, vprev1 = 0.f;
#pragma unroll
            for (int i = 0; i < 8; ++i) {
                const int j = 8 * w + i;
                const float q0 = bflo(rq[i]), q1 = bfhi(rq[i]), f0 = bflo(rf[i]), f1 = bfhi(rf[i]), v0 = bflo(rv[i]), v1 = bfhi(rv[i]);
                const float k0 = 1.0f - __expf(f0), k1 = 1.0f - __expf(f1);
                const float bb0 = my0 + b0[i], bb1 = my1 + b1[i];
                *(LAS unsigned*)(lds + S_QE + j * 272 + 4 * lane) = pkbf(q0 * __expf(bb0), q1 * __expf(bb1));
                *(LAS unsigned*)(lds + S_QS + j * 272 + 4 * lane) = pkbf(q0 * __expf(fminf(bb0 - rd0, 80.f)), q1 * __expf(fminf(bb1 - rd1, 80.f)));
                *(LAS unsigned*)(lds + S_KS + j * 272 + 4 * lane) = pkbf(k0 * __expf(fminf(rd0 - bb0, 80.f)), k1 * __expf(fminf(rd1 - bb1, 80.f)));
                if (w >= 4) *(LAS unsigned*)(lds + S_QB + (j - 32) * 272 + 4 * lane) = pkbf(q0 * __expf(fminf(bb0 - p4_0, 0.f)), q1 * __expf(fminf(bb1 - p4_1, 0.f)));
                else        *(LAS unsigned*)(lds + S_KB + j * 272 + 4 * lane) = pkbf(k0 * __expf(fminf(p4_0 - bb0, 0.f)), k1 * __expf(fminf(p4_1 - bb1, 0.f)));
                const float kk0 = k0 * __expf(fminf(p8_0 - bb0, 0.f)), kk1 = k1 * __expf(fminf(p8_1 - bb1, 0.f));
                if (i & 1) { kt0[i >> 1] = pkbf(kprev0, kk0); kt1[i >> 1] = pkbf(kprev1, kk1); vt0[i >> 1] = pkbf(vprev0, v0); vt1[i >> 1] = pkbf(vprev1, v1); }
                else { kprev0 = kk0; kprev1 = kk1; vprev0 = v0; vprev1 = v1; }
            }
            *(LAS u32x4*)(lds + S_KT + (2 * lane) * 144 + 16 * w) = (u32x4){kt0[0], kt0[1], kt0[2], kt0[3]};
            *(LAS u32x4*)(lds + S_KT + (2 * lane + 1) * 144 + 16 * w) = (u32x4){kt1[0], kt1[1], kt1[2], kt1[3]};
            *(LAS u32x4*)(lds + S_VT + (2 * lane) * 144 + 16 * w) = (u32x4){vt0[0], vt0[1], vt0[2], vt0[3]};
            *(LAS u32x4*)(lds + S_VT + (2 * lane + 1) * 144 + 16 * w) = (u32x4){vt1[0], vt1[1], vt1[2], vt1[3]};
        }
        if (ch + 1 < nch) {
#pragma unroll
            for (int i = 0; i < 8; ++i) { const int tau = 64 * (ch + 1) + 8 * w + i, t = dir ? L - 1 - tau : tau; const size_t off = (size_t)t * NIN + 2 * lane;
                rq[i] = *(const unsigned*)(Pq + off); rf[i] = *(const unsigned*)(Pf + off); rv[i] = *(const unsigned*)(Pv + off); }
        }
        __syncthreads();
        if (w < 3) {
            const lds_t* Ab = lds + (w == 2 ? S_QB : (w == 1 ? S_QS + 32 * 272 : S_QS));
            const lds_t* Bb = lds + (w == 2 ? S_KB : (w == 1 ? S_KS + 32 * 272 : S_KS));
            const int prow0 = w == 0 ? 0 : 32, pcol0 = w == 1 ? 32 : 0; const bool mask = w != 2;
            f32x16 sc;
#pragma unroll
            for (int rg = 0; rg < 16; ++rg) sc[rg] = 0.f;
#pragma unroll
            for (int s = 0; s < 8; ++s) { const bf16x8 fa = *(const LAS bf16x8*)(Ab + r * 272 + 32 * s + 16 * hh), fb = *(const LAS bf16x8*)(Bb + r * 272 + 32 * s + 16 * hh); sc = MFMA32(fa, fb, sc); }
#pragma unroll
            for (int rg = 0; rg < 16; ++rg) { const int jl = crow(rg, hh); const float val = (mask && r > jl) ? 0.f : sc[rg];
                *(LAS bf16_t*)(lds + S_PP + (prow0 + jl) * 144 + 2 * (pcol0 + r)) = (bf16_t)(pkbf(val, 0.f) & 0xffffu); }
        }
        f32x16 oacc;
#pragma unroll
        for (int rg = 0; rg < 16; ++rg) oacc[rg] = 0.f;
#pragma unroll
        for (int s = 0; s < 8; ++s) { const bf16x8 fa = *(const LAS bf16x8*)(lds + S_QE + (32 * a + r) * 272 + 32 * s + 16 * hh), fb = *(const LAS bf16x8*)(lds + S_ST + (32 * jv + r) * 272 + 32 * s + 16 * hh); oacc = MFMA32(fa, fb, oacc); }
#pragma unroll
        for (int ii = 0; ii < 2; ++ii) { const int dkb = 32 * (2 * a + ii);
#pragma unroll
            for (int rg = 0; rg < 16; ++rg) Sa[ii][rg] *= *(const LAS float*)(lds + S_DEC + 4 * (dkb + crow(rg, hh)));
#pragma unroll
            for (int s = 0; s < 4; ++s) { const bf16x8 fa = *(const LAS bf16x8*)(lds + S_KT + (dkb + r) * 144 + 32 * s + 16 * hh), fb = *(const LAS bf16x8*)(lds + S_VT + (32 * jv + r) * 144 + 32 * s + 16 * hh); Sa[ii] = MFMA32(fa, fb, Sa[ii]); } }
        __syncthreads();
#pragma unroll
        for (int s = 0; s < 4; ++s) { if (s < 2 || a == 1) { const bf16x8 fa = *(const LAS bf16x8*)(lds + S_PP + (32 * a + r) * 144 + 32 * s + 16 * hh), fb = *(const LAS bf16x8*)(lds + S_VT + (32 * jv + r) * 144 + 32 * s + 16 * hh); oacc = MFMA32(fa, fb, oacc); } }
#pragma unroll
        for (int rg = 0; rg < 16; ++rg) { const int tau = 64 * ch + 32 * a + crow(rg, hh), t = dir ? L - 1 - tau : tau;
            Oo[(size_t)t * 512 + 32 * jv + r] = (bf16_t)(pkbf(oacc[rg], 0.f) & 0xffffu); }
#pragma unroll
        for (int ii = 0; ii < 2; ++ii)
#pragma unroll
            for (int q4 = 0; q4 < 4; ++q4) { u32x2 pk; pk.x = pkbf(Sa[ii][4 * q4], Sa[ii][4 * q4 + 1]); pk.y = pkbf(Sa[ii][4 * q4 + 2], Sa[ii][4 * q4 + 3]);
                *(LAS u32x2*)(lds + S_ST + (32 * jv + r) * 272 + 2 * (32 * (2 * a + ii) + 8 * q4 + 4 * hh)) = pk; }
    }
    if (!samp) {
        float* ns = A->out + (size_t)TT * DM + ((((size_t)seq * 2 + l) * 2 + dir) * 4 + head) * 16384;
#pragma unroll
        for (int ii = 0; ii < 2; ++ii)
#pragma unroll
            for (int rg = 0; rg < 16; ++rg) ns[(size_t)(32 * (2 * a + ii) + crow(rg, hh)) * 128 + 32 * jv + r] = Sa[ii][rg];
    }
    __syncthreads();
}

constexpr int H_CST = 4112, H_CP = 0, H_UP = 33024, H_UPBYTES = 61440, H_GST = H_UP + H_UPBYTES;
DI void hyena_item(KArgs A, int l, int cs, int c, bool zero_pads, lds_t* lds) {
    const int tid = threadIdx.x, lane = tid & 63, w = __builtin_amdgcn_readfirstlane(tid >> 6);
    const int L = cs ? 1024 : 256, NB = L >> 5, nseq = cs ? 8 : 16, m0 = cs ? TP : 0, SEQST = 3 * NB * 80;
    bf16_t* UT = (bf16_t*)(A->ws + WS_UT) + (size_t)c * TT + m0;
    const bf16_t* X2T = (const bf16_t*)(A->ws + WS_X2T) + (size_t)c * TT + m0;
    const bf16_t* GF = (const bf16_t*)(A->ws + WS_GF + (size_t)l * GF_LSTRIDE + (cs ? GF_SAMPLE_OFF : 0)) + (size_t)c * (2 * L);
    if (zero_pads) { for (int i = tid; i < H_UPBYTES / 16; i += 512) *(LAS u32x4*)(lds + H_UP + 16 * i) = (u32x4){0u, 0u, 0u, 0u}; __syncthreads(); }
    { const int nchunk = nseq * L / 8, cps = L / 8;
      for (int q = tid; q < nchunk; q += 512) { const int sq = q / cps, s = 8 * (q % cps); const u32x4 v = *(const u32x4*)(UT + (size_t)sq * L + s);
          *(LAS u32x4*)(lds + H_UP + sq * SEQST + (NB + (s >> 5)) * 80 + 2 * (s & 31)) = v; }
      for (int q = tid; q < 2 * L / 8; q += 512) *(LAS u32x4*)(lds + H_GST + 16 * q) = *(const u32x4*)(GF + 8 * q); }
    __syncthreads();
    for (int e = tid; e < 16 * L; e += 512) { const int m = e / (2 * L), p = e % (2 * L), idx = 2 * L + m - p;
        bf16_t v = 0; if (idx < 2 * L) v = *(const LAS bf16_t*)(lds + H_GST + 2 * idx);
        *(LAS bf16_t*)(lds + H_CP + m * H_CST + 2 * p) = v; }
    __syncthreads();
    const int r = lane & 31, hh = lane >> 5;
    const bool active = cs ? true : (w < 4);
    if (active) {
        const int sq = cs ? w : 4 * w + (r >> 3), ab = cs ? r : (r & 7);
        const lds_t* ub = lds + H_UP + sq * SEQST + (NB + ab) * 80 + 16 * hh;
        const lds_t* cb = lds + H_CP + (r & 7) * H_CST + 2 * (L - 8 * (r >> 3) + 8 * hh);
        f32x16 z;
#pragma unroll
        for (int rg = 0; rg < 16; ++rg) z[rg] = 0.f;
        for (int d = -(NB - 1); d <= NB - 1; ++d) {
#pragma unroll
            for (int ks = 0; ks < 2; ++ks) { const bf16x8 fa = *(const LAS bf16x8*)(cb - 64 * d + 32 * ks), fb = *(const LAS bf16x8*)(ub - 80 * d + 32 * ks); z = MFMA32(fa, fb, z); }
        }
        const float invn = 1.0f / (((const float*)(A->ws + WS_CTL))[CW_HYABS + (l * 2 + cs) * 512 + c] + EPS), dd = A->hy_d[l * 512 + c];
#pragma unroll
        for (int q4 = 0; q4 < 4; ++q4) { const int t0 = 32 * ab + 8 * q4 + 4 * hh;
            const u32x2 uu = *(const LAS u32x2*)(lds + H_UP + sq * SEQST + (NB + ab) * 80 + 2 * (8 * q4 + 4 * hh));
            const u32x2 x2 = *(const u32x2*)(X2T + (size_t)sq * L + t0);
            const float y0 = bflo(x2.x) * (invn * z[4 * q4 + 0] + dd * bflo(uu.x)), y1 = bfhi(x2.x) * (invn * z[4 * q4 + 1] + dd * bfhi(uu.x));
            const float y2 = bflo(x2.y) * (invn * z[4 * q4 + 2] + dd * bflo(uu.y)), y3 = bfhi(x2.y) * (invn * z[4 * q4 + 3] + dd * bfhi(uu.y));
            u32x2 o; o.x = pkbf(y0, y1); o.y = pkbf(y2, y3);
            *(u32x2*)(UT + (size_t)sq * L + t0) = o; }
    }
    __syncthreads();
}

DI void phase_mixer(KArgs A, int l, lds_t* lds) {
    unsigned* qhead = (unsigned*)(A->ws + WS_CTL) + CW_QUEUE + 64 * l;
    volatile LAS unsigned* bc = (volatile LAS unsigned*)(lds + MISC_OFF) + 16;
    int last_kind = -1;
    for (;;) {
        __syncthreads();
        if (threadIdx.x == 0) *bc = __hip_atomic_fetch_add(qhead, 1u, __ATOMIC_RELAXED, __HIP_MEMORY_SCOPE_AGENT);
        __syncthreads();
        const int it = (int)*bc;
        if (it >= 1216) break;
        if (it < 64) { scan_item(A, l, 16 + (it >> 3), (it >> 1) & 3, it & 1, lds); last_kind = -1; }
        else if (it < 576) { hyena_item(A, l, 1, it - 64, last_kind != 1, lds); last_kind = 1; }
        else if (it < 704) { const int i2 = it - 576; scan_item(A, l, i2 >> 3, (i2 >> 1) & 3, i2 & 1, lds); last_kind = -1; }
        else { hyena_item(A, l, 0, it - 704, last_kind != 0, lds); last_kind = 0; }
    }
}

DI void phase_merge(KArgs A, int l, lds_t* lds) {
    const int tid = threadIdx.x;
    const bf16_t* P = (const bf16_t*)(A->ws + WS_P);
    const bf16_t* OF = (const bf16_t*)(A->ws + WS_H); const bf16_t* OB = OF + (size_t)TT * 512;
    const bf16_t* YT = (const bf16_t*)(A->ws + WS_UT);
    bf16_t* MG = (bf16_t*)(A->ws + WS_MERGED);
    constexpr int RS = 1040;
    for (int un = blockIdx.x; un < TT / 32; un += gridDim.x) {
        const int m0 = 32 * un;
        { const bf16_t* yp = YT + (size_t)tid * TT + m0;
#pragma unroll
          for (int q = 0; q < 4; ++q) { const u32x4 v = *(const u32x4*)(yp + 8 * q);
              const unsigned vv[4] = {v.x, v.y, v.z, v.w};
#pragma unroll
              for (int e = 0; e < 4; ++e) { *(LAS bf16_t*)(lds + (8 * q + 2 * e) * RS + 2 * tid) = (bf16_t)(vv[e] & 0xffffu); *(LAS bf16_t*)(lds + (8 * q + 2 * e + 1) * RS + 2 * tid) = (bf16_t)(vv[e] >> 16); } } }
        const int j = tid >> 4, sub = tid & 15, m = m0 + j, cbase = 32 * sub;
        {
            float o[32]; float ss = 0.f;
#pragma unroll
            for (int q = 0; q < 4; ++q) { const u32x4 f = *(const u32x4*)(OF + (size_t)m * 512 + cbase + 8 * q), b = *(const u32x4*)(OB + (size_t)m * 512 + cbase + 8 * q);
                const unsigned ff[4] = {f.x, f.y, f.z, f.w}, bb[4] = {b.x, b.y, b.z, b.w};
#pragma unroll
                for (int e = 0; e < 4; ++e) { const float a0 = bflo(ff[e]) + bflo(bb[e]), a1 = bfhi(ff[e]) + bfhi(bb[e]); o[8 * q + 2 * e] = a0; o[8 * q + 2 * e + 1] = a1; ss += a0 * a0 + a1 * a1; } }
            ss += __shfl_xor(ss, 1); ss += __shfl_xor(ss, 2);
            const float rr = 1.0f / sqrtf(ss * (1.0f / 128.0f) + EPS);
#pragma unroll
            for (int q = 0; q < 4; ++q) { const u32x4 g = *(const u32x4*)(P + (size_t)m * NIN + 2048 + cbase + 8 * q); const unsigned gg[4] = {g.x, g.y, g.z, g.w};
                const f32x4 w0 = *(const f32x4*)(A->hg_norm_w + l * 512 + cbase + 8 * q), w1 = *(const f32x4*)(A->hg_norm_w + l * 512 + cbase + 8 * q + 4);
                const float ww[8] = {w0.x, w0.y, w0.z, w0.w, w1.x, w1.y, w1.z, w1.w};
                unsigned pk[4];
#pragma unroll
                for (int e = 0; e < 4; ++e) pk[e] = pkbf(o[8 * q + 2 * e] * rr * ww[2 * e] * bflo(gg[e]), o[8 * q + 2 * e + 1] * rr * ww[2 * e + 1] * bfhi(gg[e]));
                *(u32x4*)(MG + (size_t)m * DM + cbase + 8 * q) = (u32x4){pk[0], pk[1], pk[2], pk[3]}; }
        }
        __syncthreads();
        {
            float y[32]; float ss = 0.f;
#pragma unroll
            for (int q = 0; q < 4; ++q) { const u32x4 v = *(const LAS u32x4*)(lds + j * RS + 2 * (cbase + 8 * q)); const unsigned vv[4] = {v.x, v.y, v.z, v.w};
#pragma unroll
                for (int e = 0; e < 4; ++e) { const float a0 = bflo(vv[e]), a1 = bfhi(vv[e]); y[8 * q + 2 * e] = a0; y[8 * q + 2 * e + 1] = a1; ss += a0 * a0 + a1 * a1; } }
            ss += __shfl_xor(ss, 1); ss += __shfl_xor(ss, 2); ss += __shfl_xor(ss, 4); ss += __shfl_xor(ss, 8);
            const float rr = 1.0f / sqrtf(ss * (1.0f / 512.0f) + EPS);
#pragma unroll
            for (int q = 0; q < 4; ++q) { const f32x4 w0 = *(const f32x4*)(A->hy_norm_w + l * 512 + cbase + 8 * q), w1 = *(const f32x4*)(A->hy_norm_w + l * 512 + cbase + 8 * q + 4);
                const float ww[8] = {w0.x, w0.y, w0.z, w0.w, w1.x, w1.y, w1.z, w1.w};
                unsigned pk[4];
#pragma unroll
                for (int e = 0; e < 4; ++e) pk[e] = pkbf(y[8 * q + 2 * e] * rr * ww[2 * e], y[8 * q + 2 * e + 1] * rr * ww[2 * e + 1]);
                *(u32x4*)(MG + (size_t)m * DM + 512 + cbase + 8 * q) = (u32x4){pk[0], pk[1], pk[2], pk[3]}; }
        }
        __syncthreads();
    }
}

__global__ void __launch_bounds__(512, 2) mk_fwd(Args KP) {
    extern __shared__ __attribute__((aligned(16))) unsigned char lds_raw[];
    lds_t* lds = (lds_t*)lds_raw;
    const int tid = threadIdx.x;
    volatile LAS unsigned* MISC = (volatile LAS unsigned*)(lds + MISC_OFF);
    if (tid < 64) MISC[tid] = 0u;
    __syncthreads();
    if (MK_N_LAUNCHES == 1) (void)xcd_barrier_post((unsigned*)(KP.ws + WS_CTL) + CW_BAR, MISC + 8);
    const int lo = KP.ph_lo, hi = KP.ph_hi;
#define IN(k) (lo <= (k) && (k) < hi)
#define SEAM(k) do { if (IN(k) && IN((k) + 1)) { KArgs A_ = kargs(); XcdBarrier b_; b_.bar = (unsigned*)(A_->ws + WS_CTL) + CW_BAR; b_.x = xb_xcc_id(); b_.st = (volatile LAS unsigned*)(lds + MISC_OFF) + 8; xcd_barrier(b_); } } while (0)
#define MODP(A) ((const float*)((A)->ws + WS_CTL) + CW_MOD)
#define HP(A) ((bf16_t*)((A)->ws + WS_H))

    if (IN(0)) { KArgs A = kargs(); phase_p0a(A, lds); } SEAM(0);
    if (IN(1)) { KArgs A = kargs(); phase_p0b(A, lds); } SEAM(1);
#define LAYER_BODY(l) do { \
        const int pb = 2 + 7 * l; \
        if (IN(pb + 0)) { \
            KArgs A = kargs(); \
            pg8::Gemm g{HP(A), (const bf16_t*)(A->ws + WS_WIN) + (size_t)l * NIN * DM, TT, NIN, DM}; pg8::StaticOrder S; S.init(TT, NIN, gridDim.x, blockIdx.x); \
            pg8::EpiProj E{(bf16_t*)(A->ws + WS_P), (const float*)(A->ws + WS_LBT) + l * 1024, (const float*)(A->ws + WS_RSP), (const float*)(A->ws + WS_BIAS) + (size_t)l * 9 * NIN, (LAS float*)(lds + XCH_OFF + 8192)}; \
            pg8::gemm_phase<pg8::EpiProj, pg8::StaticOrder, true, true>(lds, g, S, E); \
        } SEAM(pb + 0); \
        if (IN(pb + 1)) { KArgs A = kargs(); phase_hyprep(A, l, lds); } SEAM(pb + 1); \
        if (IN(pb + 2)) { KArgs A = kargs(); phase_mixer(A, l, lds); } SEAM(pb + 2); \
        if (IN(pb + 3)) { KArgs A = kargs(); phase_merge(A, l, lds); } SEAM(pb + 3); \
        if (IN(pb + 4)) { \
            KArgs A = kargs(); float* XA = A->out; \
            pg8::Gemm g{(const bf16_t*)(A->ws + WS_MERGED), (const bf16_t*)(A->ws + WS_WOUT) + (size_t)l * DM * DM, TT, DM, DM}; pg8::StaticOrder S; S.init(TT, DM, gridDim.x, blockIdx.x); \
            pg8::EpiResid E{l == 0 ? A->x_prompt : XA, l == 0 ? A->x_sample : XA + (size_t)TP * DM, XA, MODP(A) + (size_t)l * 9 * NMOD + 2048, \
                            HP(A), A->norm2_w + l * DM, MODP(A) + (size_t)l * 9 * NMOD + 4096, (float*)(A->ws + WS_RSP)}; \
            pg8::gemm_phase<pg8::EpiResid, pg8::StaticOrder, true, true>(lds, g, S, E); \
        } SEAM(pb + 4); \
        if (IN(pb + 5)) { \
            KArgs A = kargs(); \
            pg8::Gemm g{HP(A), (const bf16_t*)(A->ws + WS_WUP) + (size_t)l * NUP * DM, TT, NUP, DM}; pg8::StaticOrder S; S.init(TT, NUP, gridDim.x, blockIdx.x); \
            pg8::EpiFfn E{(bf16_t*)(A->ws + WS_P), A->ffn_conv_w + (size_t)l * 3 * NUP, (LAS float*)(lds + XCH_OFF), (const float*)(A->ws + WS_RSP), (const float*)(A->ws + WS_BIAS + BIAS2_OFF) + (size_t)l * 9 * NUP, (LAS float*)(lds + XCH_OFF + 8192)}; \
            pg8::gemm_phase<pg8::EpiFfn, pg8::StaticOrder, true, true>(lds, g, S, E); \
        } SEAM(pb + 5); \
        if (IN(pb + 6)) { \
            KArgs A = kargs(); float* XA = A->out; \
            pg8::Gemm g{(const bf16_t*)(A->ws + WS_P), (const bf16_t*)(A->ws + WS_WDN) + (size_t)l * DM * DFF, TT, DM, DFF}; pg8::StaticOrder S; S.init(TT, DM, gridDim.x, blockIdx.x); \
            pg8::EpiResid E{XA, XA + (size_t)TP * DM, XA, MODP(A) + (size_t)l * 9 * NMOD + 5120, \
                            l == 0 ? HP(A) : (bf16_t*)nullptr, A->norm1_w + DM, MODP(A) + (size_t)9 * NMOD + 1024, (float*)(A->ws + WS_RSP)}; \
            pg8::gemm_phase<pg8::EpiResid, pg8::StaticOrder, true, true>(lds, g, S, E); \
        } SEAM(pb + 6); \
    } while (0)
    LAYER_BODY(0);
    LAYER_BODY(1);
#undef LAYER_BODY
    if (IN(16)) { KArgs A = kargs(); phase_final_norm(A); }
#undef IN
#undef SEAM
}

extern "C" void kernel_launch(void* const* d_in, const int* in_sizes, int n_in, void* d_out, int out_size, void* d_ws, size_t ws_size, hipStream_t stream) {
    static int grid = 0;
    if (grid == 0) {
        if (n_in != 28 || ws_size < WS_END) { fprintf(stderr, "kernel_launch: unexpected inputs (n_in %d, ws %zu)\n", n_in, ws_size); grid = -1; return; }
        int dev = 0, cus = 0;
        if (hipGetDevice(&dev) != hipSuccess || hipDeviceGetAttribute(&cus, hipDeviceAttributeMultiprocessorCount, dev) != hipSuccess) { grid = -1; return; }
        if (hipFuncSetAttribute((const void*)mk_fwd, hipFuncAttributeMaxDynamicSharedMemorySize, LDS_BYTES) != hipSuccess) { fprintf(stderr, "kernel_launch: hipFuncSetAttribute failed\n"); grid = -1; return; }
        int per_cu = 0;
        if (hipOccupancyMaxActiveBlocksPerMultiprocessor(&per_cu, (const void*)mk_fwd, 512, LDS_BYTES) != hipSuccess || per_cu < 1) fprintf(stderr, "kernel_launch: occupancy query reports %d\n", per_cu);
        (void)hipGetLastError();
        grid = cus;
    }
    if (grid < 0) return;
    (void)hipMemsetAsync((char*)d_ws + WS_CTL, 0, CTL_BYTES, stream);
    Args a{};
    const float** ap = (const float**)&a;
    for (int i = 0; i < 28; ++i) ap[i] = (const float*)d_in[i];
    a.out = (float*)d_out; a.ws = (unsigned char*)d_ws;
    if (MK_N_LAUNCHES == 1) { a.ph_lo = 0; a.ph_hi = NPH; hipLaunchKernelGGL(mk_fwd, dim3(grid), dim3(512), LDS_BYTES, stream, a); }
    else { for (int p = 0; p < NPH; ++p) { a.ph_lo = p; a.ph_hi = p + 1; hipLaunchKernelGGL(mk_fwd, dim3(grid), dim3(512), LDS_BYTES, stream, a); } }
}
```

```cpp
#include <hip/hip_runtime.h>
#include <cstdio>
#include <cstdint>

#define DI __device__ __forceinline__
#define LAS __attribute__((address_space(3)))
#define GAS __attribute__((address_space(1)))
typedef unsigned short bf16_t;
typedef short bf16x8 __attribute__((ext_vector_type(8)));
typedef float f32x4 __attribute__((ext_vector_type(4)));
typedef float f32x16 __attribute__((ext_vector_type(16)));
typedef unsigned u32x4 __attribute__((ext_vector_type(4)));
typedef unsigned u32x2 __attribute__((ext_vector_type(2)));
typedef float f32x2_t __attribute__((ext_vector_type(2)));
typedef __bf16 bf16x2_t __attribute__((ext_vector_type(2)));
typedef LAS unsigned char lds_t;

#ifndef PROBE_PH
#define PROBE_PH (-1)
#endif
#ifndef MK_N_LAUNCHES
#define MK_N_LAUNCHES 1
#endif

constexpr int DM = 1024, TP = 4096, TS = 8192, TT = 12288, NIN = 4096, DFF = 2816, NUP = 5632, NMOD = 6144;
constexpr int NPH = 17;
constexpr float EPS = 1e-6f;

constexpr size_t MiB = 1u << 20;
constexpr size_t WS_CTL = 0, CTL_BYTES = 1 * MiB;
constexpr size_t WS_LBT = 1 * MiB;
constexpr size_t WS_BIAS = 1 * MiB + 64 * 1024;
constexpr size_t BIAS2_OFF = 2 * 9 * 4096 * 4;
constexpr size_t WS_RSP = 2 * MiB;
constexpr size_t WS_GF = 3 * MiB;
constexpr size_t GF_LSTRIDE = 2560 * 1024, GF_SAMPLE_OFF = 512 * 1024;
constexpr size_t WS_WIN = 10 * MiB, WS_WOUT = 26 * MiB, WS_WUP = 30 * MiB, WS_WDN = 52 * MiB;
constexpr size_t WS_H = 64 * MiB;
constexpr size_t WS_MERGED = 88 * MiB;
constexpr size_t WS_P = 112 * MiB;
constexpr size_t WS_UT = 208 * MiB, WS_X2T = 220 * MiB;
constexpr size_t WS_END = 232 * MiB;
constexpr int CW_BAR = 4096;
constexpr int CW_QUEUE = 8192;
constexpr int CW_HYABS = 9216;
constexpr int CW_MOD = 16384;
static_assert((CW_MOD + 2 * 9 * NMOD) * 4 <= (int)CTL_BYTES, "ctl");

constexpr int LDS_BYTES = 163840;
constexpr int RING_BYTES = 131072;
constexpr int XCH_OFF = 131072;
constexpr int MISC_OFF = 163840 - 256;

DI unsigned pkbf(float lo, float hi) { f32x2_t v = {lo, hi}; bf16x2_t b = __builtin_convertvector(v, bf16x2_t); return __builtin_bit_cast(unsigned, b); }
DI float bflo(unsigned u) { return __uint_as_float(u << 16); }
DI float bfhi(unsigned u) { return __uint_as_float(u & 0xffff0000u); }
DI float bf1(bf16_t h) { return __uint_as_float(((unsigned)h) << 16); }
DI float silu_f(float x) { return x * __builtin_amdgcn_rcpf(1.0f + __expf(-x)); }
DI float wave_sum(float v) {
#pragma unroll
    for (int o = 1; o < 64; o <<= 1) v += __shfl_xor(v, o);
    return v;
}
DI int ltid() { int t = threadIdx.x; asm volatile("" : "+v"(t)); return t; }
DI int crow(int reg, int hh) { return (reg & 3) + 8 * (reg >> 2) + 4 * hh; }
DI int cid_of_tile(int pm) { return pm < 16 ? 0 : 1 + ((pm - 16) >> 2); }
DI int cid_of_row(int m) { return m < TP ? 0 : 1 + ((m - TP) >> 10); }
#define MFMA32(a, b, c) __builtin_amdgcn_mfma_f32_32x32x16_bf16((a), (b), (c), 0, 0, 0)
#define LDS_WAIT() asm volatile("s_waitcnt lgkmcnt(0)" ::: "memory")
#define VM_WAIT() asm volatile("s_waitcnt vmcnt(0)" ::: "memory")

namespace pg8 {
#define PG8_LAS __attribute__((address_space(3)))
constexpr int BM = 256, BK = 64, HALF = 128, HTB = HALF * BK * 2, STAGE_BYTES = 8 * HTB, NXCD = 8, WGM = 8;
__host__ __device__ __forceinline__ int lds_byte(int r, int c) { const int st = (r >> 4) * 2 + (c >> 5), rr = r & 15, cc = c & 31, ob = rr * 64 + cc * 2; return st * 1024 + (ob ^ (((ob >> 9) & 1) << 5)); }
__host__ __device__ __forceinline__ void stage_rc(int b, int& R, int& C) { const int st = b / 1024, sb = b % 1024, swz = sb ^ (((sb >> 9) & 1) << 5); R = (st >> 1) * 16 + swz / 64; C = (st & 1) * 32 + (swz % 64) / 2; }
__host__ __device__ __forceinline__ int perm32(int rho) { const int n = rho >> 4, i = rho & 15; return 8 * (i >> 2) + 4 * n + (i & 3); }
struct Unit { int pm, pn; };
struct Gemm { const bf16_t* A; const bf16_t* Bt; int M, N, K; };
struct StaticOrder {
    int nM, nN, nwg, G, c;
    __host__ __device__ void init(int M, int N, int G_, int c_) { nM = M / BM; nN = N / BM; nwg = nM * nN; G = G_; c = c_; }
    __host__ __device__ bool next(int i, Unit& u) const {
        const long L = (long)i * G + c; if (L >= nwg) return false;
        int wgid = (int)L; { const int q = nwg / NXCD, r = nwg % NXCD, xcd = wgid % NXCD, off = wgid / NXCD; wgid = (xcd < r ? xcd * (q + 1) : r * (q + 1) + (xcd - r) * q) + off; }
        const int nig = WGM * nN, gid = wgid / nig, fm = gid * WGM, gsz = (nM - fm) < WGM ? (nM - fm) : WGM;
        u.pm = fm + ((wgid % nig) % gsz); u.pn = (wgid % nig) / gsz; return true;
    }
    __device__ __forceinline__ void a_ready(const Unit&) const {}
    __device__ __forceinline__ void done(const Unit&) const {}
};


struct RNext { f32x4 a; };
__device__ __forceinline__ void rnext_load(RNext& q, const float* rsp, int pm, int tid, bool on) {
    q.a = (f32x4){0.f, 0.f, 0.f, 0.f};
    if (on) q.a = *(const f32x4*)(rsp + (size_t)(pm * BM + (tid & 255)) * 4);
}
__device__ __forceinline__ void rnext_store(const RNext& q, PG8_LAS float* R, int par, int tid, bool on) {
    if (on) { const float sm = (q.a.x + q.a.y) + (q.a.z + q.a.w); R[par * 256 + (tid & 255)] = 1.0f / sqrtf(sm * (1.0f / 1024.0f) + 1e-6f); }
}
struct EpiProj {
    static constexpr bool PERM = true, AFTER_DRAIN = false;
    bf16_t* P; const float* lbt; const float* rsp; const float* bias; PG8_LAS float* R;
    __device__ __forceinline__ void first(const Unit& u) const { const int tid = threadIdx.x; RNext q; rnext_load(q, rsp, u.pm, tid, tid < 256); rnext_store(q, R, 0, tid, tid < 256); }
    __device__ __forceinline__ void operator()(f32x4 (&acc)[2][2][4][2], const Unit& u, int wr, int wc, int fr, int fq, const Unit& nx, bool has_next, int ui) const {
        const int tid = (wr * 4 + wc) * 64 + fq * 16 + fr; const bool pre = has_next && wr == 0;
        RNext rq; rnext_load(rq, rsp, nx.pm, tid, pre);
        PG8_LAS const float* Rc = R + (ui & 1) * 256;
        const int row0 = u.pm * BM + wr * 64 + fr, typ = u.pn >> 1, col0 = u.pn * BM + wc * 32 + 8 * fq;
        const float* bp = bias + cid_of_tile(u.pm) * NIN + col0;
        float rr[2][4];
#pragma unroll
        for (int ai = 0; ai < 2; ++ai)
#pragma unroll
            for (int m = 0; m < 4; ++m) rr[ai][m] = Rc[ai * HALF + wr * 64 + m * 16 + fr];
#pragma unroll
        for (int bj = 0; bj < 2; ++bj) {
            float lb[8], bs[8];
            { const f32x4 b0 = *(const f32x4*)(bp + bj * HALF), b1 = *(const f32x4*)(bp + bj * HALF + 4); bs[0] = b0.x; bs[1] = b0.y; bs[2] = b0.z; bs[3] = b0.w; bs[4] = b1.x; bs[5] = b1.y; bs[6] = b1.z; bs[7] = b1.w; }
#pragma unroll
            for (int i = 0; i < 8; ++i) lb[i] = 0.f;
            if (typ == 1 || typ == 2) {
                const float* lp = lbt + (typ - 1) * 512 + (col0 + bj * HALF - 512 * typ);
#pragma unroll
                for (int i = 0; i < 8; ++i) lb[i] = lp[i];
            }
#pragma unroll
            for (int ai = 0; ai < 2; ++ai)
#pragma unroll
                for (int m = 0; m < 4; ++m) {
                    float x[8];
#pragma unroll
                    for (int n = 0; n < 2; ++n)
#pragma unroll
                        for (int e = 0; e < 4; ++e) x[4 * n + e] = acc[ai][bj][m][n][e] * rr[ai][m] + bs[4 * n + e];
                    if (typ == 0) {
#pragma unroll
                        for (int i = 0; i < 8; ++i) x[i] = silu_f(x[i]) * 0.08838834764831845f;
                    } else if (typ == 1 || typ == 2) {
#pragma unroll
                        for (int i = 0; i < 8; ++i) { const float sg = __builtin_amdgcn_rcpf(1.0f + __expf(-x[i])); x[i] = __logf(lb[i] + (1.0f - lb[i]) * sg); }
                    } else if (typ == 4) {
#pragma unroll
                        for (int i = 0; i < 8; ++i) x[i] = silu_f(x[i]);
                    }
                    u32x4 w; w.x = pkbf(x[0], x[1]); w.y = pkbf(x[2], x[3]); w.z = pkbf(x[4], x[5]); w.w = pkbf(x[6], x[7]);
                    *(u32x4*)(P + (size_t)(row0 + ai * HALF + m * 16) * NIN + col0 + bj * HALF) = w;
                }
        }
        rnext_store(rq, R, (ui + 1) & 1, tid, pre);
    }
};

struct EpiResid {
    static constexpr bool PERM = false, AFTER_DRAIN = false;
    const float* bp; const float* bs; float* out; const float* gate;
    bf16_t* Hn; const float* nw; const float* sc; float* rsp; PG8_LAS float* PS;
    __device__ __forceinline__ void first(const Unit&) const {}
    __device__ __forceinline__ void operator()(f32x4 (&acc)[2][2][4][2], const Unit& u, int wr, int wc, int fr, int fq, const Unit&, bool, int) const {
        const int row0 = u.pm * BM + wr * 64 + fr, col0 = u.pn * BM + wc * 32 + 4 * fq, cid = cid_of_tile(u.pm);
        const float* base = (u.pm < 16) ? bp : (bs - (size_t)TP * DM);
        f32x4 gv[2][2], cv[2][2];
#pragma unroll
        for (int bj = 0; bj < 2; ++bj)
#pragma unroll
            for (int n = 0; n < 2; ++n) { gv[bj][n] = *(const f32x4*)(gate + cid * NMOD + col0 + bj * HALF + n * 16);
                cv[bj][n] = (f32x4){0.f, 0.f, 0.f, 0.f};
                if (Hn) cv[bj][n] = *(const f32x4*)(nw + col0 + bj * HALF + n * 16) * (1.0f + *(const f32x4*)(sc + cid * NMOD + col0 + bj * HALF + n * 16)); }
#pragma unroll
        for (int ai = 0; ai < 2; ++ai)
#pragma unroll
            for (int m = 0; m < 4; ++m) { const int row = row0 + ai * HALF + m * 16; const size_t off = (size_t)row * DM + col0; float ps = 0.f;
#pragma unroll
                for (int bj = 0; bj < 2; ++bj)
#pragma unroll
                    for (int n = 0; n < 2; ++n) { const f32x4 b = *(const f32x4*)(base + off + bj * HALF + n * 16); const f32x4 o = b + gv[bj][n] * acc[ai][bj][m][n]; *(f32x4*)(out + off + bj * HALF + n * 16) = o;
                        if (Hn) { ps += (o.x * o.x + o.y * o.y) + (o.z * o.z + o.w * o.w); const f32x4 a = o * cv[bj][n]; u32x2 pk; pk.x = pkbf(a.x, a.y); pk.y = pkbf(a.z, a.w); *(u32x2*)(Hn + off + bj * HALF + n * 16) = pk; } }
                if (Hn) { ps += __shfl_xor(ps, 16); ps += __shfl_xor(ps, 32); if (fq == 0) PS[wc * 256 + ai * HALF + wr * 64 + m * 16 + fr] = ps; } }
        if (Hn) {
            asm volatile("s_waitcnt lgkmcnt(0)" ::: "memory"); __builtin_amdgcn_s_barrier(); asm volatile("" ::: "memory");
            const int tid = (wr * 4 + wc) * 64 + fq * 16 + fr;
            if (tid < 256) rsp[(size_t)(u.pm * BM + tid) * 4 + u.pn] = (PS[tid] + PS[256 + tid]) + (PS[512 + tid] + PS[768 + tid]);
        }
    }
};

struct EpiFfn {
    static constexpr bool PERM = true, AFTER_DRAIN = false;
    bf16_t* ACT; const float* cw; PG8_LAS float* X; const float* rsp; const float* bias; PG8_LAS float* R;
    __device__ __forceinline__ void first(const Unit& u) const { const int tid = threadIdx.x; RNext q; rnext_load(q, rsp, u.pm, tid, tid < 256); rnext_store(q, R, 0, tid, tid < 256); }
    __device__ __forceinline__ void operator()(f32x4 (&acc)[2][2][4][2], const Unit& u, int wr, int wc, int fr, int fq, const Unit& nx, bool has_next, int ui) const {
        const bool prompt = u.pm < 16;
        const int lane = fq * 16 + fr;
        const int cc0 = wc * 32 + 8 * fq, fbase = u.pn * HALF + cc0;
        const int tid = (wr * 4 + wc) * 64 + lane; const bool pre = has_next && wr == 0;
        RNext rq; rnext_load(rq, rsp, nx.pm, tid, pre);
        PG8_LAS const float* Rc = R + (ui & 1) * 256;
        {
            const float* bp = bias + cid_of_tile(u.pm) * NUP + u.pn * BM + cc0;
#pragma unroll
            for (int bj = 0; bj < 2; ++bj)
#pragma unroll
                for (int n = 0; n < 2; ++n) { const f32x4 bv = *(const f32x4*)(bp + bj * HALF + 4 * n);
#pragma unroll
                    for (int ai = 0; ai < 2; ++ai)
#pragma unroll
                        for (int m = 0; m < 4; ++m) acc[ai][bj][m][n] = acc[ai][bj][m][n] * Rc[ai * HALF + wr * 64 + m * 16 + fr] + bv; }
        }
        const int src_prev = (lane & 48) | ((fr + 15) & 15), src_next = (lane & 48) | ((fr + 1) & 15);
        if (prompt) {
#pragma unroll
            for (int ai = 0; ai < 2; ++ai) { const int slab = 2 * ai + wr;
#pragma unroll
                for (int bj = 0; bj < 2; ++bj)
#pragma unroll
                    for (int n = 0; n < 2; ++n) {
                        if (fr == 0) *(PG8_LAS f32x4*)(X + (slab * 2 + 0) * 256 + bj * HALF + cc0 + 4 * n) = acc[ai][bj][0][n];
                        if (fr == 15) *(PG8_LAS f32x4*)(X + (slab * 2 + 1) * 256 + bj * HALF + cc0 + 4 * n) = acc[ai][bj][3][n];
                    } }
            asm volatile("s_waitcnt lgkmcnt(0)" ::: "memory"); __builtin_amdgcn_s_barrier(); asm volatile("" ::: "memory");
        }
#pragma unroll
        for (int n = 0; n < 2; ++n) {
            f32x4 wg[3], wv[3];
#pragma unroll
            for (int j = 0; j < 3; ++j) { wg[j] = *(const f32x4*)(cw + j * NUP + fbase + 4 * n); wv[j] = *(const f32x4*)(cw + j * NUP + DFF + fbase + 4 * n); }
#pragma unroll
            for (int ai = 0; ai < 2; ++ai) {
                const int slab = 2 * ai + wr;
                f32x4 hp[2], hn[2];
#pragma unroll
                for (int bj = 0; bj < 2; ++bj) { hp[bj] = (f32x4){0.f, 0.f, 0.f, 0.f}; hn[bj] = (f32x4){0.f, 0.f, 0.f, 0.f}; }
                if (prompt) {
#pragma unroll
                    for (int bj = 0; bj < 2; ++bj) {
                        if (fr == 0 && slab > 0) hp[bj] = *(PG8_LAS f32x4*)(X + ((slab - 1) * 2 + 1) * 256 + bj * HALF + cc0 + 4 * n);
                        if (fr == 15 && slab < 3) hn[bj] = *(PG8_LAS f32x4*)(X + ((slab + 1) * 2 + 0) * 256 + bj * HALF + cc0 + 4 * n);
                    }
                }
#pragma unroll
                for (int m = 0; m < 4; ++m) {
                    float cv[2][4];
#pragma unroll
                    for (int bj = 0; bj < 2; ++bj)
#pragma unroll
                        for (int e = 0; e < 4; ++e) {
                            const float c = acc[ai][bj][m][n][e];
                            const float r1 = __shfl(c, src_prev), r15 = __shfl(c, src_next);
                            float pm1, pn1;
                            if (m > 0) pm1 = __shfl(acc[ai][bj][m > 0 ? m - 1 : 0][n][e], src_prev); else pm1 = hp[bj][e];
                            if (m < 3) pn1 = __shfl(acc[ai][bj][m < 3 ? m + 1 : 3][n][e], src_next); else pn1 = hn[bj][e];
                            const float p = (fr == 0) ? pm1 : r1, nx = (fr == 15) ? pn1 : r15;
                            const float w0 = bj ? wv[0][e] : wg[0][e], w1 = bj ? wv[1][e] : wg[1][e], w2 = bj ? wv[2][e] : wg[2][e];
                            cv[bj][e] = w0 * p + w1 * c + w2 * nx;
                        }
                    u32x2 w; w.x = pkbf(silu_f(cv[0][0]) * cv[1][0], silu_f(cv[0][1]) * cv[1][1]); w.y = pkbf(silu_f(cv[0][2]) * cv[1][2], silu_f(cv[0][3]) * cv[1][3]);
                    *(u32x2*)(ACT + (size_t)(u.pm * BM + ai * HALF + wr * 64 + m * 16 + fr) * DFF + fbase + 4 * n) = w;
                }
            }
        }
        rnext_store(rq, R, (ui + 1) & 1, tid, pre);
    }
};

template <class Epi, class Sched, bool ALIGN_EPI = false, bool SP2 = false>
__device__ __forceinline__ void gemm_phase(PG8_LAS unsigned char* lds, const Gemm g, const Sched& S, const Epi& E) {
    const int tid = threadIdx.x, wid = __builtin_amdgcn_readfirstlane(tid >> 6), lane = tid & 63, wr = wid >> 2, wc = wid & 3, fr = lane & 15, fq = lane >> 4;
    const int K = g.K, nt = K / BK;
    unsigned voffA[2], voffB[2];
#pragma unroll
    for (int i = 0; i < 2; ++i) { int R, C; stage_rc(tid * 16 + i * 8192, R, C); const int Rb = Epi::PERM ? ((R & ~31) + perm32(R & 31)) : R;
        voffA[i] = (unsigned)(R * K + C) * 2u; voffB[i] = (unsigned)(Rb * K + C) * 2u; }
    const size_t kstep = (size_t)(BK * 2);
    const size_t hstep = (size_t)HALF * K * 2;
    const size_t tstep = 2 * hstep;
    const unsigned ldsw = (unsigned)wid * 1024u;
    const int aoff = lds_byte(wr * 64 + fr, fq * 8), boff = lds_byte(wc * 32 + fr, fq * 8);
#define PG8_SA(b, h) (((b) * 2 + (h)) * HTB)
#define PG8_SB(b, h) ((4 + (b) * 2 + (h)) * HTB)
#define PG8_STAGE(bufoff, gbase, voff) do { _Pragma("unroll") for (int _i = 0; _i < 2; ++_i) \
        __builtin_amdgcn_global_load_lds((const unsigned*)((const char*)(gbase) + (voff)[_i]), (PG8_LAS unsigned*)(lds + (bufoff) + ldsw + _i * 8192), 16, 0, 0); } while (0)
#define PG8_LDA(dst, b, h) do { _Pragma("unroll") for (int m = 0; m < 4; ++m) _Pragma("unroll") for (int k = 0; k < 2; ++k) dst[m][k] = *(const PG8_LAS bf16x8*)(lds + PG8_SA(b, h) + aoff + m * 2048 + k * 1024); } while (0)
#define PG8_LDB(dst, b, h) do { _Pragma("unroll") for (int n = 0; n < 2; ++n) _Pragma("unroll") for (int k = 0; k < 2; ++k) dst[n][k] = *(const PG8_LAS bf16x8*)(lds + PG8_SB(b, h) + boff + n * 2048 + k * 1024); } while (0)
#define PG8_MMA(ai, bj, At, Bt) do { __builtin_amdgcn_s_setprio(1); _Pragma("unroll") for (int m = 0; m < 4; ++m) _Pragma("unroll") for (int n = 0; n < 2; ++n) _Pragma("unroll") for (int k = 0; k < 2; ++k) \
        acc[ai][bj][m][n] = __builtin_amdgcn_mfma_f32_16x16x32_bf16(Bt[n][k], At[m][k], acc[ai][bj][m][n], 0, 0, 0); __builtin_amdgcn_s_setprio(0); } while (0)
#define PG8_WAIT_V(n) asm volatile("s_waitcnt vmcnt(" #n ")" ::: "memory")
#define PG8_WAIT_L(n) asm volatile("s_waitcnt lgkmcnt(" #n ")" ::: "memory")
#define PG8_BAR __builtin_amdgcn_s_barrier()
#define PG8_SCHED __builtin_amdgcn_sched_barrier(0)
    Unit cur, nxt; int ui = 0;
    if (!S.next(0, cur)) return;
    f32x4 acc[2][2][4][2];
#pragma unroll
    for (int a = 0; a < 2; ++a)
#pragma unroll
        for (int b = 0; b < 2; ++b)
#pragma unroll
            for (int m = 0; m < 4; ++m)
#pragma unroll
                for (int n = 0; n < 2; ++n) acc[a][b][m][n] = (f32x4){0.f, 0.f, 0.f, 0.f};
    bf16x8 At[4][2], B0[2][2], B1[2][2];
    const char* cA = (const char*)g.A + (size_t)cur.pm * tstep; const char* cB = (const char*)g.Bt + (size_t)cur.pn * tstep;
    S.a_ready(cur);
    E.first(cur);
    if constexpr (SP2) {
        PG8_STAGE(PG8_SB(0, 0), cB, voffB); PG8_STAGE(PG8_SB(0, 1), cB + hstep, voffB); PG8_STAGE(PG8_SA(0, 0), cA, voffA); PG8_STAGE(PG8_SA(0, 1), cA + hstep, voffA);
        if (wr == 1) PG8_BAR;
        PG8_WAIT_V(2); PG8_BAR;
        PG8_STAGE(PG8_SB(1, 0), cB + kstep, voffB); PG8_STAGE(PG8_SA(1, 0), cA + kstep, voffA); PG8_STAGE(PG8_SB(1, 1), cB + hstep + kstep, voffB);
        PG8_WAIT_V(6); PG8_BAR;
    } else {
        PG8_STAGE(PG8_SB(0, 0), cB, voffB); PG8_STAGE(PG8_SA(0, 0), cA, voffA); PG8_STAGE(PG8_SB(0, 1), cB + hstep, voffB); PG8_STAGE(PG8_SA(0, 1), cA + hstep, voffA);
        if (wr == 1) PG8_BAR;
        PG8_WAIT_V(4); PG8_BAR;
        PG8_STAGE(PG8_SB(1, 0), cB + kstep, voffB); PG8_STAGE(PG8_SA(1, 0), cA + kstep, voffA); PG8_STAGE(PG8_SB(1, 1), cB + hstep + kstep, voffB);
        PG8_WAIT_V(6); PG8_BAR;
    }
    for (;;) {
        const bool has_next = S.next(ui + 1, nxt);
        const char* nA = has_next ? (const char*)g.A + (size_t)nxt.pm * tstep : cA; const char* nB = has_next ? (const char*)g.Bt + (size_t)nxt.pn * tstep : cB;
        for (int t = 0; t < nt; t += 2) {
            const bool last = (t == nt - 2);
            const char* a1 = cA + (size_t)(t + 1) * kstep;
            const char* a2 = last ? nA : cA + (size_t)(t + 2) * kstep; const char* b2 = last ? nB : cB + (size_t)(t + 2) * kstep;
            const char* a3 = a2 + kstep; const char* b3 = b2 + kstep;
            if (last && has_next) S.a_ready(nxt);
            if constexpr (SP2) {
            PG8_LDB(B0, 0, 0); PG8_LDB(B1, 0, 1); PG8_SCHED; PG8_LDA(At, 0, 0); PG8_STAGE(PG8_SA(1, 1), a1 + hstep, voffA);
            PG8_WAIT_V(8); PG8_WAIT_L(0); PG8_BAR; PG8_MMA(0, 0, At, B0); PG8_MMA(0, 1, At, B1); PG8_BAR; PG8_SCHED;
            PG8_LDA(At, 0, 1); PG8_STAGE(PG8_SB(0, 0), b2, voffB); PG8_STAGE(PG8_SB(0, 1), b2 + hstep, voffB); PG8_STAGE(PG8_SA(0, 0), a2, voffA);
            PG8_WAIT_V(8); PG8_WAIT_L(0); PG8_BAR; PG8_MMA(1, 0, At, B0); PG8_MMA(1, 1, At, B1); PG8_BAR; PG8_SCHED;
            PG8_LDB(B0, 1, 0); PG8_LDB(B1, 1, 1); PG8_SCHED; PG8_LDA(At, 1, 0); PG8_STAGE(PG8_SA(0, 1), a2 + hstep, voffA);
            PG8_WAIT_V(8); PG8_WAIT_L(0); PG8_BAR; PG8_MMA(0, 0, At, B0); PG8_MMA(0, 1, At, B1); PG8_BAR; PG8_SCHED;
            PG8_LDA(At, 1, 1); PG8_STAGE(PG8_SB(1, 0), b3, voffB); PG8_STAGE(PG8_SB(1, 1), b3 + hstep, voffB); PG8_STAGE(PG8_SA(1, 0), a3, voffA);
            PG8_WAIT_V(8); PG8_WAIT_L(0); PG8_BAR; PG8_MMA(1, 0, At, B0); PG8_MMA(1, 1, At, B1); PG8_BAR; PG8_SCHED;
            } else {
            PG8_LDB(B0, 0, 0); PG8_SCHED; PG8_LDA(At, 0, 0); PG8_STAGE(PG8_SA(1, 1), a1 + hstep, voffA);
            PG8_WAIT_L(8); PG8_BAR; PG8_WAIT_L(0); PG8_MMA(0, 0, At, B0); PG8_BAR; PG8_SCHED;
            PG8_LDB(B1, 0, 1); PG8_STAGE(PG8_SB(0, 0), b2, voffB);
            PG8_BAR; PG8_WAIT_L(0); PG8_MMA(0, 1, At, B1); PG8_BAR;
            PG8_LDA(At, 0, 1); PG8_STAGE(PG8_SA(0, 0), a2, voffA);
            PG8_BAR; PG8_WAIT_L(0); PG8_MMA(1, 0, At, B0); PG8_BAR; PG8_SCHED;
            PG8_STAGE(PG8_SB(0, 1), b2 + hstep, voffB);
            PG8_WAIT_V(6); PG8_BAR; PG8_MMA(1, 1, At, B1); PG8_BAR;
            PG8_LDB(B0, 1, 0); PG8_SCHED; PG8_LDA(At, 1, 0); PG8_STAGE(PG8_SA(0, 1), a2 + hstep, voffA);
            PG8_WAIT_L(8); PG8_BAR; PG8_WAIT_L(0); PG8_MMA(0, 0, At, B0); PG8_BAR; PG8_SCHED;
            PG8_LDB(B1, 1, 1); PG8_STAGE(PG8_SB(1, 0), b3, voffB);
            PG8_BAR; PG8_WAIT_L(0); PG8_MMA(0, 1, At, B1); PG8_BAR;
            PG8_LDA(At, 1, 1); PG8_STAGE(PG8_SA(1, 0), a3, voffA);
            PG8_BAR; PG8_WAIT_L(0); PG8_MMA(1, 0, At, B0); PG8_BAR; PG8_SCHED;
            PG8_STAGE(PG8_SB(1, 1), b3 + hstep, voffB);
            PG8_WAIT_V(6); PG8_BAR; PG8_MMA(1, 1, At, B1); PG8_BAR;
            }
        }
        if constexpr (ALIGN_EPI) { if (wr == 0) PG8_BAR; }
        if constexpr (!Epi::AFTER_DRAIN) { E(acc, cur, wr, wc, fr, fq, nxt, has_next, ui); S.done(cur); }
        if (!has_next) break;
#pragma unroll
        for (int a = 0; a < 2; ++a)
#pragma unroll
            for (int b = 0; b < 2; ++b)
#pragma unroll
                for (int m = 0; m < 4; ++m)
#pragma unroll
                    for (int n = 0; n < 2; ++n) acc[a][b][m][n] = (f32x4){0.f, 0.f, 0.f, 0.f};
        cur = nxt; cA = nA; cB = nB; ++ui;
        if constexpr (ALIGN_EPI) { if (wr == 1) PG8_BAR; }
    }
    PG8_WAIT_V(0);
    if constexpr (!ALIGN_EPI) { if (wr == 0) PG8_BAR; }
    PG8_BAR;
#undef PG8_SA
#undef PG8_SB
#undef PG8_STAGE
#undef PG8_LDA
#undef PG8_LDB
#undef PG8_MMA
#undef PG8_WAIT_V
#undef PG8_WAIT_L
#undef PG8_BAR
#undef PG8_SCHED
}
}

#define XB_TMO      128
#define XB_XCNT(j)  (256  + 64 * (j))
#define XB_XSUB(j)  (1280 + 64 * (j))
#define XB_XGEN(j)  (2304 + 64 * (j))
#define XB_TOP      3328
#define XB_TOPGEN   3392
#define XCD_BAR_WORDS 3456
#define XB_SPIN_CAP (1u << 18)
DI unsigned xb_ld(unsigned* p)              { return __hip_atomic_load(p, __ATOMIC_RELAXED, __HIP_MEMORY_SCOPE_AGENT); }
DI unsigned xb_add(unsigned* p, unsigned v) { return __hip_atomic_fetch_add(p, v, __ATOMIC_RELAXED, __HIP_MEMORY_SCOPE_AGENT); }
DI unsigned xb_xcc_id() { return (unsigned)__builtin_amdgcn_s_getreg((3 << 11) | 20) & 0xFu; }
#define XB_SPIN(cond, bar) do { unsigned _sp = 0; while (cond) { __builtin_amdgcn_s_sleep(1); \
    if ((++_sp & 255u) == 0u) { if (xb_ld(&(bar)[XB_TMO])) break; if (_sp > XB_SPIN_CAP) { atomicAdd(&(bar)[XB_TMO], 1u); break; } } } } while (0)
struct XcdBarrier { unsigned* bar; unsigned x; volatile LAS unsigned* st; };
DI XcdBarrier xcd_barrier_post(unsigned* bar, volatile LAS unsigned* st) {
    XcdBarrier b; b.bar = bar; b.x = xb_xcc_id(); b.st = st;
    if (threadIdx.x == 0) (void)xb_add(&bar[XB_XCNT(b.x)], 1u);
    return b;
}
DI void xcd_barrier_complete(unsigned* bar, unsigned x, unsigned& nloc, unsigned& nx) {
    const unsigned G = gridDim.x * gridDim.y * gridDim.z;
    unsigned sum, cnt, mine, sp = 0u;
    for (;;) {
        sum = 0u; cnt = 0u; mine = 0u;
#pragma unroll
        for (unsigned j = 0; j < 16; ++j) { const unsigned c = xb_ld(&bar[XB_XCNT(j)]); sum += c; cnt += (c > 0u) ? 1u : 0u; mine = (j == x) ? c : mine; }
        if (sum == G) break;
        __builtin_amdgcn_s_sleep(1);
        if ((++sp & 255u) == 0u) { if (xb_ld(&bar[XB_TMO])) break; if (sp > XB_SPIN_CAP) { atomicAdd(&bar[XB_TMO], 1u); break; } }
    }
    nloc = mine > 0u ? mine : 1u; nx = cnt > 0u ? cnt : 1u;
}
DI void xcd_barrier(const XcdBarrier& b) {
    asm volatile("s_waitcnt vmcnt(0)" ::: "memory");
    __syncthreads();
    if (threadIdx.x == 0) {
        unsigned* bar = b.bar;
        __builtin_amdgcn_s_waitcnt(0);
        unsigned nloc = b.st[0], nx = b.st[1];
        if (nloc == 0u) { xcd_barrier_complete(bar, b.x, nloc, nx); b.st[0] = nloc; b.st[1] = nx; }
        const unsigned old = xb_add(&bar[XB_XSUB(b.x)], 1u);
        const unsigned gen = old / nloc;
        if (old + 1u == (gen + 1u) * nloc) {
            __builtin_amdgcn_fence(__ATOMIC_RELEASE, "agent");
            asm volatile("s_waitcnt vmcnt(0)" ::: "memory");
            const unsigned og = xb_add(&bar[XB_TOP], 1u);
            const unsigned tg = og / nx;
            if (og + 1u == (tg + 1u) * nx) xb_add(&bar[XB_TOPGEN], 1u);
            else XB_SPIN(xb_ld(&bar[XB_TOPGEN]) == tg, bar);
            __builtin_amdgcn_fence(__ATOMIC_ACQUIRE, "agent");
            xb_add(&bar[XB_XGEN(b.x)], 1u);
            asm volatile("s_waitcnt vmcnt(0)" ::: "memory");
        } else {
            XB_SPIN(xb_ld(&bar[XB_XGEN(b.x)]) == gen, bar);
            __builtin_amdgcn_fence(__ATOMIC_ACQUIRE, "agent");
            asm volatile("s_waitcnt vmcnt(0)" ::: "memory");
        }
    }
    __syncthreads();
}

struct Args {
    const float* x_prompt; const float* x_sample; const float* state; const float* c; const float* c_ctx;
    const float* w_in; const float* w_out; const float* ada_w; const float* ada_b; const float* norm1_w; const float* norm2_w;
    const float* hg_lb_fwd; const float* hg_lb_bwd; const float* hg_norm_w; const float* hy_conv_w;
    const float* hy_w1; const float* hy_b1; const float* hy_f1; const float* hy_w2; const float* hy_b2; const float* hy_f2; const float* hy_w3; const float* hy_d; const float* hy_norm_w;
    const float* ffn_up; const float* ffn_conv_w; const float* ffn_down; const float* final_norm_w;
    float* out; unsigned char* ws; int ph_lo, ph_hi;
};

typedef const __attribute__((address_space(4))) Args* KArgs;
DI KArgs kargs() { unsigned long long p = (unsigned long long)__builtin_amdgcn_kernarg_segment_ptr(); asm volatile("" : "+s"(p)); return (KArgs)p; }

struct TrItem { const float* W; bf16_t* WT; int K, N, k0, n0, ns0; };
DI TrItem tr_decode(KArgs A, int it) {
    constexpr int I_IN = 16 * 128, I_OUT = 16 * 32, I_UP = 16 * 176, I_DN = 44 * 32, I_L = I_IN + I_OUT + I_UP + I_DN;
    const int l = it / I_L; int r = it % I_L; TrItem t; unsigned char* ws = A->ws;
    if (r < I_IN) { const int kb = r / 128, nb = r % 128; t.W = A->w_in + (size_t)l * DM * NIN; t.WT = (bf16_t*)(ws + WS_WIN) + (size_t)l * NIN * DM; t.K = DM; t.N = NIN; t.k0 = 64 * kb; t.n0 = 32 * nb; t.ns0 = 32 * nb; return t; } r -= I_IN;
    if (r < I_OUT) { const int kb = r / 32, nb = r % 32; t.W = A->w_out + (size_t)l * DM * DM; t.WT = (bf16_t*)(ws + WS_WOUT) + (size_t)l * DM * DM; t.K = DM; t.N = DM; t.k0 = 64 * kb; t.n0 = 32 * nb; t.ns0 = 32 * nb; return t; } r -= I_OUT;
    if (r < I_UP) { const int kb = r / 176, nb = r % 176, n0 = 32 * nb, tj = n0 >> 8, cc = n0 & 255; t.W = A->ffn_up + (size_t)l * DM * NUP; t.WT = (bf16_t*)(ws + WS_WUP) + (size_t)l * NUP * DM; t.K = DM; t.N = NUP; t.k0 = 64 * kb; t.n0 = n0;
        t.ns0 = cc < 128 ? 128 * tj + cc : DFF + 128 * tj + (cc - 128); return t; } r -= I_UP;
    { const int kb = r / 32, nb = r % 32; t.W = A->ffn_down + (size_t)l * DFF * DM; t.WT = (bf16_t*)(ws + WS_WDN) + (size_t)l * DM * DFF; t.K = DFF; t.N = DM; t.k0 = 64 * kb; t.n0 = 32 * nb; t.ns0 = 32 * nb; return t; }
}
DI void tr_load(const TrItem& t, int lane, f32x4 (&v)[8]) {
    const float* p = t.W + (size_t)(t.k0 + (lane >> 3)) * t.N + t.ns0 + 4 * (lane & 7);
#pragma unroll
    for (int i = 0; i < 8; ++i) v[i] = *(const f32x4*)(p + (size_t)(8 * i) * t.N);
}
DI void tr_store(const TrItem& t, int lane, const f32x4 (&v)[8], LAS float* scr) {
#pragma unroll
    for (int i = 0; i < 8; ++i) { LAS float* d = scr + (8 * i + (lane >> 3)) * 33 + 4 * (lane & 7); d[0] = v[i].x; d[1] = v[i].y; d[2] = v[i].z; d[3] = v[i].w; }
    LDS_WAIT(); asm volatile("" ::: "memory");
    const int c = lane & 7;
#pragma unroll
    for (int j = 0; j < 4; ++j) { const int n = (lane >> 3) + 8 * j; const LAS float* sp = scr + (8 * c) * 33 + n;
        u32x4 o; o.x = pkbf(sp[0 * 33], sp[1 * 33]); o.y = pkbf(sp[2 * 33], sp[3 * 33]); o.z = pkbf(sp[4 * 33], sp[5 * 33]); o.w = pkbf(sp[6 * 33], sp[7 * 33]);
        *(u32x4*)(t.WT + (size_t)(t.n0 + n) * t.K + t.k0 + 8 * c) = o; }
    LDS_WAIT(); asm volatile("" ::: "memory");
}
DI void tr_run(KArgs A, int first, int end, int stride, LAS float* scr, int lane) {
    if (first >= end) return;
    f32x4 va[8], vb[8];
    TrItem ta = tr_decode(A, first), tb = ta; tr_load(ta, lane, va);
    for (int it = first; it < end; it += 2 * stride) {
        const bool hb = it + stride < end;
        if (hb) { tb = tr_decode(A, it + stride); tr_load(tb, lane, vb); }
        tr_store(ta, lane, va, scr);
        if (!hb) break;
        const bool ha = it + 2 * stride < end;
        if (ha) { ta = tr_decode(A, it + 2 * stride); tr_load(ta, lane, va); }
        tr_store(tb, lane, vb, scr);
    }
}
constexpr int TR_FIRST = 16 * 128;
constexpr int TR_TOTAL = 2 * (16 * 128 + 16 * 32 + 16 * 176 + 44 * 32);
constexpr int TR_PER_BLOCK_ITEM = 32;
constexpr int TR_QITEMS = (TR_TOTAL - TR_FIRST + TR_PER_BLOCK_ITEM - 1) / TR_PER_BLOCK_ITEM;

DI void phase_p0a(KArgs A, lds_t* lds) {
    const int tid = threadIdx.x, lane = tid & 63, wave = __builtin_amdgcn_readfirstlane(tid >> 6), G = gridDim.x, bx = blockIdx.x;
    unsigned char* ws = A->ws;
    float* MOD = (float*)(ws + WS_CTL) + CW_MOD;
    float* HYABS = (float*)(ws + WS_CTL) + CW_HYABS;
    if (bx == 0) {
        float* LBT = (float*)(ws + WS_LBT);
        for (int i = tid; i < 1024; i += 512) { const int dir = i >> 9, c = i & 511; const float* p = dir ? A->hg_lb_bwd : A->hg_lb_fwd;
            const float p0 = p[c], p1 = p[512 + c], mx = fmaxf(p0, p1), e0 = __expf(p0 - mx), e1 = __expf(p1 - mx);
            LBT[0 * 1024 + dir * 512 + c] = 0.f; LBT[1 * 1024 + dir * 512 + c] = e1 / (e0 + e1); }
    }
    for (int rnd = 0; rnd < 2; ++rnd) {
        const int un = (G == 256) ? (bx < 160 ? (rnd == 0 ? bx : 999) : 160 + 2 * (bx - 160) + rnd) : bx + rnd * G;
        if (un >= 352) continue;
        if (un < 160) {
            const int l = un / 80, r = un % 80, cs = r < 16 ? 0 : 1, pb = cs ? r - 16 : r, L = cs ? 1024 : 256, p0 = pb * 16;
            LAS float* FE = (LAS float*)lds;
            LAS float* H1 = FE + 16 * 33;
            LAS float* H2 = H1 + 16 * 64;
            LAS float* W1 = H2 + 16 * 64;
            LAS float* W2 = W1 + 33 * 64;
            LAS float* PR = W2 + 64 * 64;
            for (int i = tid; i < 33 * 64; i += 512) W1[i] = A->hy_w1[l * 33 * 64 + i];
            for (int i = tid; i < 64 * 64; i += 512) W2[i] = A->hy_w2[l * 64 * 64 + i];
            if (tid < 256) { const int q = tid >> 6, o = tid & 63; const float* src = q == 0 ? A->hy_b1 : (q == 1 ? A->hy_f1 : (q == 2 ? A->hy_b2 : A->hy_f2)); PR[tid] = src[l * 64 + o]; }
            for (int i = tid; i < 16 * 33; i += 512) { const int p = i / 33, e = i % 33, pos = p0 + p; float v;
                if (e == 0) v = (float)pos / (float)(L - 1);
                else { const int k = (e - 1) & 15; const float band = 1e-4f + (float)k * ((15.0f - 1e-4f) / 15.0f); const float ang = 6.283185307179586f * (float)pos * band / (float)L; v = (e <= 16) ? cosf(ang) : sinf(ang); }
                FE[i] = v; }
            __syncthreads();
            for (int i = tid; i < 16 * 64; i += 512) { const int p = i >> 6, o = i & 63; float sm = PR[o];
#pragma unroll
                for (int e = 0; e < 33; ++e) sm += FE[p * 33 + e] * W1[e * 64 + o];
                H1[i] = sinf(PR[64 + o] * sm); }
            __syncthreads();
            for (int i = tid; i < 16 * 64; i += 512) { const int p = i >> 6, o = i & 63; float sm = PR[128 + o];
#pragma unroll
                for (int k4 = 0; k4 < 16; ++k4) { const f32x4 h = *(const LAS f32x4*)(H1 + p * 64 + 4 * k4); sm += (h.x * W2[(4 * k4) * 64 + o] + h.y * W2[(4 * k4 + 1) * 64 + o]) + (h.z * W2[(4 * k4 + 2) * 64 + o] + h.w * W2[(4 * k4 + 3) * 64 + o]); }
                H2[i] = sinf(PR[192 + o] * sm); }
            __syncthreads();
            float af[16], ab[16];
#pragma unroll
            for (int p = 0; p < 16; ++p) { af[p] = 0.f; ab[p] = 0.f; }
            const float* w3 = A->hy_w3 + (size_t)l * 64 * 1024;
#pragma unroll 1
            for (int kb = 0; kb < 64; kb += 16) {
                float wf[16], wb[16];
#pragma unroll
                for (int k = 0; k < 16; ++k) { wf[k] = w3[(kb + k) * 1024 + tid]; wb[k] = w3[(kb + k) * 1024 + 512 + tid]; }
#pragma unroll
                for (int p = 0; p < 16; ++p)
#pragma unroll
                    for (int k4 = 0; k4 < 4; ++k4) { const f32x4 h = *(const LAS f32x4*)(H2 + p * 64 + kb + 4 * k4);
                        af[p] += (h.x * wf[4 * k4] + h.y * wf[4 * k4 + 1]) + (h.z * wf[4 * k4 + 2] + h.w * wf[4 * k4 + 3]);
                        ab[p] += (h.x * wb[4 * k4] + h.y * wb[4 * k4 + 1]) + (h.z * wb[4 * k4 + 2] + h.w * wb[4 * k4 + 3]); }
            }
            const float mind = -3.0701134573253944f, maxd = -15.350567286626973f;
            const float delta = fabsf(mind + (float)tid * ((maxd - mind) / 511.0f));
            bf16_t* GF = (bf16_t*)(ws + WS_GF + (size_t)l * GF_LSTRIDE + (cs ? GF_SAMPLE_OFF : 0)) + (size_t)tid * (2 * L);
            float asum = 0.f;
#pragma unroll
            for (int p = 0; p < 16; ++p) { const int pos = p0 + p; const float tt = (float)pos / (float)(L - 1), dec = __expf(-tt * delta);
                const float hf = af[p] * dec, hb = ab[p] * dec;
                GF[L + pos] = (bf16_t)(pkbf(hf, 0.f) & 0xffffu); asum += fabsf(hf);
                if (pos >= 1) { GF[L - pos] = (bf16_t)(pkbf(hb, 0.f) & 0xffffu); asum += fabsf(hb); } else GF[0] = 0; }
            atomicAdd(&HYABS[(l * 2 + cs) * 512 + tid], asum);
            __syncthreads();
        } else {
            const int v = un - 160, l = v / 96, r = v % 96, jb = r >> 2, kq = r & 3;
            LAS float* SC = (LAS float*)lds;
            LAS float* PA = SC + 9 * 256;
            for (int i = tid; i < 9 * 256; i += 512) { const int cid = i >> 8, k = kq * 256 + (i & 255); const float cvv = cid == 0 ? A->c_ctx[k] : A->c[(cid - 1) * DM + k]; SC[i] = silu_f(cvv); }
            __syncthreads();
            f32x4 ac[9];
#pragma unroll
            for (int q = 0; q < 9; ++q) ac[q] = (f32x4){0.f, 0.f, 0.f, 0.f};
            const float* wp = A->ada_w + ((size_t)l * DM + kq * 256 + wave * 32) * NMOD + jb * 256 + 4 * lane;
#pragma unroll 1
            for (int kb = 0; kb < 32; kb += 16) { f32x4 wv[16];
#pragma unroll
                for (int kk = 0; kk < 16; ++kk) wv[kk] = *(const f32x4*)(wp + (size_t)(kb + kk) * NMOD);
#pragma unroll
                for (int kk = 0; kk < 16; ++kk)
#pragma unroll
                    for (int q = 0; q < 9; ++q) ac[q] += SC[q * 256 + wave * 32 + kb + kk] * wv[kk]; }
#pragma unroll
            for (int q = 0; q < 9; ++q) *(LAS f32x4*)(PA + (wave * 9 + q) * 256 + 4 * lane) = ac[q];
            __syncthreads();
            for (int i = tid; i < 9 * 256; i += 512) { float s = 0.f;
#pragma unroll
                for (int w = 0; w < 8; ++w) s += PA[w * 9 * 256 + i];
                const int cid = i >> 8, j = jb * 256 + (i & 255);
                if (kq == 0) s += A->ada_b[l * NMOD + j];
                atomicAdd(&MOD[(l * 9 + cid) * NMOD + j], s); }
            __syncthreads();
        }
    }
    tr_run(A, bx * 8 + wave, TR_FIRST, G * 8, (LAS float*)(lds + wave * 16384), lane);
}

DI void bias_tables(KArgs A, lds_t* lds, int seg_lo, int seg_hi) {
    const int tid = ltid(), lane = tid & 63, wave = __builtin_amdgcn_readfirstlane(tid >> 6), gw = blockIdx.x * 8 + wave, NGW = gridDim.x * 8;
    const float* MOD = (const float*)(A->ws + WS_CTL) + CW_MOD;
    constexpr int SHS = 2064, SHI = 16 * SHS;
    __syncthreads();
    for (int seg = seg_lo; seg < seg_hi; ++seg) {
        const int sl = seg - seg_lo; const float* shp = MOD + (size_t)(seg >> 1) * 9 * NMOD + ((seg & 1) ? 3072 : 0) + 2 * tid;
        f32x2_t sv[9];
#pragma unroll
        for (int rw = 0; rw < 9; ++rw) sv[rw] = *(const f32x2_t*)(shp + rw * NMOD);
#pragma unroll
        for (int rw = 0; rw < 16; ++rw) *(LAS unsigned*)(lds + sl * SHI + rw * SHS + 4 * tid) = rw < 9 ? pkbf(sv[rw < 9 ? rw : 0].x, sv[rw < 9 ? rw : 0].y) : 0u;
    }
    __syncthreads();
    const int i16 = lane & 15, q4 = lane >> 4;
    constexpr int G_IN = NIN / 16, G_UP = NUP / 16;
    int gbase = 0;
    for (int seg = seg_lo; seg < seg_hi; ++seg) {
        const int l = seg >> 1, which = seg & 1, nrows = which ? NUP : NIN, ng = which ? G_UP : G_IN, sl = seg - seg_lo;
        const bf16_t* W = which ? (const bf16_t*)(A->ws + WS_WUP) + (size_t)l * NUP * DM : (const bf16_t*)(A->ws + WS_WIN) + (size_t)l * NIN * DM;
        float* bo = (float*)(A->ws + WS_BIAS + (which ? BIAS2_OFF : 0)) + (size_t)l * 9 * nrows;
        for (int g = (gw + NGW - (gbase % NGW)) % NGW; g < ng; g += NGW) {
            const bf16_t* wrow = W + (size_t)(16 * g + i16) * DM + 8 * q4;
            f32x4 ac = (f32x4){0.f, 0.f, 0.f, 0.f};
#pragma unroll
            for (int kh = 0; kh < 2; ++kh) {
                bf16x8 fb[16];
#pragma unroll
                for (int ks = 0; ks < 16; ++ks) fb[ks] = *(const bf16x8*)(wrow + 32 * (16 * kh + ks));
#pragma unroll
                for (int ks = 0; ks < 16; ++ks) { const bf16x8 fa = *(const LAS bf16x8*)(lds + sl * SHI + i16 * SHS + 2 * (32 * (16 * kh + ks) + 8 * q4)); ac = __builtin_amdgcn_mfma_f32_16x16x32_bf16(fa, fb[ks], ac, 0, 0, 0); }
            }
#pragma unroll
            for (int rg = 0; rg < 4; ++rg) { const int cidx = 4 * q4 + rg; if (cidx < 9) bo[(size_t)cidx * nrows + 16 * g + i16] = ac[rg]; }
        }
        gbase += ng;
    }
    __syncthreads();
}

DI void phase_p0b(KArgs A, lds_t* lds) {
    const int tid = ltid(), lane = tid & 63, wave = __builtin_amdgcn_readfirstlane(tid >> 6), gw = blockIdx.x * 8 + wave, NGW = gridDim.x * 8;
    const float* MOD = (const float*)(A->ws + WS_CTL) + CW_MOD;
    bf16_t* H = (bf16_t*)(A->ws + WS_H); float* RSP = (float*)(A->ws + WS_RSP);
    for (int mb = gw; mb < TT; mb += 3 * NGW) {
        f32x4 v[3][4];
#pragma unroll
        for (int rI = 0; rI < 3; ++rI) { const int m = mb + rI * NGW;
            if (m < TT) { const float* xr = (m < TP) ? A->x_prompt + (size_t)m * DM : A->x_sample + (size_t)(m - TP) * DM;
#pragma unroll
                for (int j = 0; j < 4; ++j) v[rI][j] = *(const f32x4*)(xr + 4 * lane + 256 * j); } }
#pragma unroll
        for (int rI = 0; rI < 3; ++rI) { const int m = mb + rI * NGW;
            if (m < TT) { const float* md = MOD + cid_of_row(m) * NMOD; float sm = 0.f;
#pragma unroll
                for (int j = 0; j < 4; ++j) sm += (v[rI][j].x * v[rI][j].x + v[rI][j].y * v[rI][j].y) + (v[rI][j].z * v[rI][j].z + v[rI][j].w * v[rI][j].w);
                sm = wave_sum(sm);
                if (lane < 4) RSP[(size_t)m * 4 + lane] = lane == 0 ? sm : 0.f;
#pragma unroll
                for (int j = 0; j < 4; ++j) { const int c = 4 * lane + 256 * j; const f32x4 w = *(const f32x4*)(A->norm1_w + c), sc = *(const f32x4*)(md + 1024 + c);
                    const f32x4 o = v[rI][j] * w * (1.0f + sc);
                    u32x2 pk; pk.x = pkbf(o.x, o.y); pk.y = pkbf(o.z, o.w); *(u32x2*)(H + (size_t)m * DM + c) = pk; } } }
    }
    bias_tables(A, lds, 0, 1);
}
DI void phase_final_norm(KArgs A) {
    const int tid = ltid(), lane = tid & 63, wave = __builtin_amdgcn_readfirstlane(tid >> 6), gw = blockIdx.x * 8 + wave, NGW = gridDim.x * 8;
    for (int m = gw; m < TT; m += NGW) {
        float* xr = A->out + (size_t)m * DM;
        f32x4 v[4]; float s = 0.f;
#pragma unroll
        for (int j = 0; j < 4; ++j) { v[j] = *(const f32x4*)(xr + 4 * lane + 256 * j); s += (v[j].x * v[j].x + v[j].y * v[j].y) + (v[j].z * v[j].z + v[j].w * v[j].w); }
        const float r = 1.0f / sqrtf(wave_sum(s) * (1.0f / DM) + EPS);
#pragma unroll
        for (int j = 0; j < 4; ++j) { const int c = 4 * lane + 256 * j; const f32x4 w = *(const f32x4*)(A->final_norm_w + c); *(f32x4*)(xr + c) = v[j] * r * w; }
    }
}

DI void phase_hyprep(KArgs A, int l, lds_t* lds) {
    const int tid = threadIdx.x;
    const bf16_t* P = (const bf16_t*)(A->ws + WS_P);
    bf16_t* UT = (bf16_t*)(A->ws + WS_UT); bf16_t* X2T = (bf16_t*)(A->ws + WS_X2T);
    constexpr int RS = 144;
    for (int un = blockIdx.x; un < 192 * 8; un += gridDim.x) {
        const int tb = un >> 3, cb = un & 7, m0 = 64 * tb;
        const bool pr = m0 < TP, has_prev = pr && ((m0 & 255) != 0), has_next = pr && (((m0 + 64) & 255) != 0);
        {
            const int row = tid >> 3, ch = tid & 7;
#pragma unroll
            for (int a = 0; a < 3; ++a) { const u32x4 v = *(const u32x4*)(P + (size_t)(m0 + row) * NIN + 2560 + a * 512 + cb * 64 + ch * 8); *(LAS u32x4*)(lds + a * 66 * RS + (row + 1) * RS + ch * 16) = v; }
            if (tid < 48) { const int a = tid >> 4, which = (tid >> 3) & 1, chh = tid & 7; const bool valid = which ? has_next : has_prev; const int mrow = which ? m0 + 64 : m0 - 1;
                u32x4 v = (u32x4){0u, 0u, 0u, 0u}; if (valid) v = *(const u32x4*)(P + (size_t)mrow * NIN + 2560 + a * 512 + cb * 64 + chh * 8);
                *(LAS u32x4*)(lds + a * 66 * RS + (which ? 65 : 0) * RS + chh * 16) = v; }
        }
        __syncthreads();
        {
            const int ch = tid >> 3, tq = tid & 7, cg = cb * 64 + ch;
            float w[3][3];
#pragma unroll
            for (int a = 0; a < 3; ++a)
#pragma unroll
                for (int j = 0; j < 3; ++j) w[a][j] = A->hy_conv_w[(l * 3 + j) * 1536 + a * 512 + cg];
            float uu[8], xx[8];
#pragma unroll
            for (int i = 0; i < 8; ++i) { const int rr = 8 * tq + i + 1; float val[3];
#pragma unroll
                for (int a = 0; a < 3; ++a) { const lds_t* b = lds + a * 66 * RS + 2 * ch;
                    const float xm = bf1(*(const LAS bf16_t*)(b + (rr - 1) * RS)), x0 = bf1(*(const LAS bf16_t*)(b + rr * RS)), xp = bf1(*(const LAS bf16_t*)(b + (rr + 1) * RS));
                    val[a] = w[a][0] * xm + w[a][1] * x0 + w[a][2] * xp; }
                uu[i] = val[1] * val[0]; xx[i] = val[2]; }
            u32x4 o; o.x = pkbf(uu[0], uu[1]); o.y = pkbf(uu[2], uu[3]); o.z = pkbf(uu[4], uu[5]); o.w = pkbf(uu[6], uu[7]);
            *(u32x4*)(UT + (size_t)cg * TT + m0 + 8 * tq) = o;
            o.x = pkbf(xx[0], xx[1]); o.y = pkbf(xx[2], xx[3]); o.z = pkbf(xx[4], xx[5]); o.w = pkbf(xx[6], xx[7]);
            *(u32x4*)(X2T + (size_t)cg * TT + m0 + 8 * tq) = o;
        }
        __syncthreads();
    }
}

constexpr int S_QE = 0, S_QS = 17408, S_KS = 34816, S_QB = 52224, S_KB = 60928, S_KT = 69632, S_VT = 88064, S_PP = 106496, S_ST = 115712, S_GT = 150528, S_DEC = 154624;
static_assert(S_DEC + 512 <= MISC_OFF, "scan lds");
DI void scan_item(KArgs A, int l, int seq, int head, int dir, lds_t* lds) {
    const int tid = ltid(), lane = tid & 63, w = __builtin_amdgcn_readfirstlane(tid >> 6);
    const bool samp = seq >= 16;
    const int L = samp ? 1024 : 256, mbase = samp ? TP + (seq - 16) * 1024 : seq * 256, nch = L >> 6;
    const bf16_t* P = (const bf16_t*)(A->ws + WS_P);
    const bf16_t* Pq = P + (size_t)mbase * NIN + head * 128;
    const bf16_t* Pf = Pq + 512 + dir * 512;
    const bf16_t* Pv = Pq + 1536;
    bf16_t* Oo = (bf16_t*)(A->ws + WS_H) + (size_t)dir * TT * 512 + (size_t)mbase * 512 + head * 128;
    const int a = w >> 2, jv = w & 3, r = lane & 31, hh = lane >> 5;
    f32x16 Sa[2];
    if (samp) {
        const float* st = A->state + ((((size_t)(seq - 16) * 2 + l) * 2 + dir) * 4 + head) * 16384;
#pragma unroll
        for (int ii = 0; ii < 2; ++ii)
#pragma unroll
            for (int rg = 0; rg < 16; ++rg) Sa[ii][rg] = st[(size_t)(32 * (2 * a + ii) + crow(rg, hh)) * 128 + 32 * jv + r];
    } else {
#pragma unroll
        for (int ii = 0; ii < 2; ++ii)
#pragma unroll
            for (int rg = 0; rg < 16; ++rg) Sa[ii][rg] = 0.f;
    }
#pragma unroll
    for (int ii = 0; ii < 2; ++ii)
#pragma unroll
        for (int q4 = 0; q4 < 4; ++q4) { u32x2 pk; pk.x = pkbf(Sa[ii][4 * q4], Sa[ii][4 * q4 + 1]); pk.y = pkbf(Sa[ii][4 * q4 + 2], Sa[ii][4 * q4 + 3]);
            *(LAS u32x2*)(lds + S_ST + (32 * jv + r) * 272 + 2 * (32 * (2 * a + ii) + 8 * q4 + 4 * hh)) = pk; }
    unsigned rq[8], rf[8], rv[8];
    const long tstep = dir ? -(long)NIN : (long)NIN;
    const size_t off0 = (size_t)(dir ? L - 1 - 8 * w : 8 * w) * NIN + 2 * lane;
#pragma unroll
    for (int i = 0; i < 8; ++i) { const long off = (long)off0 + i * tstep; rq[i] = *(const unsigned*)(Pq + off); rf[i] = *(const unsigned*)(Pf + off); rv[i] = *(const unsigned*)(Pv + off); }
    lds_t* OT = lds + S_QS + w * 2560;
    for (int ch = 0; ch < nch; ++ch) {
        { float s0 = 0.f, s1 = 0.f;
#pragma unroll
          for (int i = 0; i < 8; ++i) { s0 += bflo(rf[i]); s1 += bfhi(rf[i]); }
          *(LAS f32x2_t*)(lds + S_GT + (w * 128 + 2 * lane) * 4) = (f32x2_t){s0, s1}; }
        __syncthreads();
        {
            float my0 = 0.f, my1 = 0.f, p2_0 = 0.f, p2_1 = 0.f, p4_0 = 0.f, p4_1 = 0.f, p6_0 = 0.f, p6_1 = 0.f, run0 = 0.f, run1 = 0.f;
#pragma unroll
            for (int g = 0; g < 8; ++g) {
                if (g == 2) { p2_0 = run0; p2_1 = run1; } if (g == 4) { p4_0 = run0; p4_1 = run1; } if (g == 6) { p6_0 = run0; p6_1 = run1; }
                if (g == w) { my0 = run0; my1 = run1; }
                const f32x2_t gt = *(const LAS f32x2_t*)(lds + S_GT + (g * 128 + 2 * lane) * 4); run0 += gt.x; run1 += gt.y; }
            const float p8_0 = run0, p8_1 = run1;
            const float rd0 = (w < 4) ? p2_0 : p6_0, rd1 = (w < 4) ? p2_1 : p6_1;
            if (w == 0) *(LAS f32x2_t*)(lds + S_DEC + 8 * lane) = (f32x2_t){__expf(p8_0), __expf(p8_1)};
            float G0 = __expf(fminf(my0 - rd0, 80.f)), G1 = __expf(fminf(my1 - rd1, 80.f));
            const float crd0 = __expf(rd0), crd1 = __expf(rd1), cend0 = __expf(fminf(p8_0 - rd0, 0.f)), cend1 = __expf(fminf(p8_1 - rd1, 0.f));
            const float c40 = __expf(fminf((w < 4) ? p4_0 - p2_0 : p6_0 - p4_0, 0.f)), c41 = __expf(fminf((w < 4) ? p4_1 - p2_1 : p6_1 - p4_1, 0.f));
            unsigned kt0[4], kt1[4], vt0[4], vt1[4];
            float kprev0 = 0.f, kprev1 = 0.f, vprev0 = 0.f, vprev1 = 0.f;
            lds_t* rowp = lds + (8 * w) * 272 + 4 * lane;
#pragma unroll
            for (int i = 0; i < 8; ++i) {
                const float q0 = bflo(rq[i]), q1 = bfhi(rq[i]), F0 = __expf(bflo(rf[i])), F1 = __expf(bfhi(rf[i])), v0 = bflo(rv[i]), v1 = bfhi(rv[i]);
                const float k0 = 1.0f - F0, k1 = 1.0f - F1;
                G0 *= F0; G1 *= F1;
                const float ig0 = __builtin_amdgcn_rcpf(fmaxf(G0, 1e-30f)), ig1 = __builtin_amdgcn_rcpf(fmaxf(G1, 1e-30f));
                const float qs0 = q0 * G0, qs1 = q1 * G1, ks0 = k0 * ig0, ks1 = k1 * ig1;
                *(LAS unsigned*)(rowp + S_QS + i * 272) = pkbf(qs0, qs1);
                *(LAS unsigned*)(rowp + S_KS + i * 272) = pkbf(ks0, ks1);
                *(LAS unsigned*)(rowp + S_QE + i * 272) = pkbf(qs0 * crd0, qs1 * crd1);
                if (w >= 4) *(LAS unsigned*)(rowp + S_QB - 32 * 272 + i * 272) = pkbf(qs0 * c40, qs1 * c41);
                else        *(LAS unsigned*)(rowp + S_KB + i * 272) = pkbf(ks0 * c40, ks1 * c41);
                const float kk0 = ks0 * cend0, kk1 = ks1 * cend1;
                if (i & 1) { kt0[i >> 1] = pkbf(kprev0, kk0); kt1[i >> 1] = pkbf(kprev1, kk1); vt0[i >> 1] = pkbf(vprev0, v0); vt1[i >> 1] = pkbf(vprev1, v1); }
                else { kprev0 = kk0; kprev1 = kk1; vprev0 = v0; vprev1 = v1; }
            }
            *(LAS u32x4*)(lds + S_KT + (2 * lane) * 144 + 16 * w) = (u32x4){kt0[0], kt0[1], kt0[2], kt0[3]};
            *(LAS u32x4*)(lds + S_KT + (2 * lane + 1) * 144 + 16 * w) = (u32x4){kt1[0], kt1[1], kt1[2], kt1[3]};
            *(LAS u32x4*)(lds + S_VT + (2 * lane) * 144 + 16 * w) = (u32x4){vt0[0], vt0[1], vt0[2], vt0[3]};
            *(LAS u32x4*)(lds + S_VT + (2 * lane + 1) * 144 + 16 * w) = (u32x4){vt1[0], vt1[1], vt1[2], vt1[3]};
        }
        if (ch + 1 < nch) {
            const long offc = (long)off0 + (long)(64 * (ch + 1)) * tstep;
#pragma unroll
            for (int i = 0; i < 8; ++i) { const long off = offc + i * tstep; rq[i] = *(const unsigned*)(Pq + off); rf[i] = *(const unsigned*)(Pf + off); rv[i] = *(const unsigned*)(Pv + off); }
        }
        __syncthreads();
        if (w < 3) {
            const lds_t* Ab = lds + (w == 2 ? S_QB : (w == 1 ? S_QS + 32 * 272 : S_QS));
            const lds_t* Bb = lds + (w == 2 ? S_KB : (w == 1 ? S_KS + 32 * 272 : S_KS));
            const int prow0 = w == 0 ? 0 : 32, pcol0 = w == 1 ? 32 : 0; const bool mask = w != 2;
            f32x16 sc;
#pragma unroll
            for (int rg = 0; rg < 16; ++rg) sc[rg] = 0.f;
#pragma unroll
            for (int s = 0; s < 8; ++s) { const bf16x8 fa = *(const LAS bf16x8*)(Ab + r * 272 + 32 * s + 16 * hh), fb = *(const LAS bf16x8*)(Bb + r * 272 + 32 * s + 16 * hh); sc = MFMA32(fa, fb, sc); }
#pragma unroll
            for (int rg = 0; rg < 16; ++rg) { const int jl = crow(rg, hh); const float val = (mask && r > jl) ? 0.f : sc[rg];
                *(LAS bf16_t*)(lds + S_PP + (prow0 + jl) * 144 + 2 * (pcol0 + r)) = (bf16_t)(pkbf(val, 0.f) & 0xffffu); }
        }
        f32x16 oacc;
#pragma unroll
        for (int rg = 0; rg < 16; ++rg) oacc[rg] = 0.f;
#pragma unroll
        for (int s = 0; s < 8; ++s) { const bf16x8 fa = *(const LAS bf16x8*)(lds + S_QE + (32 * a + r) * 272 + 32 * s + 16 * hh), fb = *(const LAS bf16x8*)(lds + S_ST + (32 * jv + r) * 272 + 32 * s + 16 * hh); oacc = MFMA32(fa, fb, oacc); }
#pragma unroll
        for (int ii = 0; ii < 2; ++ii) { const int dkb = 32 * (2 * a + ii);
#pragma unroll
            for (int q4 = 0; q4 < 4; ++q4) { const f32x4 dv = *(const LAS f32x4*)(lds + S_DEC + 4 * (dkb + 8 * q4 + 4 * hh));
                Sa[ii][4 * q4] *= dv.x; Sa[ii][4 * q4 + 1] *= dv.y; Sa[ii][4 * q4 + 2] *= dv.z; Sa[ii][4 * q4 + 3] *= dv.w; }
#pragma unroll
            for (int s = 0; s < 4; ++s) { const bf16x8 fa = *(const LAS bf16x8*)(lds + S_KT + (dkb + r) * 144 + 32 * s + 16 * hh), fb = *(const LAS bf16x8*)(lds + S_VT + (32 * jv + r) * 144 + 32 * s + 16 * hh); Sa[ii] = MFMA32(fa, fb, Sa[ii]); } }
        __syncthreads();
#pragma unroll
        for (int s = 0; s < 4; ++s) { if (s < 2 || a == 1) { const bf16x8 fa = *(const LAS bf16x8*)(lds + S_PP + (32 * a + r) * 144 + 32 * s + 16 * hh), fb = *(const LAS bf16x8*)(lds + S_VT + (32 * jv + r) * 144 + 32 * s + 16 * hh); oacc = MFMA32(fa, fb, oacc); } }
#pragma unroll
        for (int rg = 0; rg < 16; ++rg) *(LAS bf16_t*)(OT + crow(rg, hh) * 80 + 2 * r) = (bf16_t)(pkbf(oacc[rg], 0.f) & 0xffffu);
#pragma unroll
        for (int ii = 0; ii < 2; ++ii)
#pragma unroll
            for (int q4 = 0; q4 < 4; ++q4) { u32x2 pk; pk.x = pkbf(Sa[ii][4 * q4], Sa[ii][4 * q4 + 1]); pk.y = pkbf(Sa[ii][4 * q4 + 2], Sa[ii][4 * q4 + 3]);
                *(LAS u32x2*)(lds + S_ST + (32 * jv + r) * 272 + 2 * (32 * (2 * a + ii) + 8 * q4 + 4 * hh)) = pk; }
        { const int tl = lane >> 1, hf = lane & 1, tau = 64 * ch + 32 * a + tl, t = dir ? L - 1 - tau : tau;
          const u32x4 o0 = *(const LAS u32x4*)(OT + tl * 80 + 32 * hf), o1 = *(const LAS u32x4*)(OT + tl * 80 + 32 * hf + 16);
          bf16_t* op = Oo + (size_t)t * 512 + 32 * jv + 16 * hf; *(u32x4*)op = o0; *(u32x4*)(op + 8) = o1; }
    }
    if (!samp) {
        float* ns = A->out + (size_t)TT * DM + ((((size_t)seq * 2 + l) * 2 + dir) * 4 + head) * 16384;
#pragma unroll
        for (int ii = 0; ii < 2; ++ii)
#pragma unroll
            for (int rg = 0; rg < 16; ++rg) ns[(size_t)(32 * (2 * a + ii) + crow(rg, hh)) * 128 + 32 * jv + r] = Sa[ii][rg];
    }
    __syncthreads();
}

constexpr int H_CST = 4112, H_CP = 0, H_UP = 33024, H_UPBYTES = 61440, H_GST = H_UP + H_UPBYTES;
DI void hyena_item(KArgs A, int l, int cs, int c, bool zero_pads, lds_t* lds) {
    const int tid = ltid(), lane = tid & 63, w = __builtin_amdgcn_readfirstlane(tid >> 6);
    const int L = cs ? 1024 : 256, NB = L >> 5, nseq = cs ? 8 : 16, m0 = cs ? TP : 0, SEQST = 3 * NB * 80;
    bf16_t* UT = (bf16_t*)(A->ws + WS_UT) + (size_t)c * TT + m0;
    const bf16_t* X2T = (const bf16_t*)(A->ws + WS_X2T) + (size_t)c * TT + m0;
    const bf16_t* GF = (const bf16_t*)(A->ws + WS_GF + (size_t)l * GF_LSTRIDE + (cs ? GF_SAMPLE_OFF : 0)) + (size_t)c * (2 * L);
    if (zero_pads) { for (int i = tid; i < H_UPBYTES / 16; i += 512) *(LAS u32x4*)(lds + H_UP + 16 * i) = (u32x4){0u, 0u, 0u, 0u}; __syncthreads(); }
    { const int nchunk = nseq * L / 8, cps = L / 8;
      for (int q = tid; q < nchunk; q += 512) { const int sq = q / cps, s = 8 * (q % cps); const u32x4 v = *(const u32x4*)(UT + (size_t)sq * L + s);
          *(LAS u32x4*)(lds + H_UP + sq * SEQST + (NB + (s >> 5)) * 80 + 2 * (s & 31)) = v; }
      for (int q = tid; q < 2 * L / 8; q += 512) *(LAS u32x4*)(lds + H_GST + 16 * q) = *(const u32x4*)(GF + 8 * q); }
    __syncthreads();
    for (int e = tid; e < 16 * L; e += 512) { const int m = e / (2 * L), p = e % (2 * L), idx = 2 * L + m - p;
        bf16_t v = 0; if (idx < 2 * L) v = *(const LAS bf16_t*)(lds + H_GST + 2 * idx);
        *(LAS bf16_t*)(lds + H_CP + m * H_CST + 2 * p) = v; }
    __syncthreads();
    const int r = lane & 31, hh = lane >> 5;
    const bool active = cs ? true : (w < 4);
    if (active) {
        const int sq = cs ? w : 4 * w + (r >> 3), ab = cs ? r : (r & 7);
        const lds_t* ub = lds + H_UP + sq * SEQST + (NB + ab) * 80 + 16 * hh;
        const lds_t* cb = lds + H_CP + (r & 7) * H_CST + 2 * (L - 8 * (r >> 3) + 8 * hh);
        f32x16 z;
#pragma unroll
        for (int rg = 0; rg < 16; ++rg) z[rg] = 0.f;
        for (int d = -(NB - 1); d <= NB - 1; ++d) {
#pragma unroll
            for (int ks = 0; ks < 2; ++ks) { const bf16x8 fa = *(const LAS bf16x8*)(cb - 64 * d + 32 * ks), fb = *(const LAS bf16x8*)(ub - 80 * d + 32 * ks); z = MFMA32(fa, fb, z); }
        }
        const float invn = 1.0f / (((const float*)(A->ws + WS_CTL))[CW_HYABS + (l * 2 + cs) * 512 + c] + EPS), dd = A->hy_d[l * 512 + c];
#pragma unroll
        for (int q4 = 0; q4 < 4; ++q4) { const int t0 = 32 * ab + 8 * q4 + 4 * hh;
            const u32x2 uu = *(const LAS u32x2*)(lds + H_UP + sq * SEQST + (NB + ab) * 80 + 2 * (8 * q4 + 4 * hh));
            const u32x2 x2 = *(const u32x2*)(X2T + (size_t)sq * L + t0);
            const float y0 = bflo(x2.x) * (invn * z[4 * q4 + 0] + dd * bflo(uu.x)), y1 = bfhi(x2.x) * (invn * z[4 * q4 + 1] + dd * bfhi(uu.x));
            const float y2 = bflo(x2.y) * (invn * z[4 * q4 + 2] + dd * bflo(uu.y)), y3 = bfhi(x2.y) * (invn * z[4 * q4 + 3] + dd * bfhi(uu.y));
            u32x2 o; o.x = pkbf(y0, y1); o.y = pkbf(y2, y3);
            *(u32x2*)(UT + (size_t)sq * L + t0) = o; }
    }
    __syncthreads();
}

DI void phase_mixer(KArgs A, int l, lds_t* lds) {
    unsigned* qhead = (unsigned*)(A->ws + WS_CTL) + CW_QUEUE + 64 * l;
    volatile LAS unsigned* bc = (volatile LAS unsigned*)(lds + MISC_OFF) + 16;
    int last_kind = -1;
    for (;;) {
        __syncthreads();
        if (threadIdx.x == 0) *bc = __hip_atomic_fetch_add(qhead, 1u, __ATOMIC_RELAXED, __HIP_MEMORY_SCOPE_AGENT);
        __syncthreads();
        const int it = (int)*bc;
        if (it >= 1216 + (l == 0 ? TR_QITEMS : 0)) break;
        if (it >= 1216) {
            const int w = __builtin_amdgcn_readfirstlane(threadIdx.x >> 6), base = TR_FIRST + (it - 1216) * TR_PER_BLOCK_ITEM;
            const int e = base + TR_PER_BLOCK_ITEM < TR_TOTAL ? base + TR_PER_BLOCK_ITEM : TR_TOTAL;
            tr_run(A, base + w, e, 8, (LAS float*)(lds + w * 16384), threadIdx.x & 63); last_kind = -1; continue; }
        const bool is_scan = it < 64 || (it >= 576 && it < 704);
        if (is_scan) { const int i2 = it < 64 ? it : it - 576, sq = (it < 64 ? 16 : 0) + (i2 >> 3); scan_item(A, l, sq, (i2 >> 1) & 3, i2 & 1, lds); last_kind = -1; }
        else { const int cs = it < 576 ? 1 : 0, c = cs ? it - 64 : it - 704; hyena_item(A, l, cs, c, last_kind != cs, lds); last_kind = cs; }
    }
}

DI void phase_merge(KArgs A, int l, lds_t* lds) {
    const int tid = threadIdx.x;
    if (l == 0) bias_tables(A, lds, 1, 4);
    const bf16_t* P = (const bf16_t*)(A->ws + WS_P);
    const bf16_t* OF = (const bf16_t*)(A->ws + WS_H); const bf16_t* OB = OF + (size_t)TT * 512;
    const bf16_t* YT = (const bf16_t*)(A->ws + WS_UT);
    bf16_t* MG = (bf16_t*)(A->ws + WS_MERGED);
    constexpr int RS = 1040;
    for (int un = blockIdx.x; un < TT / 32; un += gridDim.x) {
        const int m0 = 32 * un;
        { const bf16_t* yp = YT + (size_t)tid * TT + m0;
#pragma unroll
          for (int q = 0; q < 4; ++q) { const u32x4 v = *(const u32x4*)(yp + 8 * q);
              const unsigned vv[4] = {v.x, v.y, v.z, v.w};
#pragma unroll
              for (int e = 0; e < 4; ++e) { *(LAS bf16_t*)(lds + (8 * q + 2 * e) * RS + 2 * tid) = (bf16_t)(vv[e] & 0xffffu); *(LAS bf16_t*)(lds + (8 * q + 2 * e + 1) * RS + 2 * tid) = (bf16_t)(vv[e] >> 16); } } }
        const int j = tid >> 4, sub = tid & 15, m = m0 + j, cbase = 32 * sub;
        {
            float o[32]; float ss = 0.f;
#pragma unroll
            for (int q = 0; q < 4; ++q) { const u32x4 f = *(const u32x4*)(OF + (size_t)m * 512 + cbase + 8 * q), b = *(const u32x4*)(OB + (size_t)m * 512 + cbase + 8 * q);
                const unsigned ff[4] = {f.x, f.y, f.z, f.w}, bb[4] = {b.x, b.y, b.z, b.w};
#pragma unroll
                for (int e = 0; e < 4; ++e) { const float a0 = bflo(ff[e]) + bflo(bb[e]), a1 = bfhi(ff[e]) + bfhi(bb[e]); o[8 * q + 2 * e] = a0; o[8 * q + 2 * e + 1] = a1; ss += a0 * a0 + a1 * a1; } }
            ss += __shfl_xor(ss, 1); ss += __shfl_xor(ss, 2);
            const float rr = 1.0f / sqrtf(ss * (1.0f / 128.0f) + EPS);
#pragma unroll
            for (int q = 0; q < 4; ++q) { const u32x4 g = *(const u32x4*)(P + (size_t)m * NIN + 2048 + cbase + 8 * q); const unsigned gg[4] = {g.x, g.y, g.z, g.w};
                const f32x4 w0 = *(const f32x4*)(A->hg_norm_w + l * 512 + cbase + 8 * q), w1 = *(const f32x4*)(A->hg_norm_w + l * 512 + cbase + 8 * q + 4);
                const float ww[8] = {w0.x, w0.y, w0.z, w0.w, w1.x, w1.y, w1.z, w1.w};
                unsigned pk[4];
#pragma unroll
                for (int e = 0; e < 4; ++e) pk[e] = pkbf(o[8 * q + 2 * e] * rr * ww[2 * e] * bflo(gg[e]), o[8 * q + 2 * e + 1] * rr * ww[2 * e + 1] * bfhi(gg[e]));
                *(u32x4*)(MG + (size_t)m * DM + cbase + 8 * q) = (u32x4){pk[0], pk[1], pk[2], pk[3]}; }
        }
        __syncthreads();
        {
            float y[32]; float ss = 0.f;
#pragma unroll
            for (int q = 0; q < 4; ++q) { const u32x4 v = *(const LAS u32x4*)(lds + j * RS + 2 * (cbase + 8 * q)); const unsigned vv[4] = {v.x, v.y, v.z, v.w};
#pragma unroll
                for (int e = 0; e < 4; ++e) { const float a0 = bflo(vv[e]), a1 = bfhi(vv[e]); y[8 * q + 2 * e] = a0; y[8 * q + 2 * e + 1] = a1; ss += a0 * a0 + a1 * a1; } }
            ss += __shfl_xor(ss, 1); ss += __shfl_xor(ss, 2); ss += __shfl_xor(ss, 4); ss += __shfl_xor(ss, 8);
            const float rr = 1.0f / sqrtf(ss * (1.0f / 512.0f) + EPS);
#pragma unroll
            for (int q = 0; q < 4; ++q) { const f32x4 w0 = *(const f32x4*)(A->hy_norm_w + l * 512 + cbase + 8 * q), w1 = *(const f32x4*)(A->hy_norm_w + l * 512 + cbase + 8 * q + 4);
                const float ww[8] = {w0.x, w0.y, w0.z, w0.w, w1.x, w1.y, w1.z, w1.w};
                unsigned pk[4];
#pragma unroll
                for (int e = 0; e < 4; ++e) pk[e] = pkbf(y[8 * q + 2 * e] * rr * ww[2 * e], y[8 * q + 2 * e + 1] * rr * ww[2 * e + 1]);
                *(u32x4*)(MG + (size_t)m * DM + 512 + cbase + 8 * q) = (u32x4){pk[0], pk[1], pk[2], pk[3]}; }
        }
        __syncthreads();
    }
}

__global__ void __launch_bounds__(512, 2) mk_fwd(Args KP) {
    extern __shared__ __attribute__((aligned(16))) unsigned char lds_raw[];
    lds_t* lds = (lds_t*)lds_raw;
    const int tid = threadIdx.x;
    volatile LAS unsigned* MISC = (volatile LAS unsigned*)(lds + MISC_OFF);
    if (tid < 64) MISC[tid] = 0u;
    __syncthreads();
    if (MK_N_LAUNCHES == 1) (void)xcd_barrier_post((unsigned*)(KP.ws + WS_CTL) + CW_BAR, MISC + 8);
    const int lo = KP.ph_lo, hi = KP.ph_hi;
    if (PROBE_PH == 0 && threadIdx.x == 0) *(volatile LAS unsigned long long*)(lds + MISC_OFF + 128) = __builtin_amdgcn_s_memrealtime();
#define IN(k) (lo <= (k) && (k) < hi)
#define SEAM(k) do { PSTAMP(k); } while (0)
#define SEAM_(k) do { if (IN(k) && IN((k) + 1)) { KArgs A_ = kargs(); XcdBarrier b_; b_.bar = (unsigned*)(A_->ws + WS_CTL) + CW_BAR; b_.x = xb_xcc_id(); b_.st = (volatile LAS unsigned*)(lds + MISC_OFF) + 8; xcd_barrier(b_); } } while (0)
#define PSTAMP(k) do { SEAM_(k); if (PROBE_PH == (k) + 1 && threadIdx.x == 0) *(volatile LAS unsigned long long*)(lds + MISC_OFF + 128) = __builtin_amdgcn_s_memrealtime(); if (PROBE_PH == (k) && threadIdx.x == 0) *(volatile LAS unsigned long long*)(lds + MISC_OFF + 136) = __builtin_amdgcn_s_memrealtime(); } while (0)
#define MODP(A) ((const float*)((A)->ws + WS_CTL) + CW_MOD)
#define HP(A) ((bf16_t*)((A)->ws + WS_H))

    if (IN(0)) { KArgs A = kargs(); phase_p0a(A, lds); } SEAM(0);
    if (IN(1)) { KArgs A = kargs(); phase_p0b(A, lds); } SEAM(1);
#define LAYER_BODY(l) do { \
        const int pb = 2 + 7 * l; \
        if (IN(pb + 0)) { \
            KArgs A = kargs(); \
            pg8::Gemm g{HP(A), (const bf16_t*)(A->ws + WS_WIN) + (size_t)l * NIN * DM, TT, NIN, DM}; pg8::StaticOrder S; S.init(TT, NIN, gridDim.x, blockIdx.x); \
            pg8::EpiProj E{(bf16_t*)(A->ws + WS_P), (const float*)(A->ws + WS_LBT) + l * 1024, (const float*)(A->ws + WS_RSP), (const float*)(A->ws + WS_BIAS) + (size_t)l * 9 * NIN, (LAS float*)(lds + XCH_OFF + 8192)}; \
            pg8::gemm_phase<pg8::EpiProj, pg8::StaticOrder, true, true>(lds, g, S, E); \
        } SEAM(pb + 0); \
        if (IN(pb + 1)) { KArgs A = kargs(); phase_hyprep(A, l, lds); } SEAM(pb + 1); \
        if (IN(pb + 2)) { KArgs A = kargs(); phase_mixer(A, l, lds); } SEAM(pb + 2); \
        if (IN(pb + 3)) { KArgs A = kargs(); phase_merge(A, l, lds); } SEAM(pb + 3); \
        if (IN(pb + 4)) { \
            KArgs A = kargs(); float* XA = A->out; \
            pg8::Gemm g{(const bf16_t*)(A->ws + WS_MERGED), (const bf16_t*)(A->ws + WS_WOUT) + (size_t)l * DM * DM, TT, DM, DM}; pg8::StaticOrder S; S.init(TT, DM, gridDim.x, blockIdx.x); \
            pg8::EpiResid E{l == 0 ? A->x_prompt : XA, l == 0 ? A->x_sample : XA + (size_t)TP * DM, XA, MODP(A) + (size_t)l * 9 * NMOD + 2048, \
                            HP(A), A->norm2_w + l * DM, MODP(A) + (size_t)l * 9 * NMOD + 4096, (float*)(A->ws + WS_RSP), (LAS float*)(lds + XCH_OFF)}; \
            pg8::gemm_phase<pg8::EpiResid, pg8::StaticOrder, true, true>(lds, g, S, E); \
        } SEAM(pb + 4); \
        if (IN(pb + 5)) { \
            KArgs A = kargs(); \
            pg8::Gemm g{HP(A), (const bf16_t*)(A->ws + WS_WUP) + (size_t)l * NUP * DM, TT, NUP, DM}; pg8::StaticOrder S; S.init(TT, NUP, gridDim.x, blockIdx.x); \
            pg8::EpiFfn E{(bf16_t*)(A->ws + WS_P), A->ffn_conv_w + (size_t)l * 3 * NUP, (LAS float*)(lds + XCH_OFF), (const float*)(A->ws + WS_RSP), (const float*)(A->ws + WS_BIAS + BIAS2_OFF) + (size_t)l * 9 * NUP, (LAS float*)(lds + XCH_OFF + 8192)}; \
            pg8::gemm_phase<pg8::EpiFfn, pg8::StaticOrder, true, true>(lds, g, S, E); \
        } SEAM(pb + 5); \
        if (IN(pb + 6)) { \
            KArgs A = kargs(); float* XA = A->out; \
            pg8::Gemm g{(const bf16_t*)(A->ws + WS_P), (const bf16_t*)(A->ws + WS_WDN) + (size_t)l * DM * DFF, TT, DM, DFF}; pg8::StaticOrder S; S.init(TT, DM, gridDim.x, blockIdx.x); \
            pg8::EpiResid E{XA, XA + (size_t)TP * DM, XA, MODP(A) + (size_t)l * 9 * NMOD + 5120, \
                            l == 0 ? HP(A) : (bf16_t*)nullptr, A->norm1_w + DM, MODP(A) + (size_t)9 * NMOD + 1024, (float*)(A->ws + WS_RSP), (LAS float*)(lds + XCH_OFF)}; \
            pg8::gemm_phase<pg8::EpiResid, pg8::StaticOrder, true, true>(lds, g, S, E); \
        } SEAM(pb + 6); \
    } while (0)
    LAYER_BODY(0);
    LAYER_BODY(1);
#undef LAYER_BODY
    if (IN(16)) { KArgs A = kargs(); phase_final_norm(A); }
    if (PROBE_PH >= 0) { if (PROBE_PH == NPH - 1 && threadIdx.x == 0) *(volatile LAS unsigned long long*)(lds + MISC_OFF + 136) = __builtin_amdgcn_s_memrealtime();
        if (blockIdx.x == 0 && threadIdx.x == 0) { const unsigned long long pt0 = *(volatile LAS unsigned long long*)(lds + MISC_OFF + 128), pt1 = *(volatile LAS unsigned long long*)(lds + MISC_OFF + 136); const unsigned long long t_end = __builtin_amdgcn_s_memrealtime(), w = 8ull * (pt1 - pt0); while (__builtin_amdgcn_s_memrealtime() - t_end < w) __builtin_amdgcn_s_sleep(32); } }
#undef IN
#undef SEAM
}

extern "C" void kernel_launch(void* const* d_in, const int* in_sizes, int n_in, void* d_out, int out_size, void* d_ws, size_t ws_size, hipStream_t stream) {
    static int grid = 0;
    if (grid == 0) {
        if (n_in != 28 || ws_size < WS_END) { fprintf(stderr, "kernel_launch: unexpected inputs (n_in %d, ws %zu)\n", n_in, ws_size); grid = -1; return; }
        int dev = 0, cus = 0;
        if (hipGetDevice(&dev) != hipSuccess || hipDeviceGetAttribute(&cus, hipDeviceAttributeMultiprocessorCount, dev) != hipSuccess) { grid = -1; return; }
        if (hipFuncSetAttribute((const void*)mk_fwd, hipFuncAttributeMaxDynamicSharedMemorySize, LDS_BYTES) != hipSuccess) { fprintf(stderr, "kernel_launch: hipFuncSetAttribute failed\n"); grid = -1; return; }
        int per_cu = 0;
        if (hipOccupancyMaxActiveBlocksPerMultiprocessor(&per_cu, (const void*)mk_fwd, 512, LDS_BYTES) != hipSuccess || per_cu < 1) fprintf(stderr, "kernel_launch: occupancy query reports %d\n", per_cu);
        (void)hipGetLastError();
        grid = cus;
    }
    if (grid < 0) return;
    (void)hipMemsetAsync((char*)d_ws + WS_CTL, 0, CTL_BYTES, stream);
    Args a{};
    const float** ap = (const float**)&a;
    for (int i = 0; i < 28; ++i) ap[i] = (const float*)d_in[i];
    a.out = (float*)d_out; a.ws = (unsigned char*)d_ws;
    if (MK_N_LAUNCHES == 1) { a.ph_lo = 0; a.ph_hi = NPH; hipLaunchKernelGGL(mk_fwd, dim3(grid), dim3(512), LDS_BYTES, stream, a); }
    else { for (int p = 0; p < NPH; ++p) { a.ph_lo = p; a.ph_hi = p + 1; hipLaunchKernelGGL(mk_fwd, dim3(grid), dim3(512), LDS_BYTES, stream, a); } }
}
```

```cpp
#include <hip/hip_runtime.h>
#include <cstdio>
#include <cstdint>

#define DI __device__ __forceinline__
#define LAS __attribute__((address_space(3)))
#define GAS __attribute__((address_space(1)))
typedef unsigned short bf16_t;
typedef short bf16x8 __attribute__((ext_vector_type(8)));
typedef float f32x4 __attribute__((ext_vector_type(4)));
typedef float f32x16 __attribute__((ext_vector_type(16)));
typedef unsigned u32x4 __attribute__((ext_vector_type(4)));
typedef unsigned u32x2 __attribute__((ext_vector_type(2)));
typedef float f32x2_t __attribute__((ext_vector_type(2)));
typedef __bf16 bf16x2_t __attribute__((ext_vector_type(2)));
typedef LAS unsigned char lds_t;

#ifndef PROBE_PH
#define PROBE_PH (-1)
#endif
#ifndef MK_N_LAUNCHES
#define MK_N_LAUNCHES 1
#endif

constexpr int DM = 1024, TP = 4096, TS = 8192, TT = 12288, NIN = 4096, DFF = 2816, NUP = 5632, NMOD = 6144;
constexpr int NPH = 17;
constexpr float EPS = 1e-6f;

constexpr size_t MiB = 1u << 20;
constexpr size_t WS_CTL = 0, CTL_BYTES = 1 * MiB;
constexpr size_t WS_LBT = 1 * MiB;
constexpr size_t WS_BIAS = 1 * MiB + 64 * 1024;
constexpr size_t BIAS2_OFF = 2 * 9 * 4096 * 4;
constexpr size_t WS_RSP = 2 * MiB;
constexpr size_t WS_GF = 3 * MiB;
constexpr size_t GF_LSTRIDE = 2560 * 1024, GF_SAMPLE_OFF = 512 * 1024;
constexpr size_t WS_WIN = 10 * MiB, WS_WOUT = 26 * MiB, WS_WUP = 30 * MiB, WS_WDN = 52 * MiB;
constexpr size_t WS_H = 64 * MiB;
constexpr size_t WS_MERGED = 88 * MiB;
constexpr size_t WS_P = 112 * MiB;
constexpr size_t WS_UT = 208 * MiB, WS_X2T = 220 * MiB;
constexpr size_t WS_END = 232 * MiB;
constexpr int CW_BAR = 4096;
constexpr int CW_QUEUE = 8192;
constexpr int CW_HYABS = 9216;
constexpr int CW_MOD = 16384;
static_assert((CW_MOD + 2 * 9 * NMOD) * 4 <= (int)CTL_BYTES, "ctl");

constexpr int LDS_BYTES = 163840;
constexpr int RING_BYTES = 131072;
constexpr int XCH_OFF = 131072;
constexpr int MISC_OFF = 163840 - 256;

DI unsigned pkbf(float lo, float hi) { f32x2_t v = {lo, hi}; bf16x2_t b = __builtin_convertvector(v, bf16x2_t); return __builtin_bit_cast(unsigned, b); }
DI float bflo(unsigned u) { return __uint_as_float(u << 16); }
DI float bfhi(unsigned u) { return __uint_as_float(u & 0xffff0000u); }
DI float bf1(bf16_t h) { return __uint_as_float(((unsigned)h) << 16); }
DI float silu_f(float x) { return x * __builtin_amdgcn_rcpf(1.0f + __expf(-x)); }
DI float wave_sum(float v) {
#pragma unroll
    for (int o = 1; o < 64; o <<= 1) v += __shfl_xor(v, o);
    return v;
}
DI int ltid() { int t = threadIdx.x; asm volatile("" : "+v"(t)); return t; }
DI int crow(int reg, int hh) { return (reg & 3) + 8 * (reg >> 2) + 4 * hh; }
DI int cid_of_tile(int pm) { return pm < 16 ? 0 : 1 + ((pm - 16) >> 2); }
DI int cid_of_row(int m) { return m < TP ? 0 : 1 + ((m - TP) >> 10); }
#define MFMA32(a, b, c) __builtin_amdgcn_mfma_f32_32x32x16_bf16((a), (b), (c), 0, 0, 0)
#define LDS_WAIT() asm volatile("s_waitcnt lgkmcnt(0)" ::: "memory")
#define VM_WAIT() asm volatile("s_waitcnt vmcnt(0)" ::: "memory")
#define BAR_LDS() do { asm volatile("s_waitcnt lgkmcnt(0)" ::: "memory"); __builtin_amdgcn_s_barrier(); asm volatile("" ::: "memory"); } while (0)

namespace pg8 {
#define PG8_LAS __attribute__((address_space(3)))
constexpr int BM = 256, BK = 64, HALF = 128, HTB = HALF * BK * 2, STAGE_BYTES = 8 * HTB, NXCD = 8, WGM = 8;
__host__ __device__ __forceinline__ int lds_byte(int r, int c) { const int st = (r >> 4) * 2 + (c >> 5), rr = r & 15, cc = c & 31, ob = rr * 64 + cc * 2; return st * 1024 + (ob ^ (((ob >> 9) & 1) << 5)); }
__host__ __device__ __forceinline__ void stage_rc(int b, int& R, int& C) { const int st = b / 1024, sb = b % 1024, swz = sb ^ (((sb >> 9) & 1) << 5); R = (st >> 1) * 16 + swz / 64; C = (st & 1) * 32 + (swz % 64) / 2; }
__host__ __device__ __forceinline__ int perm32(int rho) { const int n = rho >> 4, i = rho & 15; return 8 * (i >> 2) + 4 * n + (i & 3); }
struct Unit { int pm, pn; };
struct Gemm { const bf16_t* A; const bf16_t* Bt; int M, N, K; };
struct StaticOrder {
    int nM, nN, nwg, G, c;
    __host__ __device__ void init(int M, int N, int G_, int c_) { nM = M / BM; nN = N / BM; nwg = nM * nN; G = G_; c = c_; }
    __host__ __device__ bool next(int i, Unit& u) const {
        const long L = (long)i * G + c; if (L >= nwg) return false;
        int wgid = (int)L; { const int q = nwg / NXCD, r = nwg % NXCD, xcd = wgid % NXCD, off = wgid / NXCD; wgid = (xcd < r ? xcd * (q + 1) : r * (q + 1) + (xcd - r) * q) + off; }
        const int nig = WGM * nN, gid = wgid / nig, fm = gid * WGM, gsz = (nM - fm) < WGM ? (nM - fm) : WGM;
        u.pm = fm + ((wgid % nig) % gsz); u.pn = (wgid % nig) / gsz; return true;
    }
    __device__ __forceinline__ void a_ready(const Unit&) const {}
    __device__ __forceinline__ void done(const Unit&) const {}
};


struct RNext { f32x4 a; };
__device__ __forceinline__ void rnext_load(RNext& q, const float* rsp, int pm, int tid, bool on) {
    q.a = (f32x4){0.f, 0.f, 0.f, 0.f};
    if (on) q.a = *(const f32x4*)(rsp + (size_t)(pm * BM + (tid & 255)) * 4);
}
__device__ __forceinline__ void rnext_store(const RNext& q, PG8_LAS float* R, int par, int tid, bool on) {
    if (on) { const float sm = (q.a.x + q.a.y) + (q.a.z + q.a.w); R[par * 256 + (tid & 255)] = 1.0f / sqrtf(sm * (1.0f / 1024.0f) + 1e-6f); }
}
struct EpiProj {
    static constexpr bool PERM = true, AFTER_DRAIN = false;
    bf16_t* P; const float* lbt; const float* rsp; const float* bias; PG8_LAS float* R;
    __device__ __forceinline__ void first(const Unit& u) const { const int tid = threadIdx.x; RNext q; rnext_load(q, rsp, u.pm, tid, tid < 256); rnext_store(q, R, 0, tid, tid < 256); }
    __device__ __forceinline__ void operator()(f32x4 (&acc)[2][2][4][2], const Unit& u, int wr, int wc, int fr, int fq, const Unit& nx, bool has_next, int ui) const {
        const int tid = (wr * 4 + wc) * 64 + fq * 16 + fr; const bool pre = has_next && wr == 0;
        RNext rq; rnext_load(rq, rsp, nx.pm, tid, pre);
        PG8_LAS const float* Rc = R + (ui & 1) * 256;
        const int row0 = u.pm * BM + wr * 64 + fr, typ = u.pn >> 1, col0 = u.pn * BM + wc * 32 + 8 * fq;
        const float* bp = bias + cid_of_tile(u.pm) * NIN + col0;
        float rr[2][4];
#pragma unroll
        for (int ai = 0; ai < 2; ++ai)
#pragma unroll
            for (int m = 0; m < 4; ++m) rr[ai][m] = Rc[ai * HALF + wr * 64 + m * 16 + fr];
#pragma unroll
        for (int bj = 0; bj < 2; ++bj) {
            float lb[8], bs[8];
            { const f32x4 b0 = *(const f32x4*)(bp + bj * HALF), b1 = *(const f32x4*)(bp + bj * HALF + 4); bs[0] = b0.x; bs[1] = b0.y; bs[2] = b0.z; bs[3] = b0.w; bs[4] = b1.x; bs[5] = b1.y; bs[6] = b1.z; bs[7] = b1.w; }
#pragma unroll
            for (int i = 0; i < 8; ++i) lb[i] = 0.f;
            if (typ == 1 || typ == 2) {
                const float* lp = lbt + (typ - 1) * 512 + (col0 + bj * HALF - 512 * typ);
#pragma unroll
                for (int i = 0; i < 8; ++i) lb[i] = lp[i];
            }
#pragma unroll
            for (int ai = 0; ai < 2; ++ai)
#pragma unroll
                for (int m = 0; m < 4; ++m) {
                    float x[8];
#pragma unroll
                    for (int n = 0; n < 2; ++n)
#pragma unroll
                        for (int e = 0; e < 4; ++e) x[4 * n + e] = acc[ai][bj][m][n][e] * rr[ai][m] + bs[4 * n + e];
                    if (typ == 0) {
#pragma unroll
                        for (int i = 0; i < 8; ++i) x[i] = silu_f(x[i]) * 0.08838834764831845f;
                    } else if (typ == 1 || typ == 2) {
#pragma unroll
                        for (int i = 0; i < 8; ++i) { const float sg = __builtin_amdgcn_rcpf(1.0f + __expf(-x[i])); x[i] = __logf(lb[i] + (1.0f - lb[i]) * sg); }
                    } else if (typ == 4) {
#pragma unroll
                        for (int i = 0; i < 8; ++i) x[i] = silu_f(x[i]);
                    }
                    u32x4 w; w.x = pkbf(x[0], x[1]); w.y = pkbf(x[2], x[3]); w.z = pkbf(x[4], x[5]); w.w = pkbf(x[6], x[7]);
                    *(u32x4*)(P + (size_t)(row0 + ai * HALF + m * 16) * NIN + col0 + bj * HALF) = w;
                }
        }
        rnext_store(rq, R, (ui + 1) & 1, tid, pre);
    }
};

struct EpiResid {
    static constexpr bool PERM = false, AFTER_DRAIN = false;
    const float* bp; const float* bs; float* out; const float* gate;
    bf16_t* Hn; const float* nw; const float* sc; float* rsp; PG8_LAS float* PS;
    __device__ __forceinline__ void first(const Unit&) const {}
    __device__ __forceinline__ void operator()(f32x4 (&acc)[2][2][4][2], const Unit& u, int wr, int wc, int fr, int fq, const Unit&, bool, int) const {
        const int row0 = u.pm * BM + wr * 64 + fr, col0 = u.pn * BM + wc * 32 + 4 * fq, cid = cid_of_tile(u.pm);
        const float* base = (u.pm < 16) ? bp : (bs - (size_t)TP * DM);
        f32x4 gv[2][2], cv[2][2];
#pragma unroll
        for (int bj = 0; bj < 2; ++bj)
#pragma unroll
            for (int n = 0; n < 2; ++n) { gv[bj][n] = *(const f32x4*)(gate + cid * NMOD + col0 + bj * HALF + n * 16);
                cv[bj][n] = (f32x4){0.f, 0.f, 0.f, 0.f};
                if (Hn) cv[bj][n] = *(const f32x4*)(nw + col0 + bj * HALF + n * 16) * (1.0f + *(const f32x4*)(sc + cid * NMOD + col0 + bj * HALF + n * 16)); }
#pragma unroll
        for (int ai = 0; ai < 2; ++ai)
#pragma unroll
            for (int m = 0; m < 4; ++m) { const int row = row0 + ai * HALF + m * 16; const size_t off = (size_t)row * DM + col0; float ps = 0.f;
#pragma unroll
                for (int bj = 0; bj < 2; ++bj)
#pragma unroll
                    for (int n = 0; n < 2; ++n) { const f32x4 b = *(const f32x4*)(base + off + bj * HALF + n * 16); const f32x4 o = b + gv[bj][n] * acc[ai][bj][m][n]; *(f32x4*)(out + off + bj * HALF + n * 16) = o;
                        if (Hn) { ps += (o.x * o.x + o.y * o.y) + (o.z * o.z + o.w * o.w); const f32x4 a = o * cv[bj][n]; u32x2 pk; pk.x = pkbf(a.x, a.y); pk.y = pkbf(a.z, a.w); *(u32x2*)(Hn + off + bj * HALF + n * 16) = pk; } }
                if (Hn) { ps += __shfl_xor(ps, 16); ps += __shfl_xor(ps, 32); if (fq == 0) PS[wc * 256 + ai * HALF + wr * 64 + m * 16 + fr] = ps; } }
        if (Hn) {
            asm volatile("s_waitcnt lgkmcnt(0)" ::: "memory"); __builtin_amdgcn_s_barrier(); asm volatile("" ::: "memory");
            const int tid = (wr * 4 + wc) * 64 + fq * 16 + fr;
            if (tid < 256) rsp[(size_t)(u.pm * BM + tid) * 4 + u.pn] = (PS[tid] + PS[256 + tid]) + (PS[512 + tid] + PS[768 + tid]);
        }
    }
};

struct EpiFfn {
    static constexpr bool PERM = true, AFTER_DRAIN = false;
    bf16_t* ACT; const float* cw; PG8_LAS float* X; const float* rsp; const float* bias; PG8_LAS float* R;
    __device__ __forceinline__ void first(const Unit& u) const { const int tid = threadIdx.x; RNext q; rnext_load(q, rsp, u.pm, tid, tid < 256); rnext_store(q, R, 0, tid, tid < 256); }
    __device__ __forceinline__ void operator()(f32x4 (&acc)[2][2][4][2], const Unit& u, int wr, int wc, int fr, int fq, const Unit& nx, bool has_next, int ui) const {
        const bool prompt = u.pm < 16;
        const int lane = fq * 16 + fr;
        const int cc0 = wc * 32 + 8 * fq, fbase = u.pn * HALF + cc0;
        const int tid = (wr * 4 + wc) * 64 + lane; const bool pre = has_next && wr == 0;
        RNext rq; rnext_load(rq, rsp, nx.pm, tid, pre);
        PG8_LAS const float* Rc = R + (ui & 1) * 256;
        {
            const float* bp = bias + cid_of_tile(u.pm) * NUP + u.pn * BM + cc0;
#pragma unroll
            for (int bj = 0; bj < 2; ++bj)
#pragma unroll
                for (int n = 0; n < 2; ++n) { const f32x4 bv = *(const f32x4*)(bp + bj * HALF + 4 * n);
#pragma unroll
                    for (int ai = 0; ai < 2; ++ai)
#pragma unroll
                        for (int m = 0; m < 4; ++m) acc[ai][bj][m][n] = acc[ai][bj][m][n] * Rc[ai * HALF + wr * 64 + m * 16 + fr] + bv; }
        }
        const int src_prev = (lane & 48) | ((fr + 15) & 15), src_next = (lane & 48) | ((fr + 1) & 15);
        if (prompt) {
#pragma unroll
            for (int ai = 0; ai < 2; ++ai) { const int slab = 2 * ai + wr;
#pragma unroll
                for (int bj = 0; bj < 2; ++bj)
#pragma unroll
                    for (int n = 0; n < 2; ++n) {
                        if (fr == 0) *(PG8_LAS f32x4*)(X + (slab * 2 + 0) * 256 + bj * HALF + cc0 + 4 * n) = acc[ai][bj][0][n];
                        if (fr == 15) *(PG8_LAS f32x4*)(X + (slab * 2 + 1) * 256 + bj * HALF + cc0 + 4 * n) = acc[ai][bj][3][n];
                    } }
            asm volatile("s_waitcnt lgkmcnt(0)" ::: "memory"); __builtin_amdgcn_s_barrier(); asm volatile("" ::: "memory");
        }
#pragma unroll
        for (int n = 0; n < 2; ++n) {
            f32x4 wg[3], wv[3];
#pragma unroll
            for (int j = 0; j < 3; ++j) { wg[j] = *(const f32x4*)(cw + j * NUP + fbase + 4 * n); wv[j] = *(const f32x4*)(cw + j * NUP + DFF + fbase + 4 * n); }
#pragma unroll
            for (int ai = 0; ai < 2; ++ai) {
                const int slab = 2 * ai + wr;
                f32x4 hp[2], hn[2];
#pragma unroll
                for (int bj = 0; bj < 2; ++bj) { hp[bj] = (f32x4){0.f, 0.f, 0.f, 0.f}; hn[bj] = (f32x4){0.f, 0.f, 0.f, 0.f}; }
                if (prompt) {
#pragma unroll
                    for (int bj = 0; bj < 2; ++bj) {
                        if (fr == 0 && slab > 0) hp[bj] = *(PG8_LAS f32x4*)(X + ((slab - 1) * 2 + 1) * 256 + bj * HALF + cc0 + 4 * n);
                        if (fr == 15 && slab < 3) hn[bj] = *(PG8_LAS f32x4*)(X + ((slab + 1) * 2 + 0) * 256 + bj * HALF + cc0 + 4 * n);
                    }
                }
#pragma unroll
                for (int m = 0; m < 4; ++m) {
                    float cv[2][4];
#pragma unroll
                    for (int bj = 0; bj < 2; ++bj)
#pragma unroll
                        for (int e = 0; e < 4; ++e) {
                            const float c = acc[ai][bj][m][n][e];
                            const float r1 = __shfl(c, src_prev), r15 = __shfl(c, src_next);
                            float pm1, pn1;
                            if (m > 0) pm1 = __shfl(acc[ai][bj][m > 0 ? m - 1 : 0][n][e], src_prev); else pm1 = hp[bj][e];
                            if (m < 3) pn1 = __shfl(acc[ai][bj][m < 3 ? m + 1 : 3][n][e], src_next); else pn1 = hn[bj][e];
                            const float p = (fr == 0) ? pm1 : r1, nx = (fr == 15) ? pn1 : r15;
                            const float w0 = bj ? wv[0][e] : wg[0][e], w1 = bj ? wv[1][e] : wg[1][e], w2 = bj ? wv[2][e] : wg[2][e];
                            cv[bj][e] = w0 * p + w1 * c + w2 * nx;
                        }
                    u32x2 w; w.x = pkbf(silu_f(cv[0][0]) * cv[1][0], silu_f(cv[0][1]) * cv[1][1]); w.y = pkbf(silu_f(cv[0][2]) * cv[1][2], silu_f(cv[0][3]) * cv[1][3]);
                    *(u32x2*)(ACT + (size_t)(u.pm * BM + ai * HALF + wr * 64 + m * 16 + fr) * DFF + fbase + 4 * n) = w;
                }
            }
        }
        rnext_store(rq, R, (ui + 1) & 1, tid, pre);
    }
};

template <class Epi, class Sched, bool ALIGN_EPI = false, bool SP2 = false>
__device__ __forceinline__ void gemm_phase(PG8_LAS unsigned char* lds, const Gemm g, const Sched& S, const Epi& E) {
    const int tid = threadIdx.x, wid = __builtin_amdgcn_readfirstlane(tid >> 6), lane = tid & 63, wr = wid >> 2, wc = wid & 3, fr = lane & 15, fq = lane >> 4;
    const int K = g.K, nt = K / BK;
    unsigned voffA[2], voffB[2];
#pragma unroll
    for (int i = 0; i < 2; ++i) { int R, C; stage_rc(tid * 16 + i * 8192, R, C); const int Rb = Epi::PERM ? ((R & ~31) + perm32(R & 31)) : R;
        voffA[i] = (unsigned)(R * K + C) * 2u; voffB[i] = (unsigned)(Rb * K + C) * 2u; }
    const size_t kstep = (size_t)(BK * 2);
    const size_t hstep = (size_t)HALF * K * 2;
    const size_t tstep = 2 * hstep;
    const unsigned ldsw = (unsigned)wid * 1024u;
    const int aoff = lds_byte(wr * 64 + fr, fq * 8), boff = lds_byte(wc * 32 + fr, fq * 8);
#define PG8_SA(b, h) (((b) * 2 + (h)) * HTB)
#define PG8_SB(b, h) ((4 + (b) * 2 + (h)) * HTB)
#define PG8_STAGE(bufoff, gbase, voff) do { _Pragma("unroll") for (int _i = 0; _i < 2; ++_i) \
        __builtin_amdgcn_global_load_lds((const unsigned*)((const char*)(gbase) + (voff)[_i]), (PG8_LAS unsigned*)(lds + (bufoff) + ldsw + _i * 8192), 16, 0, 0); } while (0)
#define PG8_LDA(dst, b, h) do { _Pragma("unroll") for (int m = 0; m < 4; ++m) _Pragma("unroll") for (int k = 0; k < 2; ++k) dst[m][k] = *(const PG8_LAS bf16x8*)(lds + PG8_SA(b, h) + aoff + m * 2048 + k * 1024); } while (0)
#define PG8_LDB(dst, b, h) do { _Pragma("unroll") for (int n = 0; n < 2; ++n) _Pragma("unroll") for (int k = 0; k < 2; ++k) dst[n][k] = *(const PG8_LAS bf16x8*)(lds + PG8_SB(b, h) + boff + n * 2048 + k * 1024); } while (0)
#define PG8_MMA(ai, bj, At, Bt) do { __builtin_amdgcn_s_setprio(1); _Pragma("unroll") for (int m = 0; m < 4; ++m) _Pragma("unroll") for (int n = 0; n < 2; ++n) _Pragma("unroll") for (int k = 0; k < 2; ++k) \
        acc[ai][bj][m][n] = __builtin_amdgcn_mfma_f32_16x16x32_bf16(Bt[n][k], At[m][k], acc[ai][bj][m][n], 0, 0, 0); __builtin_amdgcn_s_setprio(0); } while (0)
#define PG8_WAIT_V(n) asm volatile("s_waitcnt vmcnt(" #n ")" ::: "memory")
#define PG8_WAIT_L(n) asm volatile("s_waitcnt lgkmcnt(" #n ")" ::: "memory")
#define PG8_BAR __builtin_amdgcn_s_barrier()
#define PG8_SCHED __builtin_amdgcn_sched_barrier(0)
    Unit cur, nxt; int ui = 0;
    if (!S.next(0, cur)) return;
    f32x4 acc[2][2][4][2];
#pragma unroll
    for (int a = 0; a < 2; ++a)
#pragma unroll
        for (int b = 0; b < 2; ++b)
#pragma unroll
            for (int m = 0; m < 4; ++m)
#pragma unroll
                for (int n = 0; n < 2; ++n) acc[a][b][m][n] = (f32x4){0.f, 0.f, 0.f, 0.f};
    bf16x8 At[4][2], B0[2][2], B1[2][2];
    const char* cA = (const char*)g.A + (size_t)cur.pm * tstep; const char* cB = (const char*)g.Bt + (size_t)cur.pn * tstep;
    S.a_ready(cur);
    E.first(cur);
    if constexpr (SP2) {
        PG8_STAGE(PG8_SB(0, 0), cB, voffB); PG8_STAGE(PG8_SB(0, 1), cB + hstep, voffB); PG8_STAGE(PG8_SA(0, 0), cA, voffA); PG8_STAGE(PG8_SA(0, 1), cA + hstep, voffA);
        if (wr == 1) PG8_BAR;
        PG8_WAIT_V(2); PG8_BAR;
        PG8_STAGE(PG8_SB(1, 0), cB + kstep, voffB); PG8_STAGE(PG8_SA(1, 0), cA + kstep, voffA); PG8_STAGE(PG8_SB(1, 1), cB + hstep + kstep, voffB);
        PG8_WAIT_V(6); PG8_BAR;
    } else {
        PG8_STAGE(PG8_SB(0, 0), cB, voffB); PG8_STAGE(PG8_SA(0, 0), cA, voffA); PG8_STAGE(PG8_SB(0, 1), cB + hstep, voffB); PG8_STAGE(PG8_SA(0, 1), cA + hstep, voffA);
        if (wr == 1) PG8_BAR;
        PG8_WAIT_V(4); PG8_BAR;
        PG8_STAGE(PG8_SB(1, 0), cB + kstep, voffB); PG8_STAGE(PG8_SA(1, 0), cA + kstep, voffA); PG8_STAGE(PG8_SB(1, 1), cB + hstep + kstep, voffB);
        PG8_WAIT_V(6); PG8_BAR;
    }
    for (;;) {
        const bool has_next = S.next(ui + 1, nxt);
        const char* nA = has_next ? (const char*)g.A + (size_t)nxt.pm * tstep : cA; const char* nB = has_next ? (const char*)g.Bt + (size_t)nxt.pn * tstep : cB;
        for (int t = 0; t < nt; t += 2) {
            const bool last = (t == nt - 2);
            const char* a1 = cA + (size_t)(t + 1) * kstep;
            const char* a2 = last ? nA : cA + (size_t)(t + 2) * kstep; const char* b2 = last ? nB : cB + (size_t)(t + 2) * kstep;
            const char* a3 = a2 + kstep; const char* b3 = b2 + kstep;
            if (last && has_next) S.a_ready(nxt);
            if constexpr (SP2) {
            PG8_LDB(B0, 0, 0); PG8_LDB(B1, 0, 1); PG8_SCHED; PG8_LDA(At, 0, 0); PG8_STAGE(PG8_SA(1, 1), a1 + hstep, voffA);
            PG8_WAIT_V(8); PG8_WAIT_L(0); PG8_BAR; PG8_MMA(0, 0, At, B0); PG8_MMA(0, 1, At, B1); PG8_BAR; PG8_SCHED;
            PG8_LDA(At, 0, 1); PG8_STAGE(PG8_SB(0, 0), b2, voffB); PG8_STAGE(PG8_SB(0, 1), b2 + hstep, voffB); PG8_STAGE(PG8_SA(0, 0), a2, voffA);
            PG8_WAIT_V(8); PG8_WAIT_L(0); PG8_BAR; PG8_MMA(1, 0, At, B0); PG8_MMA(1, 1, At, B1); PG8_BAR; PG8_SCHED;
            PG8_LDB(B0, 1, 0); PG8_LDB(B1, 1, 1); PG8_SCHED; PG8_LDA(At, 1, 0); PG8_STAGE(PG8_SA(0, 1), a2 + hstep, voffA);
            PG8_WAIT_V(8); PG8_WAIT_L(0); PG8_BAR; PG8_MMA(0, 0, At, B0); PG8_MMA(0, 1, At, B1); PG8_BAR; PG8_SCHED;
            PG8_LDA(At, 1, 1); PG8_STAGE(PG8_SB(1, 0), b3, voffB); PG8_STAGE(PG8_SB(1, 1), b3 + hstep, voffB); PG8_STAGE(PG8_SA(1, 0), a3, voffA);
            PG8_WAIT_V(8); PG8_WAIT_L(0); PG8_BAR; PG8_MMA(1, 0, At, B0); PG8_MMA(1, 1, At, B1); PG8_BAR; PG8_SCHED;
            } else {
            PG8_LDB(B0, 0, 0); PG8_SCHED; PG8_LDA(At, 0, 0); PG8_STAGE(PG8_SA(1, 1), a1 + hstep, voffA);
            PG8_WAIT_L(8); PG8_BAR; PG8_WAIT_L(0); PG8_MMA(0, 0, At, B0); PG8_BAR; PG8_SCHED;
            PG8_LDB(B1, 0, 1); PG8_STAGE(PG8_SB(0, 0), b2, voffB);
            PG8_BAR; PG8_WAIT_L(0); PG8_MMA(0, 1, At, B1); PG8_BAR;
            PG8_LDA(At, 0, 1); PG8_STAGE(PG8_SA(0, 0), a2, voffA);
            PG8_BAR; PG8_WAIT_L(0); PG8_MMA(1, 0, At, B0); PG8_BAR; PG8_SCHED;
            PG8_STAGE(PG8_SB(0, 1), b2 + hstep, voffB);
            PG8_WAIT_V(6); PG8_BAR; PG8_MMA(1, 1, At, B1); PG8_BAR;
            PG8_LDB(B0, 1, 0); PG8_SCHED; PG8_LDA(At, 1, 0); PG8_STAGE(PG8_SA(0, 1), a2 + hstep, voffA);
            PG8_WAIT_L(8); PG8_BAR; PG8_WAIT_L(0); PG8_MMA(0, 0, At, B0); PG8_BAR; PG8_SCHED;
            PG8_LDB(B1, 1, 1); PG8_STAGE(PG8_SB(1, 0), b3, voffB);
            PG8_BAR; PG8_WAIT_L(0); PG8_MMA(0, 1, At, B1); PG8_BAR;
            PG8_LDA(At, 1, 1); PG8_STAGE(PG8_SA(1, 0), a3, voffA);
            PG8_BAR; PG8_WAIT_L(0); PG8_MMA(1, 0, At, B0); PG8_BAR; PG8_SCHED;
            PG8_STAGE(PG8_SB(1, 1), b3 + hstep, voffB);
            PG8_WAIT_V(6); PG8_BAR; PG8_MMA(1, 1, At, B1); PG8_BAR;
            }
        }
        if constexpr (ALIGN_EPI) { if (wr == 0) PG8_BAR; }
        if constexpr (!Epi::AFTER_DRAIN) { E(acc, cur, wr, wc, fr, fq, nxt, has_next, ui); S.done(cur); }
        if (!has_next) break;
#pragma unroll
        for (int a = 0; a < 2; ++a)
#pragma unroll
            for (int b = 0; b < 2; ++b)
#pragma unroll
                for (int m = 0; m < 4; ++m)
#pragma unroll
                    for (int n = 0; n < 2; ++n) acc[a][b][m][n] = (f32x4){0.f, 0.f, 0.f, 0.f};
        cur = nxt; cA = nA; cB = nB; ++ui;
        if constexpr (ALIGN_EPI) { if (wr == 1) PG8_BAR; }
    }
    PG8_WAIT_V(0);
    if constexpr (!ALIGN_EPI) { if (wr == 0) PG8_BAR; }
    PG8_BAR;
#undef PG8_SA
#undef PG8_SB
#undef PG8_STAGE
#undef PG8_LDA
#undef PG8_LDB
#undef PG8_MMA
#undef PG8_WAIT_V
#undef PG8_WAIT_L
#undef PG8_BAR
#undef PG8_SCHED
}
}

#define XB_TMO      128
#define XB_XCNT(j)  (256  + 64 * (j))
#define XB_XSUB(j)  (1280 + 64 * (j))
#define XB_XGEN(j)  (2304 + 64 * (j))
#define XB_TOP      3328
#define XB_TOPGEN   3392
#define XCD_BAR_WORDS 3456
#define XB_SPIN_CAP (1u << 18)
DI unsigned xb_ld(unsigned* p)              { return __hip_atomic_load(p, __ATOMIC_RELAXED, __HIP_MEMORY_SCOPE_AGENT); }
DI unsigned xb_add(unsigned* p, unsigned v) { return __hip_atomic_fetch_add(p, v, __ATOMIC_RELAXED, __HIP_MEMORY_SCOPE_AGENT); }
DI unsigned xb_xcc_id() { return (unsigned)__builtin_amdgcn_s_getreg((3 << 11) | 20) & 0xFu; }
#define XB_SPIN(cond, bar) do { unsigned _sp = 0; while (cond) { __builtin_amdgcn_s_sleep(1); \
    if ((++_sp & 255u) == 0u) { if (xb_ld(&(bar)[XB_TMO])) break; if (_sp > XB_SPIN_CAP) { atomicAdd(&(bar)[XB_TMO], 1u); break; } } } } while (0)
struct XcdBarrier { unsigned* bar; unsigned x; volatile LAS unsigned* st; };
DI XcdBarrier xcd_barrier_post(unsigned* bar, volatile LAS unsigned* st) {
    XcdBarrier b; b.bar = bar; b.x = xb_xcc_id(); b.st = st;
    if (threadIdx.x == 0) (void)xb_add(&bar[XB_XCNT(b.x)], 1u);
    return b;
}
DI void xcd_barrier_complete(unsigned* bar, unsigned x, unsigned& nloc, unsigned& nx) {
    const unsigned G = gridDim.x * gridDim.y * gridDim.z;
    unsigned sum, cnt, mine, sp = 0u;
    for (;;) {
        sum = 0u; cnt = 0u; mine = 0u;
#pragma unroll
        for (unsigned j = 0; j < 16; ++j) { const unsigned c = xb_ld(&bar[XB_XCNT(j)]); sum += c; cnt += (c > 0u) ? 1u : 0u; mine = (j == x) ? c : mine; }
        if (sum == G) break;
        __builtin_amdgcn_s_sleep(1);
        if ((++sp & 255u) == 0u) { if (xb_ld(&bar[XB_TMO])) break; if (sp > XB_SPIN_CAP) { atomicAdd(&bar[XB_TMO], 1u); break; } }
    }
    nloc = mine > 0u ? mine : 1u; nx = cnt > 0u ? cnt : 1u;
}
DI void xcd_barrier(const XcdBarrier& b) {
    asm volatile("s_waitcnt vmcnt(0)" ::: "memory");
    __syncthreads();
    if (threadIdx.x == 0) {
        unsigned* bar = b.bar;
        __builtin_amdgcn_s_waitcnt(0);
        unsigned nloc = b.st[0], nx = b.st[1];
        if (nloc == 0u) { xcd_barrier_complete(bar, b.x, nloc, nx); b.st[0] = nloc; b.st[1] = nx; }
        const unsigned old = xb_add(&bar[XB_XSUB(b.x)], 1u);
        const unsigned gen = old / nloc;
        if (old + 1u == (gen + 1u) * nloc) {
            __builtin_amdgcn_fence(__ATOMIC_RELEASE, "agent");
            asm volatile("s_waitcnt vmcnt(0)" ::: "memory");
            const unsigned og = xb_add(&bar[XB_TOP], 1u);
            const unsigned tg = og / nx;
            if (og + 1u == (tg + 1u) * nx) xb_add(&bar[XB_TOPGEN], 1u);
            else XB_SPIN(xb_ld(&bar[XB_TOPGEN]) == tg, bar);
            __builtin_amdgcn_fence(__ATOMIC_ACQUIRE, "agent");
            xb_add(&bar[XB_XGEN(b.x)], 1u);
            asm volatile("s_waitcnt vmcnt(0)" ::: "memory");
        } else {
            XB_SPIN(xb_ld(&bar[XB_XGEN(b.x)]) == gen, bar);
            __builtin_amdgcn_fence(__ATOMIC_ACQUIRE, "agent");
            asm volatile("s_waitcnt vmcnt(0)" ::: "memory");
        }
    }
    __syncthreads();
}

struct Args {
    const float* x_prompt; const float* x_sample; const float* state; const float* c; const float* c_ctx;
    const float* w_in; const float* w_out; const float* ada_w; const float* ada_b; const float* norm1_w; const float* norm2_w;
    const float* hg_lb_fwd; const float* hg_lb_bwd; const float* hg_norm_w; const float* hy_conv_w;
    const float* hy_w1; const float* hy_b1; const float* hy_f1; const float* hy_w2; const float* hy_b2; const float* hy_f2; const float* hy_w3; const float* hy_d; const float* hy_norm_w;
    const float* ffn_up; const float* ffn_conv_w; const float* ffn_down; const float* final_norm_w;
    float* out; unsigned char* ws; int ph_lo, ph_hi;
};

typedef const __attribute__((address_space(4))) Args* KArgs;
DI KArgs kargs() { unsigned long long p = (unsigned long long)__builtin_amdgcn_kernarg_segment_ptr(); asm volatile("" : "+s"(p)); return (KArgs)p; }

struct TrItem { const float* W; bf16_t* WT; int K, N, k0, n0, ns0; };
DI TrItem tr_decode(KArgs A, int it) {
    constexpr int I_IN = 16 * 128, I_OUT = 16 * 32, I_UP = 16 * 176, I_DN = 44 * 32, I_L = I_IN + I_OUT + I_UP + I_DN;
    const int l = it / I_L; int r = it % I_L; TrItem t; unsigned char* ws = A->ws;
    if (r < I_IN) { const int kb = r / 128, nb = r % 128; t.W = A->w_in + (size_t)l * DM * NIN; t.WT = (bf16_t*)(ws + WS_WIN) + (size_t)l * NIN * DM; t.K = DM; t.N = NIN; t.k0 = 64 * kb; t.n0 = 32 * nb; t.ns0 = 32 * nb; return t; } r -= I_IN;
    if (r < I_OUT) { const int kb = r / 32, nb = r % 32; t.W = A->w_out + (size_t)l * DM * DM; t.WT = (bf16_t*)(ws + WS_WOUT) + (size_t)l * DM * DM; t.K = DM; t.N = DM; t.k0 = 64 * kb; t.n0 = 32 * nb; t.ns0 = 32 * nb; return t; } r -= I_OUT;
    if (r < I_UP) { const int kb = r / 176, nb = r % 176, n0 = 32 * nb, tj = n0 >> 8, cc = n0 & 255; t.W = A->ffn_up + (size_t)l * DM * NUP; t.WT = (bf16_t*)(ws + WS_WUP) + (size_t)l * NUP * DM; t.K = DM; t.N = NUP; t.k0 = 64 * kb; t.n0 = n0;
        t.ns0 = cc < 128 ? 128 * tj + cc : DFF + 128 * tj + (cc - 128); return t; } r -= I_UP;
    { const int kb = r / 32, nb = r % 32; t.W = A->ffn_down + (size_t)l * DFF * DM; t.WT = (bf16_t*)(ws + WS_WDN) + (size_t)l * DM * DFF; t.K = DFF; t.N = DM; t.k0 = 64 * kb; t.n0 = 32 * nb; t.ns0 = 32 * nb; return t; }
}
DI void tr_load(const TrItem& t, int lane, f32x4 (&v)[8]) {
    const float* p = t.W + (size_t)(t.k0 + (lane >> 3)) * t.N + t.ns0 + 4 * (lane & 7);
#pragma unroll
    for (int i = 0; i < 8; ++i) v[i] = *(const f32x4*)(p + (size_t)(8 * i) * t.N);
}
DI void tr_store(const TrItem& t, int lane, const f32x4 (&v)[8], LAS float* scr) {
#pragma unroll
    for (int i = 0; i < 8; ++i) { LAS float* d = scr + (8 * i + (lane >> 3)) * 33 + 4 * (lane & 7); d[0] = v[i].x; d[1] = v[i].y; d[2] = v[i].z; d[3] = v[i].w; }
    LDS_WAIT(); asm volatile("" ::: "memory");
    const int c = lane & 7;
#pragma unroll
    for (int j = 0; j < 4; ++j) { const int n = (lane >> 3) + 8 * j; const LAS float* sp = scr + (8 * c) * 33 + n;
        u32x4 o; o.x = pkbf(sp[0 * 33], sp[1 * 33]); o.y = pkbf(sp[2 * 33], sp[3 * 33]); o.z = pkbf(sp[4 * 33], sp[5 * 33]); o.w = pkbf(sp[6 * 33], sp[7 * 33]);
        *(u32x4*)(t.WT + (size_t)(t.n0 + n) * t.K + t.k0 + 8 * c) = o; }
    LDS_WAIT(); asm volatile("" ::: "memory");
}
DI void tr_run(KArgs A, int first, int end, int stride, LAS float* scr, int lane) {
    if (first >= end) return;
    f32x4 va[8], vb[8];
    TrItem ta = tr_decode(A, first), tb = ta; tr_load(ta, lane, va);
    for (int it = first; it < end; it += 2 * stride) {
        const bool hb = it + stride < end;
        if (hb) { tb = tr_decode(A, it + stride); tr_load(tb, lane, vb); }
        tr_store(ta, lane, va, scr);
        if (!hb) break;
        const bool ha = it + 2 * stride < end;
        if (ha) { ta = tr_decode(A, it + 2 * stride); tr_load(ta, lane, va); }
        tr_store(tb, lane, vb, scr);
    }
}
constexpr int TR_FIRST = 16 * 128;
constexpr int TR_TOTAL = 2 * (16 * 128 + 16 * 32 + 16 * 176 + 44 * 32);
constexpr int TR_PER_BLOCK_ITEM = 32;
constexpr int TR_QITEMS = (TR_TOTAL - TR_FIRST + TR_PER_BLOCK_ITEM - 1) / TR_PER_BLOCK_ITEM;

DI void phase_p0a(KArgs A, lds_t* lds) {
    const int tid = threadIdx.x, lane = tid & 63, wave = __builtin_amdgcn_readfirstlane(tid >> 6), G = gridDim.x, bx = blockIdx.x;
    unsigned char* ws = A->ws;
    float* MOD = (float*)(ws + WS_CTL) + CW_MOD;
    float* HYABS = (float*)(ws + WS_CTL) + CW_HYABS;
    if (bx == 0) {
        float* LBT = (float*)(ws + WS_LBT);
        for (int i = tid; i < 1024; i += 512) { const int dir = i >> 9, c = i & 511; const float* p = dir ? A->hg_lb_bwd : A->hg_lb_fwd;
            const float p0 = p[c], p1 = p[512 + c], mx = fmaxf(p0, p1), e0 = __expf(p0 - mx), e1 = __expf(p1 - mx);
            LBT[0 * 1024 + dir * 512 + c] = 0.f; LBT[1 * 1024 + dir * 512 + c] = e1 / (e0 + e1); }
    }
    for (int rnd = 0; rnd < 2; ++rnd) {
        const int un = (G == 256) ? (bx < 160 ? (rnd == 0 ? bx : 999) : 160 + 2 * (bx - 160) + rnd) : bx + rnd * G;
        if (un >= 352) continue;
        if (un < 160) {
            const int l = un / 80, r = un % 80, cs = r < 16 ? 0 : 1, pb = cs ? r - 16 : r, L = cs ? 1024 : 256, p0 = pb * 16;
            LAS float* FE = (LAS float*)lds;
            LAS float* H1 = FE + 16 * 33;
            LAS float* H2 = H1 + 16 * 64;
            LAS float* W1 = H2 + 16 * 64;
            LAS float* W2 = W1 + 33 * 64;
            LAS float* PR = W2 + 64 * 64;
            for (int i = tid; i < 33 * 64; i += 512) W1[i] = A->hy_w1[l * 33 * 64 + i];
            for (int i = tid; i < 64 * 64; i += 512) W2[i] = A->hy_w2[l * 64 * 64 + i];
            if (tid < 256) { const int q = tid >> 6, o = tid & 63; const float* src = q == 0 ? A->hy_b1 : (q == 1 ? A->hy_f1 : (q == 2 ? A->hy_b2 : A->hy_f2)); PR[tid] = src[l * 64 + o]; }
            for (int i = tid; i < 16 * 33; i += 512) { const int p = i / 33, e = i % 33, pos = p0 + p; float v;
                if (e == 0) v = (float)pos / (float)(L - 1);
                else { const int k = (e - 1) & 15; const float band = 1e-4f + (float)k * ((15.0f - 1e-4f) / 15.0f); const float ang = 6.283185307179586f * (float)pos * band / (float)L; v = (e <= 16) ? cosf(ang) : sinf(ang); }
                FE[i] = v; }
            __syncthreads();
            for (int i = tid; i < 16 * 64; i += 512) { const int p = i >> 6, o = i & 63; float sm = PR[o];
#pragma unroll
                for (int e = 0; e < 33; ++e) sm += FE[p * 33 + e] * W1[e * 64 + o];
                H1[i] = sinf(PR[64 + o] * sm); }
            __syncthreads();
            for (int i = tid; i < 16 * 64; i += 512) { const int p = i >> 6, o = i & 63; float sm = PR[128 + o];
#pragma unroll
                for (int k4 = 0; k4 < 16; ++k4) { const f32x4 h = *(const LAS f32x4*)(H1 + p * 64 + 4 * k4); sm += (h.x * W2[(4 * k4) * 64 + o] + h.y * W2[(4 * k4 + 1) * 64 + o]) + (h.z * W2[(4 * k4 + 2) * 64 + o] + h.w * W2[(4 * k4 + 3) * 64 + o]); }
                H2[i] = sinf(PR[192 + o] * sm); }
            __syncthreads();
            float af[16], ab[16];
#pragma unroll
            for (int p = 0; p < 16; ++p) { af[p] = 0.f; ab[p] = 0.f; }
            const float* w3 = A->hy_w3 + (size_t)l * 64 * 1024;
#pragma unroll 1
            for (int kb = 0; kb < 64; kb += 16) {
                float wf[16], wb[16];
#pragma unroll
                for (int k = 0; k < 16; ++k) { wf[k] = w3[(kb + k) * 1024 + tid]; wb[k] = w3[(kb + k) * 1024 + 512 + tid]; }
#pragma unroll
                for (int p = 0; p < 16; ++p)
#pragma unroll
                    for (int k4 = 0; k4 < 4; ++k4) { const f32x4 h = *(const LAS f32x4*)(H2 + p * 64 + kb + 4 * k4);
                        af[p] += (h.x * wf[4 * k4] + h.y * wf[4 * k4 + 1]) + (h.z * wf[4 * k4 + 2] + h.w * wf[4 * k4 + 3]);
                        ab[p] += (h.x * wb[4 * k4] + h.y * wb[4 * k4 + 1]) + (h.z * wb[4 * k4 + 2] + h.w * wb[4 * k4 + 3]); }
            }
            const float mind = -3.0701134573253944f, maxd = -15.350567286626973f;
            const float delta = fabsf(mind + (float)tid * ((maxd - mind) / 511.0f));
            bf16_t* GF = (bf16_t*)(ws + WS_GF + (size_t)l * GF_LSTRIDE + (cs ? GF_SAMPLE_OFF : 0)) + (size_t)tid * (2 * L);
            float asum = 0.f;
#pragma unroll
            for (int p = 0; p < 16; ++p) { const int pos = p0 + p; const float tt = (float)pos / (float)(L - 1), dec = __expf(-tt * delta);
                const float hf = af[p] * dec, hb = ab[p] * dec;
                GF[L + pos] = (bf16_t)(pkbf(hf, 0.f) & 0xffffu); asum += fabsf(hf);
                if (pos >= 1) { GF[L - pos] = (bf16_t)(pkbf(hb, 0.f) & 0xffffu); asum += fabsf(hb); } else GF[0] = 0; }
            atomicAdd(&HYABS[(l * 2 + cs) * 512 + tid], asum);
            __syncthreads();
        } else {
            const int v = un - 160, l = v / 96, r = v % 96, jb = r >> 2, kq = r & 3;
            LAS float* SC = (LAS float*)lds;
            LAS float* PA = SC + 9 * 256;
            for (int i = tid; i < 9 * 256; i += 512) { const int cid = i >> 8, k = kq * 256 + (i & 255); const float cvv = cid == 0 ? A->c_ctx[k] : A->c[(cid - 1) * DM + k]; SC[i] = silu_f(cvv); }
            __syncthreads();
            f32x4 ac[9];
#pragma unroll
            for (int q = 0; q < 9; ++q) ac[q] = (f32x4){0.f, 0.f, 0.f, 0.f};
            const float* wp = A->ada_w + ((size_t)l * DM + kq * 256 + wave * 32) * NMOD + jb * 256 + 4 * lane;
#pragma unroll 1
            for (int kb = 0; kb < 32; kb += 16) { f32x4 wv[16];
#pragma unroll
                for (int kk = 0; kk < 16; ++kk) wv[kk] = *(const f32x4*)(wp + (size_t)(kb + kk) * NMOD);
#pragma unroll
                for (int kk = 0; kk < 16; ++kk)
#pragma unroll
                    for (int q = 0; q < 9; ++q) ac[q] += SC[q * 256 + wave * 32 + kb + kk] * wv[kk]; }
#pragma unroll
            for (int q = 0; q < 9; ++q) *(LAS f32x4*)(PA + (wave * 9 + q) * 256 + 4 * lane) = ac[q];
            __syncthreads();
            for (int i = tid; i < 9 * 256; i += 512) { float s = 0.f;
#pragma unroll
                for (int w = 0; w < 8; ++w) s += PA[w * 9 * 256 + i];
                const int cid = i >> 8, j = jb * 256 + (i & 255);
                if (kq == 0) s += A->ada_b[l * NMOD + j];
                atomicAdd(&MOD[(l * 9 + cid) * NMOD + j], s); }
            __syncthreads();
        }
    }
    tr_run(A, bx * 8 + wave, TR_FIRST, G * 8, (LAS float*)(lds + wave * 16384), lane);
}

DI void bias_tables(KArgs A, lds_t* lds, int seg_lo, int seg_hi) {
    const int tid = ltid(), lane = tid & 63, wave = __builtin_amdgcn_readfirstlane(tid >> 6), gw = blockIdx.x * 8 + wave, NGW = gridDim.x * 8;
    const float* MOD = (const float*)(A->ws + WS_CTL) + CW_MOD;
    constexpr int SHS = 2064, SHI = 16 * SHS;
    __syncthreads();
    for (int seg = seg_lo; seg < seg_hi; ++seg) {
        const int sl = seg - seg_lo; const float* shp = MOD + (size_t)(seg >> 1) * 9 * NMOD + ((seg & 1) ? 3072 : 0) + 2 * tid;
        f32x2_t sv[9];
#pragma unroll
        for (int rw = 0; rw < 9; ++rw) sv[rw] = *(const f32x2_t*)(shp + rw * NMOD);
#pragma unroll
        for (int rw = 0; rw < 16; ++rw) *(LAS unsigned*)(lds + sl * SHI + rw * SHS + 4 * tid) = rw < 9 ? pkbf(sv[rw < 9 ? rw : 0].x, sv[rw < 9 ? rw : 0].y) : 0u;
    }
    __syncthreads();
    const int i16 = lane & 15, q4 = lane >> 4;
    constexpr int G_IN = NIN / 16, G_UP = NUP / 16;
    int gbase = 0;
    for (int seg = seg_lo; seg < seg_hi; ++seg) {
        const int l = seg >> 1, which = seg & 1, nrows = which ? NUP : NIN, ng = which ? G_UP : G_IN, sl = seg - seg_lo;
        const bf16_t* W = which ? (const bf16_t*)(A->ws + WS_WUP) + (size_t)l * NUP * DM : (const bf16_t*)(A->ws + WS_WIN) + (size_t)l * NIN * DM;
        float* bo = (float*)(A->ws + WS_BIAS + (which ? BIAS2_OFF : 0)) + (size_t)l * 9 * nrows;
        for (int g = (gw + NGW - (gbase % NGW)) % NGW; g < ng; g += NGW) {
            const bf16_t* wrow = W + (size_t)(16 * g + i16) * DM + 8 * q4;
            f32x4 ac = (f32x4){0.f, 0.f, 0.f, 0.f};
#pragma unroll
            for (int kh = 0; kh < 2; ++kh) {
                bf16x8 fb[16];
#pragma unroll
                for (int ks = 0; ks < 16; ++ks) fb[ks] = *(const bf16x8*)(wrow + 32 * (16 * kh + ks));
#pragma unroll
                for (int ks = 0; ks < 16; ++ks) { const bf16x8 fa = *(const LAS bf16x8*)(lds + sl * SHI + i16 * SHS + 2 * (32 * (16 * kh + ks) + 8 * q4)); ac = __builtin_amdgcn_mfma_f32_16x16x32_bf16(fa, fb[ks], ac, 0, 0, 0); }
            }
#pragma unroll
            for (int rg = 0; rg < 4; ++rg) { const int cidx = 4 * q4 + rg; if (cidx < 9) bo[(size_t)cidx * nrows + 16 * g + i16] = ac[rg]; }
        }
        gbase += ng;
    }
    __syncthreads();
}

DI void phase_p0b(KArgs A, lds_t* lds) {
    const int tid = ltid(), lane = tid & 63, wave = __builtin_amdgcn_readfirstlane(tid >> 6), gw = blockIdx.x * 8 + wave, NGW = gridDim.x * 8;
    const float* MOD = (const float*)(A->ws + WS_CTL) + CW_MOD;
    bf16_t* H = (bf16_t*)(A->ws + WS_H); float* RSP = (float*)(A->ws + WS_RSP);
    for (int mb = gw; mb < TT; mb += 3 * NGW) {
        f32x4 v[3][4];
#pragma unroll
        for (int rI = 0; rI < 3; ++rI) { const int m = mb + rI * NGW;
            if (m < TT) { const float* xr = (m < TP) ? A->x_prompt + (size_t)m * DM : A->x_sample + (size_t)(m - TP) * DM;
#pragma unroll
                for (int j = 0; j < 4; ++j) v[rI][j] = *(const f32x4*)(xr + 4 * lane + 256 * j); } }
#pragma unroll
        for (int rI = 0; rI < 3; ++rI) { const int m = mb + rI * NGW;
            if (m < TT) { const float* md = MOD + cid_of_row(m) * NMOD; float sm = 0.f;
#pragma unroll
                for (int j = 0; j < 4; ++j) sm += (v[rI][j].x * v[rI][j].x + v[rI][j].y * v[rI][j].y) + (v[rI][j].z * v[rI][j].z + v[rI][j].w * v[rI][j].w);
                sm = wave_sum(sm);
                if (lane < 4) RSP[(size_t)m * 4 + lane] = lane == 0 ? sm : 0.f;
#pragma unroll
                for (int j = 0; j < 4; ++j) { const int c = 4 * lane + 256 * j; const f32x4 w = *(const f32x4*)(A->norm1_w + c), sc = *(const f32x4*)(md + 1024 + c);
                    const f32x4 o = v[rI][j] * w * (1.0f + sc);
                    u32x2 pk; pk.x = pkbf(o.x, o.y); pk.y = pkbf(o.z, o.w); *(u32x2*)(H + (size_t)m * DM + c) = pk; } } }
    }
    bias_tables(A, lds, 0, 1);
}
DI void phase_final_norm(KArgs A) {
    const int tid = ltid(), lane = tid & 63, wave = __builtin_amdgcn_readfirstlane(tid >> 6), gw = blockIdx.x * 8 + wave, NGW = gridDim.x * 8;
    for (int m = gw; m < TT; m += NGW) {
        float* xr = A->out + (size_t)m * DM;
        f32x4 v[4]; float s = 0.f;
#pragma unroll
        for (int j = 0; j < 4; ++j) { v[j] = *(const f32x4*)(xr + 4 * lane + 256 * j); s += (v[j].x * v[j].x + v[j].y * v[j].y) + (v[j].z * v[j].z + v[j].w * v[j].w); }
        const float r = 1.0f / sqrtf(wave_sum(s) * (1.0f / DM) + EPS);
#pragma unroll
        for (int j = 0; j < 4; ++j) { const int c = 4 * lane + 256 * j; const f32x4 w = *(const f32x4*)(A->final_norm_w + c); *(f32x4*)(xr + c) = v[j] * r * w; }
    }
}

struct HyRaw { u32x4 v[3]; u32x4 h; };
DI void hyprep_load(const bf16_t* P, int un, int tid, HyRaw& q) {
    const int tb = un >> 3, cb = un & 7, m0 = 64 * tb, row = tid >> 3, ch = tid & 7;
    const bool pr = m0 < TP, has_prev = pr && ((m0 & 255) != 0), has_next = pr && (((m0 + 64) & 255) != 0);
#pragma unroll
    for (int a = 0; a < 3; ++a) q.v[a] = *(const u32x4*)(P + (size_t)(m0 + row) * NIN + 2560 + a * 512 + cb * 64 + ch * 8);
    q.h = (u32x4){0u, 0u, 0u, 0u};
    if (tid < 48) { const int a = tid >> 4, which = (tid >> 3) & 1, chh = tid & 7; const bool valid = which ? has_next : has_prev; const int mrow = which ? m0 + 64 : m0 - 1;
        if (valid) q.h = *(const u32x4*)(P + (size_t)mrow * NIN + 2560 + a * 512 + cb * 64 + chh * 8); }
}
DI void phase_hyprep(KArgs A, int l, lds_t* lds) {
    const int tid = ltid();
    const bf16_t* P = (const bf16_t*)(A->ws + WS_P);
    bf16_t* UT = (bf16_t*)(A->ws + WS_UT); bf16_t* X2T = (bf16_t*)(A->ws + WS_X2T);
    constexpr int RS = 144;
    const int NU = 192 * 8, G = gridDim.x;
    HyRaw cur, nxt;
    if ((int)blockIdx.x < NU) hyprep_load(P, blockIdx.x, tid, cur);
    for (int un = blockIdx.x; un < NU; un += G) {
        const int tb = un >> 3, cb = un & 7, m0 = 64 * tb;
        {
            const int row = tid >> 3, ch = tid & 7;
#pragma unroll
            for (int a = 0; a < 3; ++a) *(LAS u32x4*)(lds + a * 66 * RS + (row + 1) * RS + ch * 16) = cur.v[a];
            if (tid < 48) { const int a = tid >> 4, which = (tid >> 3) & 1, chh = tid & 7; *(LAS u32x4*)(lds + a * 66 * RS + (which ? 65 : 0) * RS + chh * 16) = cur.h; }
        }
        if (un + G < NU) hyprep_load(P, un + G, tid, nxt);
        BAR_LDS();
        {
            const int ch = tid >> 3, tq = tid & 7, cg = cb * 64 + ch;
            float w[3][3];
#pragma unroll
            for (int a = 0; a < 3; ++a)
#pragma unroll
                for (int j = 0; j < 3; ++j) w[a][j] = A->hy_conv_w[(l * 3 + j) * 1536 + a * 512 + cg];
            float uu[8], xx[8];
#pragma unroll
            for (int i = 0; i < 8; ++i) { const int rr = 8 * tq + i + 1; float val[3];
#pragma unroll
                for (int a = 0; a < 3; ++a) { const lds_t* bp = lds + a * 66 * RS + 2 * ch;
                    const float xm = bf1(*(const LAS bf16_t*)(bp + (rr - 1) * RS)), x0 = bf1(*(const LAS bf16_t*)(bp + rr * RS)), xp = bf1(*(const LAS bf16_t*)(bp + (rr + 1) * RS));
                    val[a] = w[a][0] * xm + w[a][1] * x0 + w[a][2] * xp; }
                uu[i] = val[1] * val[0]; xx[i] = val[2]; }
            u32x4 o; o.x = pkbf(uu[0], uu[1]); o.y = pkbf(uu[2], uu[3]); o.z = pkbf(uu[4], uu[5]); o.w = pkbf(uu[6], uu[7]);
            *(u32x4*)(UT + (size_t)cg * TT + m0 + 8 * tq) = o;
            o.x = pkbf(xx[0], xx[1]); o.y = pkbf(xx[2], xx[3]); o.z = pkbf(xx[4], xx[5]); o.w = pkbf(xx[6], xx[7]);
            *(u32x4*)(X2T + (size_t)cg * TT + m0 + 8 * tq) = o;
        }
        BAR_LDS();
        cur = nxt;
    }
}

constexpr int S_QE = 0, S_QS = 17408, S_KS = 34816, S_QB = 52224, S_KB = 60928, S_KT = 69632, S_VT = 88064, S_PP = 106496, S_ST = 115712, S_GT = 150528, S_DEC = 154624;
static_assert(S_DEC + 512 <= MISC_OFF, "scan lds");
DI void scan_item(KArgs A, int l, int seq, int head, int dir, lds_t* lds) {
    const int tid = ltid(), lane = tid & 63, w = __builtin_amdgcn_readfirstlane(tid >> 6);
    const bool samp = seq >= 16;
    const int L = samp ? 1024 : 256, mbase = samp ? TP + (seq - 16) * 1024 : seq * 256, nch = L >> 6;
    const bf16_t* P = (const bf16_t*)(A->ws + WS_P);
    const bf16_t* Pq = P + (size_t)mbase * NIN + head * 128;
    const bf16_t* Pf = Pq + 512 + dir * 512;
    const bf16_t* Pv = Pq + 1536;
    bf16_t* Oo = (bf16_t*)(A->ws + WS_H) + (size_t)dir * TT * 512 + (size_t)mbase * 512 + head * 128;
    const int a = w >> 2, jv = w & 3, r = lane & 31, hh = lane >> 5;
    f32x16 Sa[2];
    if (samp) {
        const float* st = A->state + ((((size_t)(seq - 16) * 2 + l) * 2 + dir) * 4 + head) * 16384;
#pragma unroll
        for (int ii = 0; ii < 2; ++ii)
#pragma unroll
            for (int rg = 0; rg < 16; ++rg) Sa[ii][rg] = st[(size_t)(32 * (2 * a + ii) + crow(rg, hh)) * 128 + 32 * jv + r];
    } else {
#pragma unroll
        for (int ii = 0; ii < 2; ++ii)
#pragma unroll
            for (int rg = 0; rg < 16; ++rg) Sa[ii][rg] = 0.f;
    }
#pragma unroll
    for (int ii = 0; ii < 2; ++ii)
#pragma unroll
        for (int q4 = 0; q4 < 4; ++q4) { u32x2 pk; pk.x = pkbf(Sa[ii][4 * q4], Sa[ii][4 * q4 + 1]); pk.y = pkbf(Sa[ii][4 * q4 + 2], Sa[ii][4 * q4 + 3]);
            *(LAS u32x2*)(lds + S_ST + (32 * jv + r) * 272 + 2 * (32 * (2 * a + ii) + 8 * q4 + 4 * hh)) = pk; }
    unsigned rq[8], rf[8], rv[8];
    const long tstep = dir ? -(long)NIN : (long)NIN;
    const size_t off0 = (size_t)(dir ? L - 1 - 8 * w : 8 * w) * NIN + 2 * lane;
#pragma unroll
    for (int i = 0; i < 8; ++i) { const long off = (long)off0 + i * tstep; rq[i] = *(const unsigned*)(Pq + off); rf[i] = *(const unsigned*)(Pf + off); rv[i] = *(const unsigned*)(Pv + off); }
#pragma unroll
    for (int i = 0; i < 8; ++i) asm volatile("" :: "v"(rq[i]), "v"(rf[i]), "v"(rv[i]));
    lds_t* OT = lds + S_QS + w * 2560;
    for (int ch = 0; ch < nch; ++ch) {
        unsigned nq[8], nf[8], nv[8];
        if (ch + 1 < nch) {
            const long offc = (long)off0 + (long)(64 * (ch + 1)) * tstep;
#pragma unroll
            for (int i = 0; i < 8; ++i) { const long off = offc + i * tstep; nq[i] = *(const unsigned*)(Pq + off); nf[i] = *(const unsigned*)(Pf + off); nv[i] = *(const unsigned*)(Pv + off); }
        } else {
#pragma unroll
            for (int i = 0; i < 8; ++i) { nq[i] = 0u; nf[i] = 0u; nv[i] = 0u; }
        }
        { float s0 = 0.f, s1 = 0.f;
#pragma unroll
          for (int i = 0; i < 8; ++i) { s0 += bflo(rf[i]); s1 += bfhi(rf[i]); }
          *(LAS f32x2_t*)(lds + S_GT + (w * 128 + 2 * lane) * 4) = (f32x2_t){s0, s1}; }
        BAR_LDS();
        {
            float my0 = 0.f, my1 = 0.f, p2_0 = 0.f, p2_1 = 0.f, p4_0 = 0.f, p4_1 = 0.f, p6_0 = 0.f, p6_1 = 0.f, run0 = 0.f, run1 = 0.f;
#pragma unroll
            for (int g = 0; g < 8; ++g) {
                if (g == 2) { p2_0 = run0; p2_1 = run1; } if (g == 4) { p4_0 = run0; p4_1 = run1; } if (g == 6) { p6_0 = run0; p6_1 = run1; }
                if (g == w) { my0 = run0; my1 = run1; }
                const f32x2_t gt = *(const LAS f32x2_t*)(lds + S_GT + (g * 128 + 2 * lane) * 4); run0 += gt.x; run1 += gt.y; }
            const float p8_0 = run0, p8_1 = run1;
            const float rd0 = (w < 4) ? p2_0 : p6_0, rd1 = (w < 4) ? p2_1 : p6_1;
            if (w == 0) *(LAS f32x2_t*)(lds + S_DEC + 8 * lane) = (f32x2_t){__expf(p8_0), __expf(p8_1)};
            float G0 = __expf(fminf(my0 - rd0, 80.f)), G1 = __expf(fminf(my1 - rd1, 80.f));
            const float crd0 = __expf(rd0), crd1 = __expf(rd1), cend0 = __expf(fminf(p8_0 - rd0, 0.f)), cend1 = __expf(fminf(p8_1 - rd1, 0.f));
            const float c40 = __expf(fminf((w < 4) ? p4_0 - p2_0 : p6_0 - p4_0, 0.f)), c41 = __expf(fminf((w < 4) ? p4_1 - p2_1 : p6_1 - p4_1, 0.f));
            unsigned kt0[4], kt1[4], vt0[4], vt1[4];
            float kprev0 = 0.f, kprev1 = 0.f, vprev0 = 0.f, vprev1 = 0.f;
            lds_t* rowp = lds + (8 * w) * 272 + 4 * lane;
#pragma unroll
            for (int i = 0; i < 8; ++i) {
                const float q0 = bflo(rq[i]), q1 = bfhi(rq[i]), F0 = __expf(bflo(rf[i])), F1 = __expf(bfhi(rf[i])), v0 = bflo(rv[i]), v1 = bfhi(rv[i]);
                const float k0 = 1.0f - F0, k1 = 1.0f - F1;
                G0 *= F0; G1 *= F1;
                const float ig0 = __builtin_amdgcn_rcpf(fmaxf(G0, 1e-30f)), ig1 = __builtin_amdgcn_rcpf(fmaxf(G1, 1e-30f));
                const float qs0 = q0 * G0, qs1 = q1 * G1, ks0 = k0 * ig0, ks1 = k1 * ig1;
                *(LAS unsigned*)(rowp + S_QS + i * 272) = pkbf(qs0, qs1);
                *(LAS unsigned*)(rowp + S_KS + i * 272) = pkbf(ks0, ks1);
                *(LAS unsigned*)(rowp + S_QE + i * 272) = pkbf(qs0 * crd0, qs1 * crd1);
                if (w >= 4) *(LAS unsigned*)(rowp + S_QB - 32 * 272 + i * 272) = pkbf(qs0 * c40, qs1 * c41);
                else        *(LAS unsigned*)(rowp + S_KB + i * 272) = pkbf(ks0 * c40, ks1 * c41);
                const float kk0 = ks0 * cend0, kk1 = ks1 * cend1;
                if (i & 1) { kt0[i >> 1] = pkbf(kprev0, kk0); kt1[i >> 1] = pkbf(kprev1, kk1); vt0[i >> 1] = pkbf(vprev0, v0); vt1[i >> 1] = pkbf(vprev1, v1); }
                else { kprev0 = kk0; kprev1 = kk1; vprev0 = v0; vprev1 = v1; }
            }
            *(LAS u32x4*)(lds + S_KT + (2 * lane) * 144 + 16 * w) = (u32x4){kt0[0], kt0[1], kt0[2], kt0[3]};
            *(LAS u32x4*)(lds + S_KT + (2 * lane + 1) * 144 + 16 * w) = (u32x4){kt1[0], kt1[1], kt1[2], kt1[3]};
            *(LAS u32x4*)(lds + S_VT + (2 * lane) * 144 + 16 * w) = (u32x4){vt0[0], vt0[1], vt0[2], vt0[3]};
            *(LAS u32x4*)(lds + S_VT + (2 * lane + 1) * 144 + 16 * w) = (u32x4){vt1[0], vt1[1], vt1[2], vt1[3]};
        }
        BAR_LDS();
        if (w < 3) {
            const lds_t* Ab = lds + (w == 2 ? S_QB : (w == 1 ? S_QS + 32 * 272 : S_QS));
            const lds_t* Bb = lds + (w == 2 ? S_KB : (w == 1 ? S_KS + 32 * 272 : S_KS));
            const int prow0 = w == 0 ? 0 : 32, pcol0 = w == 1 ? 32 : 0; const bool mask = w != 2;
            f32x16 sc;
#pragma unroll
            for (int rg = 0; rg < 16; ++rg) sc[rg] = 0.f;
            { bf16x8 fa[8], fb[8];
#pragma unroll
              for (int s = 0; s < 8; ++s) { fa[s] = *(const LAS bf16x8*)(Ab + r * 272 + 32 * s + 16 * hh); fb[s] = *(const LAS bf16x8*)(Bb + r * 272 + 32 * s + 16 * hh); }
              __builtin_amdgcn_sched_barrier(0);
#pragma unroll
              for (int s = 0; s < 8; ++s) sc = MFMA32(fa[s], fb[s], sc); }
#pragma unroll
            for (int rg = 0; rg < 16; ++rg) { const int jl = crow(rg, hh); const float val = (mask && r > jl) ? 0.f : sc[rg];
                *(LAS bf16_t*)(lds + S_PP + (prow0 + jl) * 144 + 2 * (pcol0 + r)) = (bf16_t)(pkbf(val, 0.f) & 0xffffu); }
        }
        f32x16 oacc;
#pragma unroll
        for (int rg = 0; rg < 16; ++rg) oacc[rg] = 0.f;
        { bf16x8 fa[8], fb[8];
#pragma unroll
          for (int s = 0; s < 8; ++s) { fa[s] = *(const LAS bf16x8*)(lds + S_QE + (32 * a + r) * 272 + 32 * s + 16 * hh); fb[s] = *(const LAS bf16x8*)(lds + S_ST + (32 * jv + r) * 272 + 32 * s + 16 * hh); }
          __builtin_amdgcn_sched_barrier(0);
#pragma unroll
          for (int s = 0; s < 8; ++s) oacc = MFMA32(fa[s], fb[s], oacc); }
        { bf16x8 fa[2][4], fb[4]; f32x4 dv[2][4];
#pragma unroll
          for (int s = 0; s < 4; ++s) fb[s] = *(const LAS bf16x8*)(lds + S_VT + (32 * jv + r) * 144 + 32 * s + 16 * hh);
#pragma unroll
          for (int ii = 0; ii < 2; ++ii) { const int dkb = 32 * (2 * a + ii);
#pragma unroll
              for (int q4 = 0; q4 < 4; ++q4) dv[ii][q4] = *(const LAS f32x4*)(lds + S_DEC + 4 * (dkb + 8 * q4 + 4 * hh));
#pragma unroll
              for (int s = 0; s < 4; ++s) fa[ii][s] = *(const LAS bf16x8*)(lds + S_KT + (dkb + r) * 144 + 32 * s + 16 * hh); }
          __builtin_amdgcn_sched_barrier(0);
#pragma unroll
          for (int ii = 0; ii < 2; ++ii)
#pragma unroll
              for (int q4 = 0; q4 < 4; ++q4) { Sa[ii][4 * q4] *= dv[ii][q4].x; Sa[ii][4 * q4 + 1] *= dv[ii][q4].y; Sa[ii][4 * q4 + 2] *= dv[ii][q4].z; Sa[ii][4 * q4 + 3] *= dv[ii][q4].w; }
#pragma unroll
          for (int s = 0; s < 4; ++s) { Sa[0] = MFMA32(fa[0][s], fb[s], Sa[0]); Sa[1] = MFMA32(fa[1][s], fb[s], Sa[1]); } }
        BAR_LDS();
        { bf16x8 fa[4], fb[4];
#pragma unroll
          for (int s = 0; s < 4; ++s) { if (s < 2 || a == 1) { fa[s] = *(const LAS bf16x8*)(lds + S_PP + (32 * a + r) * 144 + 32 * s + 16 * hh); fb[s] = *(const LAS bf16x8*)(lds + S_VT + (32 * jv + r) * 144 + 32 * s + 16 * hh); } }
          __builtin_amdgcn_sched_barrier(0);
#pragma unroll
          for (int s = 0; s < 4; ++s) { if (s < 2 || a == 1) oacc = MFMA32(fa[s], fb[s], oacc); } }
#pragma unroll
        for (int rg = 0; rg < 16; ++rg) *(LAS bf16_t*)(OT + crow(rg, hh) * 80 + 2 * r) = (bf16_t)(pkbf(oacc[rg], 0.f) & 0xffffu);
#pragma unroll
        for (int ii = 0; ii < 2; ++ii)
#pragma unroll
            for (int q4 = 0; q4 < 4; ++q4) { u32x2 pk; pk.x = pkbf(Sa[ii][4 * q4], Sa[ii][4 * q4 + 1]); pk.y = pkbf(Sa[ii][4 * q4 + 2], Sa[ii][4 * q4 + 3]);
                *(LAS u32x2*)(lds + S_ST + (32 * jv + r) * 272 + 2 * (32 * (2 * a + ii) + 8 * q4 + 4 * hh)) = pk; }
        { const int tl = lane >> 1, hf = lane & 1, tau = 64 * ch + 32 * a + tl, t = dir ? L - 1 - tau : tau;
          const u32x4 o0 = *(const LAS u32x4*)(OT + tl * 80 + 32 * hf), o1 = *(const LAS u32x4*)(OT + tl * 80 + 32 * hf + 16);
          bf16_t* op = Oo + (size_t)t * 512 + 32 * jv + 16 * hf; *(u32x4*)op = o0; *(u32x4*)(op + 8) = o1; }
#pragma unroll
        for (int i = 0; i < 8; ++i) { rq[i] = nq[i]; rf[i] = nf[i]; rv[i] = nv[i]; }
    }
    if (!samp) {
        float* ns = A->out + (size_t)TT * DM + ((((size_t)seq * 2 + l) * 2 + dir) * 4 + head) * 16384;
#pragma unroll
        for (int ii = 0; ii < 2; ++ii)
#pragma unroll
            for (int rg = 0; rg < 16; ++rg) ns[(size_t)(32 * (2 * a + ii) + crow(rg, hh)) * 128 + 32 * jv + r] = Sa[ii][rg];
    }
    BAR_LDS();
}

constexpr int H_CST = 4112, H_CP = 0, H_UP = 33024, H_UPBYTES = 61440, H_GST = H_UP + H_UPBYTES;
DI void hyena_item(KArgs A, int l, int cs, int c, bool zero_pads, lds_t* lds) {
    const int tid = ltid(), lane = tid & 63, w = __builtin_amdgcn_readfirstlane(tid >> 6);
    const int L = cs ? 1024 : 256, NB = L >> 5, nseq = cs ? 8 : 16, m0 = cs ? TP : 0, SEQST = 3 * NB * 80;
    bf16_t* UT = (bf16_t*)(A->ws + WS_UT) + (size_t)c * TT + m0;
    const bf16_t* X2T = (const bf16_t*)(A->ws + WS_X2T) + (size_t)c * TT + m0;
    const bf16_t* GF = (const bf16_t*)(A->ws + WS_GF + (size_t)l * GF_LSTRIDE + (cs ? GF_SAMPLE_OFF : 0)) + (size_t)c * (2 * L);
    if (zero_pads) { for (int i = tid; i < H_UPBYTES / 16; i += 512) *(LAS u32x4*)(lds + H_UP + 16 * i) = (u32x4){0u, 0u, 0u, 0u}; BAR_LDS(); }
    { const int nchunk = nseq * L / 8, cps = L / 8;
      for (int q = tid; q < nchunk; q += 512) { const int sq = q / cps, s = 8 * (q % cps); const u32x4 v = *(const u32x4*)(UT + (size_t)sq * L + s);
          *(LAS u32x4*)(lds + H_UP + sq * SEQST + (NB + (s >> 5)) * 80 + 2 * (s & 31)) = v; }
      for (int q = tid; q < 2 * L / 8; q += 512) *(LAS u32x4*)(lds + H_GST + 16 * q) = *(const u32x4*)(GF + 8 * q); }
    BAR_LDS();
    for (int e = tid; e < 16 * L; e += 512) { const int m = e / (2 * L), p = e % (2 * L), idx = 2 * L + m - p;
        bf16_t v = 0; if (idx < 2 * L) v = *(const LAS bf16_t*)(lds + H_GST + 2 * idx);
        *(LAS bf16_t*)(lds + H_CP + m * H_CST + 2 * p) = v; }
    BAR_LDS();
    const int r = lane & 31, hh = lane >> 5;
    const bool active = cs ? true : (w < 4);
    if (active) {
        const int sq = cs ? w : 4 * w + (r >> 3), ab = cs ? r : (r & 7);
        const lds_t* ub = lds + H_UP + sq * SEQST + (NB + ab) * 80 + 16 * hh;
        const lds_t* cb = lds + H_CP + (r & 7) * H_CST + 2 * (L - 8 * (r >> 3) + 8 * hh);
        f32x16 z;
#pragma unroll
        for (int rg = 0; rg < 16; ++rg) z[rg] = 0.f;
        bf16x8 fa0, fa1, fb0, fb1, ga0, ga1, gb0, gb1;
        int d = -(NB - 1);
        fa0 = *(const LAS bf16x8*)(cb - 64 * d); fa1 = *(const LAS bf16x8*)(cb - 64 * d + 32); fb0 = *(const LAS bf16x8*)(ub - 80 * d); fb1 = *(const LAS bf16x8*)(ub - 80 * d + 32);
        for (; d + 1 <= NB - 1; d += 2) {
            ga0 = *(const LAS bf16x8*)(cb - 64 * (d + 1)); ga1 = *(const LAS bf16x8*)(cb - 64 * (d + 1) + 32); gb0 = *(const LAS bf16x8*)(ub - 80 * (d + 1)); gb1 = *(const LAS bf16x8*)(ub - 80 * (d + 1) + 32);
            __builtin_amdgcn_sched_barrier(0);
            z = MFMA32(fa0, fb0, z); z = MFMA32(fa1, fb1, z);
            __builtin_amdgcn_sched_barrier(0);
            fa0 = *(const LAS bf16x8*)(cb - 64 * (d + 2)); fa1 = *(const LAS bf16x8*)(cb - 64 * (d + 2) + 32); fb0 = *(const LAS bf16x8*)(ub - 80 * (d + 2)); fb1 = *(const LAS bf16x8*)(ub - 80 * (d + 2) + 32);
            __builtin_amdgcn_sched_barrier(0);
            z = MFMA32(ga0, gb0, z); z = MFMA32(ga1, gb1, z);
            __builtin_amdgcn_sched_barrier(0);
        }
        z = MFMA32(fa0, fb0, z); z = MFMA32(fa1, fb1, z);
        const float invn = 1.0f / (((const float*)(A->ws + WS_CTL))[CW_HYABS + (l * 2 + cs) * 512 + c] + EPS), dd = A->hy_d[l * 512 + c];
#pragma unroll
        for (int q4 = 0; q4 < 4; ++q4) { const int t0 = 32 * ab + 8 * q4 + 4 * hh;
            const u32x2 uu = *(const LAS u32x2*)(lds + H_UP + sq * SEQST + (NB + ab) * 80 + 2 * (8 * q4 + 4 * hh));
            const u32x2 x2 = *(const u32x2*)(X2T + (size_t)sq * L + t0);
            const float y0 = bflo(x2.x) * (invn * z[4 * q4 + 0] + dd * bflo(uu.x)), y1 = bfhi(x2.x) * (invn * z[4 * q4 + 1] + dd * bfhi(uu.x));
            const float y2 = bflo(x2.y) * (invn * z[4 * q4 + 2] + dd * bflo(uu.y)), y3 = bfhi(x2.y) * (invn * z[4 * q4 + 3] + dd * bfhi(uu.y));
            u32x2 o; o.x = pkbf(y0, y1); o.y = pkbf(y2, y3);
            *(u32x2*)(UT + (size_t)sq * L + t0) = o; }
    }
    BAR_LDS();
}

DI void phase_mixer(KArgs A, int l, lds_t* lds) {
    unsigned* qhead = (unsigned*)(A->ws + WS_CTL) + CW_QUEUE + 64 * l;
    volatile LAS unsigned* bc = (volatile LAS unsigned*)(lds + MISC_OFF) + 16;
    int last_kind = -1;
    int n_items = 0;
    if ((PROBE_PH == 100 || PROBE_PH == 101) && l == 1 && threadIdx.x == 0) *(volatile LAS unsigned long long*)(lds + MISC_OFF + 128) = __builtin_amdgcn_s_memrealtime();
    for (;;) {
        BAR_LDS();
        if (threadIdx.x == 0) *bc = __hip_atomic_fetch_add(qhead, 1u, __ATOMIC_RELAXED, __HIP_MEMORY_SCOPE_AGENT);
        BAR_LDS();
        const int it = (int)*bc;
        if (PROBE_PH == 100 && l == 1 && n_items == 1 && threadIdx.x == 0) *(volatile LAS unsigned long long*)(lds + MISC_OFF + 136) = __builtin_amdgcn_s_memrealtime();
        ++n_items;
        if (it >= 1216 + (l == 0 ? TR_QITEMS : 0)) break;
        if (it >= 1216) {
            const int w = __builtin_amdgcn_readfirstlane(threadIdx.x >> 6), base = TR_FIRST + (it - 1216) * TR_PER_BLOCK_ITEM;
            const int e = base + TR_PER_BLOCK_ITEM < TR_TOTAL ? base + TR_PER_BLOCK_ITEM : TR_TOTAL;
            tr_run(A, base + w, e, 8, (LAS float*)(lds + w * 16384), threadIdx.x & 63); last_kind = -1; continue; }
        const bool is_scan = it < 64 || (it >= 576 && it < 704);
        if (is_scan) { const int i2 = it < 64 ? it : it - 576, sq = (it < 64 ? 16 : 0) + (i2 >> 3); scan_item(A, l, sq, (i2 >> 1) & 3, i2 & 1, lds); last_kind = -1; }
        else { const int cs = it < 576 ? 1 : 0, c = cs ? it - 64 : it - 704; hyena_item(A, l, cs, c, last_kind != cs, lds); last_kind = cs; }
    }
    if (PROBE_PH == 101 && l == 1 && threadIdx.x == 0) *(volatile LAS unsigned long long*)(lds + MISC_OFF + 136) = __builtin_amdgcn_s_memrealtime();
}

DI void phase_merge(KArgs A, int l, lds_t* lds) {
    const int tid = threadIdx.x;
    if (l == 0) bias_tables(A, lds, 1, 4);
    const bf16_t* P = (const bf16_t*)(A->ws + WS_P);
    const bf16_t* OF = (const bf16_t*)(A->ws + WS_H); const bf16_t* OB = OF + (size_t)TT * 512;
    const bf16_t* YT = (const bf16_t*)(A->ws + WS_UT);
    bf16_t* MG = (bf16_t*)(A->ws + WS_MERGED);
    constexpr int RS = 1040;
    for (int un = blockIdx.x; un < TT / 32; un += gridDim.x) {
        const int m0 = 32 * un;
        const int j = tid >> 4, sub = tid & 15, m = m0 + j, cbase = 32 * sub;
        u32x4 yv[4], fv[4], bv[4], gv[4];
        { const bf16_t* yp = YT + (size_t)tid * TT + m0;
#pragma unroll
          for (int q = 0; q < 4; ++q) { yv[q] = *(const u32x4*)(yp + 8 * q); fv[q] = *(const u32x4*)(OF + (size_t)m * 512 + cbase + 8 * q); bv[q] = *(const u32x4*)(OB + (size_t)m * 512 + cbase + 8 * q);
              gv[q] = *(const u32x4*)(P + (size_t)m * NIN + 2048 + cbase + 8 * q); } }
#pragma unroll
        for (int q = 0; q < 4; ++q) { const unsigned vv[4] = {yv[q].x, yv[q].y, yv[q].z, yv[q].w};
#pragma unroll
            for (int e = 0; e < 4; ++e) { *(LAS bf16_t*)(lds + (8 * q + 2 * e) * RS + 2 * tid) = (bf16_t)(vv[e] & 0xffffu); *(LAS bf16_t*)(lds + (8 * q + 2 * e + 1) * RS + 2 * tid) = (bf16_t)(vv[e] >> 16); } }
        {
            float o[32]; float ss = 0.f;
#pragma unroll
            for (int q = 0; q < 4; ++q) { const unsigned ff[4] = {fv[q].x, fv[q].y, fv[q].z, fv[q].w}, bb[4] = {bv[q].x, bv[q].y, bv[q].z, bv[q].w};
#pragma unroll
                for (int e = 0; e < 4; ++e) { const float a0 = bflo(ff[e]) + bflo(bb[e]), a1 = bfhi(ff[e]) + bfhi(bb[e]); o[8 * q + 2 * e] = a0; o[8 * q + 2 * e + 1] = a1; ss += a0 * a0 + a1 * a1; } }
            ss += __shfl_xor(ss, 1); ss += __shfl_xor(ss, 2);
            const float rr = 1.0f / sqrtf(ss * (1.0f / 128.0f) + EPS);
#pragma unroll
            for (int q = 0; q < 4; ++q) { const unsigned gg[4] = {gv[q].x, gv[q].y, gv[q].z, gv[q].w};
                const f32x4 w0 = *(const f32x4*)(A->hg_norm_w + l * 512 + cbase + 8 * q), w1 = *(const f32x4*)(A->hg_norm_w + l * 512 + cbase + 8 * q + 4);
                const float ww[8] = {w0.x, w0.y, w0.z, w0.w, w1.x, w1.y, w1.z, w1.w};
                unsigned pk[4];
#pragma unroll
                for (int e = 0; e < 4; ++e) pk[e] = pkbf(o[8 * q + 2 * e] * rr * ww[2 * e] * bflo(gg[e]), o[8 * q + 2 * e + 1] * rr * ww[2 * e + 1] * bfhi(gg[e]));
                *(u32x4*)(MG + (size_t)m * DM + cbase + 8 * q) = (u32x4){pk[0], pk[1], pk[2], pk[3]}; }
        }
        BAR_LDS();
        {
            float y[32]; float ss = 0.f;
#pragma unroll
            for (int q = 0; q < 4; ++q) { const u32x4 v = *(const LAS u32x4*)(lds + j * RS + 2 * (cbase + 8 * q)); const unsigned vv[4] = {v.x, v.y, v.z, v.w};
#pragma unroll
                for (int e = 0; e < 4; ++e) { const float a0 = bflo(vv[e]), a1 = bfhi(vv[e]); y[8 * q + 2 * e] = a0; y[8 * q + 2 * e + 1] = a1; ss += a0 * a0 + a1 * a1; } }
            ss += __shfl_xor(ss, 1); ss += __shfl_xor(ss, 2); ss += __shfl_xor(ss, 4); ss += __shfl_xor(ss, 8);
            const float rr = 1.0f / sqrtf(ss * (1.0f / 512.0f) + EPS);
#pragma unroll
            for (int q = 0; q < 4; ++q) { const f32x4 w0 = *(const f32x4*)(A->hy_norm_w + l * 512 + cbase + 8 * q), w1 = *(const f32x4*)(A->hy_norm_w + l * 512 + cbase + 8 * q + 4);
                const float ww[8] = {w0.x, w0.y, w0.z, w0.w, w1.x, w1.y, w1.z, w1.w};
                unsigned pk[4];
#pragma unroll
                for (int e = 0; e < 4; ++e) pk[e] = pkbf(y[8 * q + 2 * e] * rr * ww[2 * e], y[8 * q + 2 * e + 1] * rr * ww[2 * e + 1]);
                *(u32x4*)(MG + (size_t)m * DM + 512 + cbase + 8 * q) = (u32x4){pk[0], pk[1], pk[2], pk[3]}; }
        }
        BAR_LDS();
    }
}

__global__ void __launch_bounds__(512, 2) mk_fwd(Args KP) {
    extern __shared__ __attribute__((aligned(16))) unsigned char lds_raw[];
    lds_t* lds = (lds_t*)lds_raw;
    const int tid = threadIdx.x;
    volatile LAS unsigned* MISC = (volatile LAS unsigned*)(lds + MISC_OFF);
    if (tid < 64) MISC[tid] = 0u;
    __syncthreads();
    if (MK_N_LAUNCHES == 1) (void)xcd_barrier_post((unsigned*)(KP.ws + WS_CTL) + CW_BAR, MISC + 8);
    const int lo = KP.ph_lo, hi = KP.ph_hi;
    if (PROBE_PH == 0 && threadIdx.x == 0) *(volatile LAS unsigned long long*)(lds + MISC_OFF + 128) = __builtin_amdgcn_s_memrealtime();
#define IN(k) (lo <= (k) && (k) < hi)
#define SEAM(k) do { PSTAMP(k); } while (0)
#define SEAM_(k) do { if (IN(k) && IN((k) + 1)) { KArgs A_ = kargs(); XcdBarrier b_; b_.bar = (unsigned*)(A_->ws + WS_CTL) + CW_BAR; b_.x = xb_xcc_id(); b_.st = (volatile LAS unsigned*)(lds + MISC_OFF) + 8; xcd_barrier(b_); } } while (0)
#define PSTAMP(k) do { SEAM_(k); if (PROBE_PH == (k) + 1 && threadIdx.x == 0) *(volatile LAS unsigned long long*)(lds + MISC_OFF + 128) = __builtin_amdgcn_s_memrealtime(); if (PROBE_PH == (k) && threadIdx.x == 0) *(volatile LAS unsigned long long*)(lds + MISC_OFF + 136) = __builtin_amdgcn_s_memrealtime(); } while (0)
#define MODP(A) ((const float*)((A)->ws + WS_CTL) + CW_MOD)
#define HP(A) ((bf16_t*)((A)->ws + WS_H))

    if (IN(0)) { KArgs A = kargs(); phase_p0a(A, lds); } SEAM(0);
    if (IN(1)) { KArgs A = kargs(); phase_p0b(A, lds); } SEAM(1);
#define LAYER_BODY(l) do { \
        const int pb = 2 + 7 * l; \
        if (IN(pb + 0)) { \
            KArgs A = kargs(); \
            pg8::Gemm g{HP(A), (const bf16_t*)(A->ws + WS_WIN) + (size_t)l * NIN * DM, TT, NIN, DM}; pg8::StaticOrder S; S.init(TT, NIN, gridDim.x, blockIdx.x); \
            pg8::EpiProj E{(bf16_t*)(A->ws + WS_P), (const float*)(A->ws + WS_LBT) + l * 1024, (const float*)(A->ws + WS_RSP), (const float*)(A->ws + WS_BIAS) + (size_t)l * 9 * NIN, (LAS float*)(lds + XCH_OFF + 8192)}; \
            pg8::gemm_phase<pg8::EpiProj, pg8::StaticOrder, true, true>(lds, g, S, E); \
        } SEAM(pb + 0); \
        if (IN(pb + 1)) { KArgs A = kargs(); phase_hyprep(A, l, lds); } SEAM(pb + 1); \
        if (IN(pb + 2)) { KArgs A = kargs(); phase_mixer(A, l, lds); } SEAM(pb + 2); \
        if (IN(pb + 3)) { KArgs A = kargs(); phase_merge(A, l, lds); } SEAM(pb + 3); \
        if (IN(pb + 4)) { \
            KArgs A = kargs(); float* XA = A->out; \
            pg8::Gemm g{(const bf16_t*)(A->ws + WS_MERGED), (const bf16_t*)(A->ws + WS_WOUT) + (size_t)l * DM * DM, TT, DM, DM}; pg8::StaticOrder S; S.init(TT, DM, gridDim.x, blockIdx.x); \
            pg8::EpiResid E{l == 0 ? A->x_prompt : XA, l == 0 ? A->x_sample : XA + (size_t)TP * DM, XA, MODP(A) + (size_t)l * 9 * NMOD + 2048, \
                            HP(A), A->norm2_w + l * DM, MODP(A) + (size_t)l * 9 * NMOD + 4096, (float*)(A->ws + WS_RSP), (LAS float*)(lds + XCH_OFF)}; \
            pg8::gemm_phase<pg8::EpiResid, pg8::StaticOrder, true, true>(lds, g, S, E); \
        } SEAM(pb + 4); \
        if (IN(pb + 5)) { \
            KArgs A = kargs(); \
            pg8::Gemm g{HP(A), (const bf16_t*)(A->ws + WS_WUP) + (size_t)l * NUP * DM, TT, NUP, DM}; pg8::StaticOrder S; S.init(TT, NUP, gridDim.x, blockIdx.x); \
            pg8::EpiFfn E{(bf16_t*)(A->ws + WS_P), A->ffn_conv_w + (size_t)l * 3 * NUP, (LAS float*)(lds + XCH_OFF), (const float*)(A->ws + WS_RSP), (const float*)(A->ws + WS_BIAS + BIAS2_OFF) + (size_t)l * 9 * NUP, (LAS float*)(lds + XCH_OFF + 8192)}; \
            pg8::gemm_phase<pg8::EpiFfn, pg8::StaticOrder, true, true>(lds, g, S, E); \
        } SEAM(pb + 5); \
        if (IN(pb + 6)) { \
            KArgs A = kargs(); float* XA = A->out; \
            pg8::Gemm g{(const bf16_t*)(A->ws + WS_P), (const bf16_t*)(A->ws + WS_WDN) + (size_t)l * DM * DFF, TT, DM, DFF}; pg8::StaticOrder S; S.init(TT, DM, gridDim.x, blockIdx.x); \
            pg8::EpiResid E{XA, XA + (size_t)TP * DM, XA, MODP(A) + (size_t)l * 9 * NMOD + 5120, \
                            l == 0 ? HP(A) : (bf16_t*)nullptr, A->norm1_w + DM, MODP(A) + (size_t)9 * NMOD + 1024, (float*)(A->ws + WS_RSP), (LAS float*)(lds + XCH_OFF)}; \
            pg8::gemm_phase<pg8::EpiResid, pg8::StaticOrder, true, true>(lds, g, S, E); \
        } SEAM(pb + 6); \
    } while (0)
    LAYER_BODY(0);
    LAYER_BODY(1);
#undef LAYER_BODY
    if (IN(16)) { KArgs A = kargs(); phase_final_norm(A); }
    if (PROBE_PH >= 0) { if (PROBE_PH == NPH - 1 && threadIdx.x == 0) *(volatile LAS unsigned long long*)(lds + MISC_OFF + 136) = __builtin_amdgcn_s_memrealtime();
        if (blockIdx.x == 0 && threadIdx.x == 0) { const unsigned long long pt0 = *(volatile LAS unsigned long long*)(lds + MISC_OFF + 128), pt1 = *(volatile LAS unsigned long long*)(lds + MISC_OFF + 136); const unsigned long long t_end = __builtin_amdgcn_s_memrealtime(), w = 8ull * (pt1 - pt0); while (__builtin_amdgcn_s_memrealtime() - t_end < w) __builtin_amdgcn_s_sleep(32); } }
#undef IN
#undef SEAM
}

extern "C" void kernel_launch(void* const* d_in, const int* in_sizes, int n_in, void* d_out, int out_size, void* d_ws, size_t ws_size, hipStream_t stream) {
    static int grid = 0;
    if (grid == 0) {
        if (n_in != 28 || ws_size < WS_END) { fprintf(stderr, "kernel_launch: unexpected inputs (n_in %d, ws %zu)\n", n_in, ws_size); grid = -1; return; }
        int dev = 0, cus = 0;
        if (hipGetDevice(&dev) != hipSuccess || hipDeviceGetAttribute(&cus, hipDeviceAttributeMultiprocessorCount, dev) != hipSuccess) { grid = -1; return; }
        if (hipFuncSetAttribute((const void*)mk_fwd, hipFuncAttributeMaxDynamicSharedMemorySize, LDS_BYTES) != hipSuccess) { fprintf(stderr, "kernel_launch: hipFuncSetAttribute failed\n"); grid = -1; return; }
        int per_cu = 0;
        if (hipOccupancyMaxActiveBlocksPerMultiprocessor(&per_cu, (const void*)mk_fwd, 512, LDS_BYTES) != hipSuccess || per_cu < 1) fprintf(stderr, "kernel_launch: occupancy query reports %d\n", per_cu);
        (void)hipGetLastError();
        grid = cus;
    }
    if (grid < 0) return;
    (void)hipMemsetAsync((char*)d_ws + WS_CTL, 0, CTL_BYTES, stream);
    Args a{};
    const float** ap = (const float**)&a;
    for (int i = 0; i < 28; ++i) ap[i] = (const float*)d_in[i];
    a.out = (float*)d_out; a.ws = (unsigned char*)d_ws;
    if (MK_N_LAUNCHES == 1) { a.ph_lo = 0; a.ph_hi = NPH; hipLaunchKernelGGL(mk_fwd, dim3(grid), dim3(512), LDS_BYTES, stream, a); }
    else { for (int p = 0; p < NPH; ++p) { a.ph_lo = p; a.ph_hi = p + 1; hipLaunchKernelGGL(mk_fwd, dim3(grid), dim3(512), LDS_BYTES, stream, a); } }
}
```

```cpp
#include <hip/hip_runtime.h>
#include <cstdio>
#include <cstdint>

#define DI __device__ __forceinline__
#define LAS __attribute__((address_space(3)))
#define GAS __attribute__((address_space(1)))
typedef unsigned short bf16_t;
typedef short bf16x8 __attribute__((ext_vector_type(8)));
typedef float f32x4 __attribute__((ext_vector_type(4)));
typedef float f32x16 __attribute__((ext_vector_type(16)));
typedef unsigned u32x4 __attribute__((ext_vector_type(4)));
typedef unsigned u32x2 __attribute__((ext_vector_type(2)));
typedef float f32x2_t __attribute__((ext_vector_type(2)));
typedef __bf16 bf16x2_t __attribute__((ext_vector_type(2)));
typedef LAS unsigned char lds_t;

#ifndef PROBE_PH
#define PROBE_PH (-1)
#endif
#ifndef MK_N_LAUNCHES
#define MK_N_LAUNCHES 1
#endif

constexpr int DM = 1024, TP = 4096, TS = 8192, TT = 12288, NIN = 4096, DFF = 2816, NUP = 5632, NMOD = 6144;
constexpr int NPH = 17;
constexpr float EPS = 1e-6f;

constexpr size_t MiB = 1u << 20;
constexpr size_t WS_CTL = 0, CTL_BYTES = 1 * MiB;
constexpr size_t WS_LBT = 1 * MiB;
constexpr size_t WS_BIAS = 1 * MiB + 64 * 1024;
constexpr size_t BIAS2_OFF = 2 * 9 * 4096 * 4;
constexpr size_t WS_RSP = 2 * MiB;
constexpr size_t WS_GF = 3 * MiB;
constexpr size_t GF_LSTRIDE = 2560 * 1024, GF_SAMPLE_OFF = 512 * 1024;
constexpr size_t WS_WIN = 10 * MiB, WS_WOUT = 26 * MiB, WS_WUP = 30 * MiB, WS_WDN = 52 * MiB;
constexpr size_t WS_H = 64 * MiB;
constexpr size_t WS_MERGED = 88 * MiB;
constexpr size_t WS_P = 112 * MiB;
constexpr size_t WS_UT = 208 * MiB, WS_X2T = 220 * MiB;
constexpr size_t WS_XB = 232 * MiB;
constexpr size_t WS_END = 256 * MiB;
constexpr int CW_BAR = 4096;
constexpr int CW_QUEUE = 8192;
constexpr int CW_HYABS = 9216;
constexpr int CW_MOD = 16384;
static_assert((CW_MOD + 2 * 9 * NMOD) * 4 <= (int)CTL_BYTES, "ctl");

constexpr int LDS_BYTES = 163840;
constexpr int RING_BYTES = 131072;
constexpr int XCH_OFF = 131072;
constexpr int MISC_OFF = 163840 - 256;

DI unsigned pkbf(float lo, float hi) { f32x2_t v = {lo, hi}; bf16x2_t b = __builtin_convertvector(v, bf16x2_t); return __builtin_bit_cast(unsigned, b); }
DI float bflo(unsigned u) { return __uint_as_float(u << 16); }
DI float bfhi(unsigned u) { return __uint_as_float(u & 0xffff0000u); }
DI float bf1(bf16_t h) { return __uint_as_float(((unsigned)h) << 16); }
DI float silu_f(float x) { return x * __builtin_amdgcn_rcpf(1.0f + __expf(-x)); }
DI float wave_sum(float v) {
#pragma unroll
    for (int o = 1; o < 64; o <<= 1) v += __shfl_xor(v, o);
    return v;
}
DI int ltid() { int t = threadIdx.x; asm volatile("" : "+v"(t)); return t; }
DI int crow(int reg, int hh) { return (reg & 3) + 8 * (reg >> 2) + 4 * hh; }
DI int cid_of_tile(int pm) { return pm < 16 ? 0 : 1 + ((pm - 16) >> 2); }
DI int cid_of_row(int m) { return m < TP ? 0 : 1 + ((m - TP) >> 10); }
#define MFMA32(a, b, c) __builtin_amdgcn_mfma_f32_32x32x16_bf16((a), (b), (c), 0, 0, 0)
#define LDS_WAIT() asm volatile("s_waitcnt lgkmcnt(0)" ::: "memory")
#define VM_WAIT() asm volatile("s_waitcnt vmcnt(0)" ::: "memory")
#define BAR_LDS() do { asm volatile("s_waitcnt lgkmcnt(0)" ::: "memory"); __builtin_amdgcn_s_barrier(); asm volatile("" ::: "memory"); } while (0)

namespace pg8 {
#define PG8_LAS __attribute__((address_space(3)))
constexpr int BM = 256, BK = 64, HALF = 128, HTB = HALF * BK * 2, STAGE_BYTES = 8 * HTB, NXCD = 8, WGM = 8;
__host__ __device__ __forceinline__ int lds_byte(int r, int c) { const int st = (r >> 4) * 2 + (c >> 5), rr = r & 15, cc = c & 31, ob = rr * 64 + cc * 2; return st * 1024 + (ob ^ (((ob >> 9) & 1) << 5)); }
__host__ __device__ __forceinline__ void stage_rc(int b, int& R, int& C) { const int st = b / 1024, sb = b % 1024, swz = sb ^ (((sb >> 9) & 1) << 5); R = (st >> 1) * 16 + swz / 64; C = (st & 1) * 32 + (swz % 64) / 2; }
__host__ __device__ __forceinline__ int perm32(int rho) { const int n = rho >> 4, i = rho & 15; return 8 * (i >> 2) + 4 * n + (i & 3); }
struct Unit { int pm, pn; };
struct Gemm { const bf16_t* A; const bf16_t* Bt; int M, N, K; };
struct StaticOrder {
    int nM, nN, nwg, G, c;
    __host__ __device__ void init(int M, int N, int G_, int c_, int bm = BM) { nM = M / bm; nN = N / BM; nwg = nM * nN; G = G_; c = c_; }
    __host__ __device__ bool next(int i, Unit& u) const {
        const long L = (long)i * G + c; if (L >= nwg) return false;
        int wgid = (int)L; { const int q = nwg / NXCD, r = nwg % NXCD, xcd = wgid % NXCD, off = wgid / NXCD; wgid = (xcd < r ? xcd * (q + 1) : r * (q + 1) + (xcd - r) * q) + off; }
        const int nig = WGM * nN, gid = wgid / nig, fm = gid * WGM, gsz = (nM - fm) < WGM ? (nM - fm) : WGM;
        u.pm = fm + ((wgid % nig) % gsz); u.pn = (wgid % nig) / gsz; return true;
    }
    __device__ __forceinline__ void a_ready(const Unit&) const {}
    __device__ __forceinline__ void done(const Unit&) const {}
};


struct RNext { f32x4 a; };
__device__ __forceinline__ void rnext_load(RNext& q, const float* rsp, int pm, int tid, bool on) {
    q.a = (f32x4){0.f, 0.f, 0.f, 0.f};
    if (on) q.a = *(const f32x4*)(rsp + (size_t)(pm * BM + (tid & 255)) * 4);
}
__device__ __forceinline__ void rnext_store(const RNext& q, PG8_LAS float* R, int par, int tid, bool on) {
    if (on) { const float sm = (q.a.x + q.a.y) + (q.a.z + q.a.w); R[par * 256 + (tid & 255)] = 1.0f / sqrtf(sm * (1.0f / 1024.0f) + 1e-6f); }
}
struct EpiProj {
    static constexpr bool PERM = true, AFTER_DRAIN = false;
    bf16_t* P; const float* lbt; const float* rsp; const float* bias; PG8_LAS float* R;
    __device__ __forceinline__ void first(const Unit& u) const { const int tid = threadIdx.x; RNext q; rnext_load(q, rsp, u.pm, tid, tid < 256); rnext_store(q, R, 0, tid, tid < 256); }
    __device__ __forceinline__ void operator()(f32x4 (&acc)[2][2][4][2], const Unit& u, int wr, int wc, int fr, int fq, const Unit& nx, bool has_next, int ui) const {
        const int tid = (wr * 4 + wc) * 64 + fq * 16 + fr; const bool pre = has_next && wr == 0;
        RNext rq; rnext_load(rq, rsp, nx.pm, tid, pre);
        PG8_LAS const float* Rc = R + (ui & 1) * 256;
        const int row0 = u.pm * BM + wr * 64 + fr, typ = u.pn >> 1, col0 = u.pn * BM + wc * 32 + 8 * fq;
        const float* bp = bias + cid_of_tile(u.pm) * NIN + col0;
        float rr[2][4];
#pragma unroll
        for (int ai = 0; ai < 2; ++ai)
#pragma unroll
            for (int m = 0; m < 4; ++m) rr[ai][m] = Rc[ai * HALF + wr * 64 + m * 16 + fr];
#pragma unroll
        for (int bj = 0; bj < 2; ++bj) {
            float lb[8], bs[8];
            { const f32x4 b0 = *(const f32x4*)(bp + bj * HALF), b1 = *(const f32x4*)(bp + bj * HALF + 4); bs[0] = b0.x; bs[1] = b0.y; bs[2] = b0.z; bs[3] = b0.w; bs[4] = b1.x; bs[5] = b1.y; bs[6] = b1.z; bs[7] = b1.w; }
#pragma unroll
            for (int i = 0; i < 8; ++i) lb[i] = 0.f;
            if (typ == 1 || typ == 2) {
                const float* lp = lbt + (typ - 1) * 512 + (col0 + bj * HALF - 512 * typ);
#pragma unroll
                for (int i = 0; i < 8; ++i) lb[i] = lp[i];
            }
#pragma unroll
            for (int ai = 0; ai < 2; ++ai)
#pragma unroll
                for (int m = 0; m < 4; ++m) {
                    float x[8];
#pragma unroll
                    for (int n = 0; n < 2; ++n)
#pragma unroll
                        for (int e = 0; e < 4; ++e) x[4 * n + e] = acc[ai][bj][m][n][e] * rr[ai][m] + bs[4 * n + e];
                    if (typ == 0) {
#pragma unroll
                        for (int i = 0; i < 8; ++i) x[i] = silu_f(x[i]) * 0.08838834764831845f;
                    } else if (typ == 1 || typ == 2) {
#pragma unroll
                        for (int i = 0; i < 8; ++i) { const float sg = __builtin_amdgcn_rcpf(1.0f + __expf(-x[i])); x[i] = __logf(lb[i] + (1.0f - lb[i]) * sg); }
                    } else if (typ == 4) {
#pragma unroll
                        for (int i = 0; i < 8; ++i) x[i] = silu_f(x[i]);
                    }
                    u32x4 w; w.x = pkbf(x[0], x[1]); w.y = pkbf(x[2], x[3]); w.z = pkbf(x[4], x[5]); w.w = pkbf(x[6], x[7]);
                    *(u32x4*)(P + (size_t)(row0 + ai * HALF + m * 16) * NIN + col0 + bj * HALF) = w;
                }
        }
        rnext_store(rq, R, (ui + 1) & 1, tid, pre);
    }
};

template <bool BASE_BF16, bool OUT_BF16, int MT> struct EpiResid {
    static constexpr bool PERM = false, AFTER_DRAIN = false;
    static constexpr int BMU = 64 * MT, RH = 32 * MT;
    const float* bp; const float* bs; const bf16_t* xb; float* outf; bf16_t* outb; const float* gate;
    bf16_t* Hn; const float* nw; const float* sc; float* rsp; PG8_LAS float* PS;
    __device__ __forceinline__ void first(const Unit&) const {}
    __device__ __forceinline__ void operator()(f32x4 (&acc)[2][2][MT][2], const Unit& u, int wr, int wc, int fr, int fq, const Unit&, bool, int) const {
        const int rowt = u.pm * BMU + wr * (16 * MT), col0 = u.pn * BM + wc * 32 + 4 * fq;
        f32x4 gv[2][2], cv[2][2]; int cur_cid = -1;
        constexpr int MB = (BASE_BF16 && MT == 4) ? 2 : 1;
#pragma unroll
        for (int ai = 0; ai < 2; ++ai)
#pragma unroll
        for (int mh = 0; mh < MT; mh += MB) {
            const int rowg = rowt + ai * RH + mh * 16, cid = cid_of_row(rowg);
            const float* base = (rowg < TP) ? bp : (bs - (size_t)TP * DM);
            if (cid != cur_cid) { cur_cid = cid;
#pragma unroll
                for (int bj = 0; bj < 2; ++bj)
#pragma unroll
                    for (int n = 0; n < 2; ++n) { gv[bj][n] = *(const f32x4*)(gate + cid * NMOD + col0 + bj * HALF + n * 16);
                        cv[bj][n] = (f32x4){0.f, 0.f, 0.f, 0.f};
                        if (Hn) cv[bj][n] = *(const f32x4*)(nw + col0 + bj * HALF + n * 16) * (1.0f + *(const f32x4*)(sc + cid * NMOD + col0 + bj * HALF + n * 16)); } }
            f32x4 bf[MB][2][2]; u32x2 bb[MB][2][2];
#pragma unroll
            for (int mi = 0; mi < MB; ++mi) { const size_t off = (size_t)(rowg + mi * 16 + fr) * DM + col0;
#pragma unroll
                for (int bj = 0; bj < 2; ++bj)
#pragma unroll
                    for (int n = 0; n < 2; ++n) { if constexpr (BASE_BF16) bb[mi][bj][n] = *(const u32x2*)(xb + off + bj * HALF + n * 16); else bf[mi][bj][n] = *(const f32x4*)(base + off + bj * HALF + n * 16); } }
#pragma unroll
            for (int mi = 0; mi < MB; ++mi) { const int m = mh + mi, row = rowg + mi * 16 + fr; const size_t off = (size_t)row * DM + col0; float ps = 0.f;
#pragma unroll
                for (int bj = 0; bj < 2; ++bj)
#pragma unroll
                    for (int n = 0; n < 2; ++n) {
                        f32x4 b;
                        if constexpr (BASE_BF16) { const u32x2 q = bb[mi][bj][n]; b = (f32x4){bflo(q.x), bfhi(q.x), bflo(q.y), bfhi(q.y)}; } else b = bf[mi][bj][n];
                        const f32x4 o = b + gv[bj][n] * acc[ai][bj][m][n];
                        if constexpr (OUT_BF16) { u32x2 pk; pk.x = pkbf(o.x, o.y); pk.y = pkbf(o.z, o.w); *(u32x2*)(outb + off + bj * HALF + n * 16) = pk; } else *(f32x4*)(outf + off + bj * HALF + n * 16) = o;
                        if (Hn) { ps += (o.x * o.x + o.y * o.y) + (o.z * o.z + o.w * o.w); const f32x4 a = o * cv[bj][n]; u32x2 pk; pk.x = pkbf(a.x, a.y); pk.y = pkbf(a.z, a.w); *(u32x2*)(Hn + off + bj * HALF + n * 16) = pk; } }
                if (Hn) { ps += __shfl_xor(ps, 16); ps += __shfl_xor(ps, 32); if (fq == 0) PS[wc * 256 + ai * RH + wr * (16 * MT) + m * 16 + fr] = ps; } }
        }
        if (Hn) {
            asm volatile("s_waitcnt lgkmcnt(0)" ::: "memory"); __builtin_amdgcn_s_barrier(); asm volatile("" ::: "memory");
            const int tid = (wr * 4 + wc) * 64 + fq * 16 + fr;
            if (tid < BMU) rsp[(size_t)(u.pm * BMU + tid) * 4 + u.pn] = (PS[tid] + PS[256 + tid]) + (PS[512 + tid] + PS[768 + tid]);
        }
    }
};

struct EpiFfn {
    static constexpr bool PERM = true, AFTER_DRAIN = false;
    bf16_t* ACT; const float* cw; PG8_LAS float* X; const float* rsp; const float* bias; PG8_LAS float* R;
    __device__ __forceinline__ void first(const Unit& u) const { const int tid = threadIdx.x; RNext q; rnext_load(q, rsp, u.pm, tid, tid < 256); rnext_store(q, R, 0, tid, tid < 256); }
    __device__ __forceinline__ void operator()(f32x4 (&acc)[2][2][4][2], const Unit& u, int wr, int wc, int fr, int fq, const Unit& nx, bool has_next, int ui) const {
        const bool prompt = u.pm < 16;
        const int lane = fq * 16 + fr;
        const int cc0 = wc * 32 + 8 * fq, fbase = u.pn * HALF + cc0;
        const int tid = (wr * 4 + wc) * 64 + lane; const bool pre = has_next && wr == 0;
        RNext rq; rnext_load(rq, rsp, nx.pm, tid, pre);
        PG8_LAS const float* Rc = R + (ui & 1) * 256;
        {
            const float* bp = bias + cid_of_tile(u.pm) * NUP + u.pn * BM + cc0;
#pragma unroll
            for (int bj = 0; bj < 2; ++bj)
#pragma unroll
                for (int n = 0; n < 2; ++n) { const f32x4 bv = *(const f32x4*)(bp + bj * HALF + 4 * n);
#pragma unroll
                    for (int ai = 0; ai < 2; ++ai)
#pragma unroll
                        for (int m = 0; m < 4; ++m) acc[ai][bj][m][n] = acc[ai][bj][m][n] * Rc[ai * HALF + wr * 64 + m * 16 + fr] + bv; }
        }
        const int src_prev = (lane & 48) | ((fr + 15) & 15), src_next = (lane & 48) | ((fr + 1) & 15);
        if (prompt) {
#pragma unroll
            for (int ai = 0; ai < 2; ++ai) { const int slab = 2 * ai + wr;
#pragma unroll
                for (int bj = 0; bj < 2; ++bj)
#pragma unroll
                    for (int n = 0; n < 2; ++n) {
                        if (fr == 0) *(PG8_LAS f32x4*)(X + (slab * 2 + 0) * 256 + bj * HALF + cc0 + 4 * n) = acc[ai][bj][0][n];
                        if (fr == 15) *(PG8_LAS f32x4*)(X + (slab * 2 + 1) * 256 + bj * HALF + cc0 + 4 * n) = acc[ai][bj][3][n];
                    } }
            asm volatile("s_waitcnt lgkmcnt(0)" ::: "memory"); __builtin_amdgcn_s_barrier(); asm volatile("" ::: "memory");
        }
#pragma unroll
        for (int n = 0; n < 2; ++n) {
            f32x4 wg[3], wv[3];
#pragma unroll
            for (int j = 0; j < 3; ++j) { wg[j] = *(const f32x4*)(cw + j * NUP + fbase + 4 * n); wv[j] = *(const f32x4*)(cw + j * NUP + DFF + fbase + 4 * n); }
#pragma unroll
            for (int ai = 0; ai < 2; ++ai) {
                const int slab = 2 * ai + wr;
                f32x4 hp[2], hn[2];
#pragma unroll
                for (int bj = 0; bj < 2; ++bj) { hp[bj] = (f32x4){0.f, 0.f, 0.f, 0.f}; hn[bj] = (f32x4){0.f, 0.f, 0.f, 0.f}; }
                if (prompt) {
#pragma unroll
                    for (int bj = 0; bj < 2; ++bj) {
                        if (fr == 0 && slab > 0) hp[bj] = *(PG8_LAS f32x4*)(X + ((slab - 1) * 2 + 1) * 256 + bj * HALF + cc0 + 4 * n);
                        if (fr == 15 && slab < 3) hn[bj] = *(PG8_LAS f32x4*)(X + ((slab + 1) * 2 + 0) * 256 + bj * HALF + cc0 + 4 * n);
                    }
                }
#pragma unroll
                for (int m = 0; m < 4; ++m) {
                    float cv[2][4];
#pragma unroll
                    for (int bj = 0; bj < 2; ++bj)
#pragma unroll
                        for (int e = 0; e < 4; ++e) {
                            const float c = acc[ai][bj][m][n][e];
                            const float r1 = __shfl(c, src_prev), r15 = __shfl(c, src_next);
                            float pm1, pn1;
                            if (m > 0) pm1 = __shfl(acc[ai][bj][m > 0 ? m - 1 : 0][n][e], src_prev); else pm1 = hp[bj][e];
                            if (m < 3) pn1 = __shfl(acc[ai][bj][m < 3 ? m + 1 : 3][n][e], src_next); else pn1 = hn[bj][e];
                            const float p = (fr == 0) ? pm1 : r1, nx = (fr == 15) ? pn1 : r15;
                            const float w0 = bj ? wv[0][e] : wg[0][e], w1 = bj ? wv[1][e] : wg[1][e], w2 = bj ? wv[2][e] : wg[2][e];
                            cv[bj][e] = w0 * p + w1 * c + w2 * nx;
                        }
                    u32x2 w; w.x = pkbf(silu_f(cv[0][0]) * cv[1][0], silu_f(cv[0][1]) * cv[1][1]); w.y = pkbf(silu_f(cv[0][2]) * cv[1][2], silu_f(cv[0][3]) * cv[1][3]);
                    *(u32x2*)(ACT + (size_t)(u.pm * BM + ai * HALF + wr * 64 + m * 16 + fr) * DFF + fbase + 4 * n) = w;
                }
            }
        }
        rnext_store(rq, R, (ui + 1) & 1, tid, pre);
    }
};

template <class Epi, class Sched, bool ALIGN_EPI = false, bool SP2 = false, int MT = 4>
__device__ __forceinline__ void gemm_phase(PG8_LAS unsigned char* lds, const Gemm g, const Sched& S, const Epi& E) {
    const int tid = ltid(), wid = __builtin_amdgcn_readfirstlane(tid >> 6), lane = tid & 63, wr = wid >> 2, wc = wid & 3, fr = lane & 15, fq = lane >> 4;
    const int K = g.K, nt = K / BK;
    unsigned voffA[2], voffB[2];
#pragma unroll
    for (int i = 0; i < 2; ++i) { int R, C; stage_rc(tid * 16 + i * 8192, R, C); const int Rb = Epi::PERM ? ((R & ~31) + perm32(R & 31)) : R;
        voffA[i] = (unsigned)(R * K + C) * 2u; voffB[i] = (unsigned)(Rb * K + C) * 2u; }
    const size_t kstep = (size_t)(BK * 2);
    const size_t hstep = (size_t)HALF * K * 2;
    const size_t tstep = 2 * hstep;
    const size_t hstepA = (size_t)(32 * MT) * K * 2;
    const size_t tstepA = 2 * hstepA;
    const unsigned ldsw = (unsigned)wid * 1024u;
    const int aoff = lds_byte(wr * (16 * MT) + fr, fq * 8), boff = lds_byte(wc * 32 + fr, fq * 8);
#define PG8_SA(b, h) (((b) * 2 + (h)) * HTB)
#define PG8_SB(b, h) ((4 + (b) * 2 + (h)) * HTB)
#define PG8_STAGE(bufoff, gbase, voff) do { _Pragma("unroll") for (int _i = 0; _i < 2; ++_i) \
        __builtin_amdgcn_global_load_lds((const unsigned*)((const char*)(gbase) + (voff)[_i]), (PG8_LAS unsigned*)(lds + (bufoff) + ldsw + _i * 8192), 16, 0, 0); } while (0)
#define PG8_LDA(dst, b, h) do { _Pragma("unroll") for (int m = 0; m < MT; ++m) _Pragma("unroll") for (int k = 0; k < 2; ++k) dst[m][k] = *(const PG8_LAS bf16x8*)(lds + PG8_SA(b, h) + aoff + m * 2048 + k * 1024); } while (0)
#define PG8_LDB(dst, b, h) do { _Pragma("unroll") for (int n = 0; n < 2; ++n) _Pragma("unroll") for (int k = 0; k < 2; ++k) dst[n][k] = *(const PG8_LAS bf16x8*)(lds + PG8_SB(b, h) + boff + n * 2048 + k * 1024); } while (0)
#define PG8_MMA(ai, bj, At, Bt) do { __builtin_amdgcn_s_setprio(1); _Pragma("unroll") for (int m = 0; m < MT; ++m) _Pragma("unroll") for (int n = 0; n < 2; ++n) _Pragma("unroll") for (int k = 0; k < 2; ++k) \
        acc[ai][bj][m][n] = __builtin_amdgcn_mfma_f32_16x16x32_bf16(Bt[n][k], At[m][k], acc[ai][bj][m][n], 0, 0, 0); __builtin_amdgcn_s_setprio(0); } while (0)
#define PG8_WAIT_V(n) asm volatile("s_waitcnt vmcnt(" #n ")" ::: "memory")
#define PG8_WAIT_L(n) asm volatile("s_waitcnt lgkmcnt(" #n ")" ::: "memory")
#define PG8_BAR __builtin_amdgcn_s_barrier()
#define PG8_SCHED __builtin_amdgcn_sched_barrier(0)
    Unit cur, nxt; int ui = 0;
    if (!S.next(0, cur)) return;
    f32x4 acc[2][2][MT][2];
#pragma unroll
    for (int a = 0; a < 2; ++a)
#pragma unroll
        for (int b = 0; b < 2; ++b)
#pragma unroll
            for (int m = 0; m < MT; ++m)
#pragma unroll
                for (int n = 0; n < 2; ++n) acc[a][b][m][n] = (f32x4){0.f, 0.f, 0.f, 0.f};
    bf16x8 At[MT][2], B0[2][2], B1[2][2];
    const char* cA = (const char*)g.A + (size_t)cur.pm * tstepA; const char* cB = (const char*)g.Bt + (size_t)cur.pn * tstep;
    S.a_ready(cur);
    E.first(cur);
    if constexpr (SP2) {
        PG8_STAGE(PG8_SB(0, 0), cB, voffB); PG8_STAGE(PG8_SB(0, 1), cB + hstep, voffB); PG8_STAGE(PG8_SA(0, 0), cA, voffA); PG8_STAGE(PG8_SA(0, 1), cA + hstepA, voffA);
        if (wr == 1) PG8_BAR;
        PG8_WAIT_V(2); PG8_BAR;
        PG8_STAGE(PG8_SB(1, 0), cB + kstep, voffB); PG8_STAGE(PG8_SA(1, 0), cA + kstep, voffA); PG8_STAGE(PG8_SB(1, 1), cB + hstep + kstep, voffB);
        PG8_WAIT_V(6); PG8_BAR;
    } else {
        PG8_STAGE(PG8_SB(0, 0), cB, voffB); PG8_STAGE(PG8_SA(0, 0), cA, voffA); PG8_STAGE(PG8_SB(0, 1), cB + hstep, voffB); PG8_STAGE(PG8_SA(0, 1), cA + hstepA, voffA);
        if (wr == 1) PG8_BAR;
        PG8_WAIT_V(4); PG8_BAR;
        PG8_STAGE(PG8_SB(1, 0), cB + kstep, voffB); PG8_STAGE(PG8_SA(1, 0), cA + kstep, voffA); PG8_STAGE(PG8_SB(1, 1), cB + hstep + kstep, voffB);
        PG8_WAIT_V(6); PG8_BAR;
    }
    for (;;) {
        const bool has_next = S.next(ui + 1, nxt);
        const char* nA = has_next ? (const char*)g.A + (size_t)nxt.pm * tstepA : cA; const char* nB = has_next ? (const char*)g.Bt + (size_t)nxt.pn * tstep : cB;
        for (int t = 0; t < nt; t += 2) {
            const bool last = (t == nt - 2);
            const char* a1 = cA + (size_t)(t + 1) * kstep;
            const char* a2 = last ? nA : cA + (size_t)(t + 2) * kstep; const char* b2 = last ? nB : cB + (size_t)(t + 2) * kstep;
            const char* a3 = a2 + kstep; const char* b3 = b2 + kstep;
            if (last && has_next) S.a_ready(nxt);
            if constexpr (SP2) {
            PG8_LDB(B0, 0, 0); PG8_LDB(B1, 0, 1); PG8_SCHED; PG8_LDA(At, 0, 0); PG8_STAGE(PG8_SA(1, 1), a1 + hstepA, voffA);
            PG8_WAIT_V(8); PG8_WAIT_L(0); PG8_BAR; PG8_MMA(0, 0, At, B0); PG8_MMA(0, 1, At, B1); PG8_BAR; PG8_SCHED;
            PG8_LDA(At, 0, 1); PG8_STAGE(PG8_SB(0, 0), b2, voffB); PG8_STAGE(PG8_SB(0, 1), b2 + hstep, voffB); PG8_STAGE(PG8_SA(0, 0), a2, voffA);
            PG8_WAIT_V(8); PG8_WAIT_L(0); PG8_BAR; PG8_MMA(1, 0, At, B0); PG8_MMA(1, 1, At, B1); PG8_BAR; PG8_SCHED;
            PG8_LDB(B0, 1, 0); PG8_LDB(B1, 1, 1); PG8_SCHED; PG8_LDA(At, 1, 0); PG8_STAGE(PG8_SA(0, 1), a2 + hstepA, voffA);
            PG8_WAIT_V(8); PG8_WAIT_L(0); PG8_BAR; PG8_MMA(0, 0, At, B0); PG8_MMA(0, 1, At, B1); PG8_BAR; PG8_SCHED;
            PG8_LDA(At, 1, 1); PG8_STAGE(PG8_SB(1, 0), b3, voffB); PG8_STAGE(PG8_SB(1, 1), b3 + hstep, voffB); PG8_STAGE(PG8_SA(1, 0), a3, voffA);
            PG8_WAIT_V(8); PG8_WAIT_L(0); PG8_BAR; PG8_MMA(1, 0, At, B0); PG8_MMA(1, 1, At, B1); PG8_BAR; PG8_SCHED;
            } else {
            PG8_LDB(B0, 0, 0); PG8_SCHED; PG8_LDA(At, 0, 0); PG8_STAGE(PG8_SA(1, 1), a1 + hstepA, voffA);
            PG8_WAIT_L(8); PG8_BAR; PG8_WAIT_L(0); PG8_MMA(0, 0, At, B0); PG8_BAR; PG8_SCHED;
            PG8_LDB(B1, 0, 1); PG8_STAGE(PG8_SB(0, 0), b2, voffB);
            PG8_BAR; PG8_WAIT_L(0); PG8_MMA(0, 1, At, B1); PG8_BAR;
            PG8_LDA(At, 0, 1); PG8_STAGE(PG8_SA(0, 0), a2, voffA);
            PG8_BAR; PG8_WAIT_L(0); PG8_MMA(1, 0, At, B0); PG8_BAR; PG8_SCHED;
            PG8_STAGE(PG8_SB(0, 1), b2 + hstep, voffB);
            PG8_WAIT_V(6); PG8_BAR; PG8_MMA(1, 1, At, B1); PG8_BAR;
            PG8_LDB(B0, 1, 0); PG8_SCHED; PG8_LDA(At, 1, 0); PG8_STAGE(PG8_SA(0, 1), a2 + hstepA, voffA);
            PG8_WAIT_L(8); PG8_BAR; PG8_WAIT_L(0); PG8_MMA(0, 0, At, B0); PG8_BAR; PG8_SCHED;
            PG8_LDB(B1, 1, 1); PG8_STAGE(PG8_SB(1, 0), b3, voffB);
            PG8_BAR; PG8_WAIT_L(0); PG8_MMA(0, 1, At, B1); PG8_BAR;
            PG8_LDA(At, 1, 1); PG8_STAGE(PG8_SA(1, 0), a3, voffA);
            PG8_BAR; PG8_WAIT_L(0); PG8_MMA(1, 0, At, B0); PG8_BAR; PG8_SCHED;
            PG8_STAGE(PG8_SB(1, 1), b3 + hstep, voffB);
            PG8_WAIT_V(6); PG8_BAR; PG8_MMA(1, 1, At, B1); PG8_BAR;
            }
        }
        if constexpr (ALIGN_EPI) { if (wr == 0) PG8_BAR; }
        if constexpr (!Epi::AFTER_DRAIN) { E(acc, cur, wr, wc, fr, fq, nxt, has_next, ui); S.done(cur); }
        if (!has_next) break;
#pragma unroll
        for (int a = 0; a < 2; ++a)
#pragma unroll
            for (int b = 0; b < 2; ++b)
#pragma unroll
                for (int m = 0; m < MT; ++m)
#pragma unroll
                    for (int n = 0; n < 2; ++n) acc[a][b][m][n] = (f32x4){0.f, 0.f, 0.f, 0.f};
        cur = nxt; cA = nA; cB = nB; ++ui;
        if constexpr (ALIGN_EPI) { if (wr == 1) PG8_BAR; }
    }
    PG8_WAIT_V(0);
    if constexpr (!ALIGN_EPI) { if (wr == 0) PG8_BAR; }
    PG8_BAR;
#undef PG8_SA
#undef PG8_SB
#undef PG8_STAGE
#undef PG8_LDA
#undef PG8_LDB
#undef PG8_MMA
#undef PG8_WAIT_V
#undef PG8_WAIT_L
#undef PG8_BAR
#undef PG8_SCHED
}
}

#define XB_TMO      128
#define XB_XCNT(j)  (256  + 64 * (j))
#define XB_XSUB(j)  (1280 + 64 * (j))
#define XB_XGEN(j)  (2304 + 64 * (j))
#define XB_TOP      3328
#define XB_TOPGEN   3392
#define XCD_BAR_WORDS 3456
#define XB_SPIN_CAP (1u << 18)
DI unsigned xb_ld(unsigned* p)              { return __hip_atomic_load(p, __ATOMIC_RELAXED, __HIP_MEMORY_SCOPE_AGENT); }
DI unsigned xb_add(unsigned* p, unsigned v) { return __hip_atomic_fetch_add(p, v, __ATOMIC_RELAXED, __HIP_MEMORY_SCOPE_AGENT); }
DI unsigned xb_xcc_id() { return (unsigned)__builtin_amdgcn_s_getreg((3 << 11) | 20) & 0xFu; }
#define XB_SPIN(cond, bar) do { unsigned _sp = 0; while (cond) { __builtin_amdgcn_s_sleep(1); \
    if ((++_sp & 255u) == 0u) { if (xb_ld(&(bar)[XB_TMO])) break; if (_sp > XB_SPIN_CAP) { atomicAdd(&(bar)[XB_TMO], 1u); break; } } } } while (0)
struct XcdBarrier { unsigned* bar; unsigned x; volatile LAS unsigned* st; };
DI XcdBarrier xcd_barrier_post(unsigned* bar, volatile LAS unsigned* st) {
    XcdBarrier b; b.bar = bar; b.x = xb_xcc_id(); b.st = st;
    if (threadIdx.x == 0) (void)xb_add(&bar[XB_XCNT(b.x)], 1u);
    return b;
}
DI void xcd_barrier_complete(unsigned* bar, unsigned x, unsigned& nloc, unsigned& nx) {
    const unsigned G = gridDim.x * gridDim.y * gridDim.z;
    unsigned sum, cnt, mine, sp = 0u;
    for (;;) {
        sum = 0u; cnt = 0u; mine = 0u;
#pragma unroll
        for (unsigned j = 0; j < 16; ++j) { const unsigned c = xb_ld(&bar[XB_XCNT(j)]); sum += c; cnt += (c > 0u) ? 1u : 0u; mine = (j == x) ? c : mine; }
        if (sum == G) break;
        __builtin_amdgcn_s_sleep(1);
        if ((++sp & 255u) == 0u) { if (xb_ld(&bar[XB_TMO])) break; if (sp > XB_SPIN_CAP) { atomicAdd(&bar[XB_TMO], 1u); break; } }
    }
    nloc = mine > 0u ? mine : 1u; nx = cnt > 0u ? cnt : 1u;
}
DI void xcd_barrier(const XcdBarrier& b) {
    asm volatile("s_waitcnt vmcnt(0)" ::: "memory");
    __syncthreads();
    if (threadIdx.x == 0) {
        unsigned* bar = b.bar;
        __builtin_amdgcn_s_waitcnt(0);
        unsigned nloc = b.st[0], nx = b.st[1];
        if (nloc == 0u) { xcd_barrier_complete(bar, b.x, nloc, nx); b.st[0] = nloc; b.st[1] = nx; }
        const unsigned old = xb_add(&bar[XB_XSUB(b.x)], 1u);
        const unsigned gen = old / nloc;
        if (old + 1u == (gen + 1u) * nloc) {
            __builtin_amdgcn_fence(__ATOMIC_RELEASE, "agent");
            asm volatile("s_waitcnt vmcnt(0)" ::: "memory");
            const unsigned og = xb_add(&bar[XB_TOP], 1u);
            const unsigned tg = og / nx;
            if (og + 1u == (tg + 1u) * nx) xb_add(&bar[XB_TOPGEN], 1u);
            else XB_SPIN(xb_ld(&bar[XB_TOPGEN]) == tg, bar);
            __builtin_amdgcn_fence(__ATOMIC_ACQUIRE, "agent");
            xb_add(&bar[XB_XGEN(b.x)], 1u);
            asm volatile("s_waitcnt vmcnt(0)" ::: "memory");
        } else {
            XB_SPIN(xb_ld(&bar[XB_XGEN(b.x)]) == gen, bar);
            __builtin_amdgcn_fence(__ATOMIC_ACQUIRE, "agent");
            asm volatile("s_waitcnt vmcnt(0)" ::: "memory");
        }
    }
    __syncthreads();
}

struct Args {
    const float* x_prompt; const float* x_sample; const float* state; const float* c; const float* c_ctx;
    const float* w_in; const float* w_out; const float* ada_w; const float* ada_b; const float* norm1_w; const float* norm2_w;
    const float* hg_lb_fwd; const float* hg_lb_bwd; const float* hg_norm_w; const float* hy_conv_w;
    const float* hy_w1; const float* hy_b1; const float* hy_f1; const float* hy_w2; const float* hy_b2; const float* hy_f2; const float* hy_w3; const float* hy_d; const float* hy_norm_w;
    const float* ffn_up; const float* ffn_conv_w; const float* ffn_down; const float* final_norm_w;
    float* out; unsigned char* ws; int ph_lo, ph_hi;
};

typedef const __attribute__((address_space(4))) Args* KArgs;
DI KArgs kargs() { unsigned long long p = (unsigned long long)__builtin_amdgcn_kernarg_segment_ptr(); asm volatile("" : "+s"(p)); return (KArgs)p; }

struct TrItem { const float* W; bf16_t* WT; int K, N, k0, n0, ns0; };
DI TrItem tr_decode(KArgs A, int it) {
    constexpr int I_IN = 16 * 128, I_OUT = 16 * 32, I_UP = 16 * 176, I_DN = 44 * 32, I_L = I_IN + I_OUT + I_UP + I_DN;
    const int l = it / I_L; int r = it % I_L; TrItem t; unsigned char* ws = A->ws;
    if (r < I_IN) { const int kb = r / 128, nb = r % 128; t.W = A->w_in + (size_t)l * DM * NIN; t.WT = (bf16_t*)(ws + WS_WIN) + (size_t)l * NIN * DM; t.K = DM; t.N = NIN; t.k0 = 64 * kb; t.n0 = 32 * nb; t.ns0 = 32 * nb; return t; } r -= I_IN;
    if (r < I_OUT) { const int kb = r / 32, nb = r % 32; t.W = A->w_out + (size_t)l * DM * DM; t.WT = (bf16_t*)(ws + WS_WOUT) + (size_t)l * DM * DM; t.K = DM; t.N = DM; t.k0 = 64 * kb; t.n0 = 32 * nb; t.ns0 = 32 * nb; return t; } r -= I_OUT;
    if (r < I_UP) { const int kb = r / 176, nb = r % 176, n0 = 32 * nb, tj = n0 >> 8, cc = n0 & 255; t.W = A->ffn_up + (size_t)l * DM * NUP; t.WT = (bf16_t*)(ws + WS_WUP) + (size_t)l * NUP * DM; t.K = DM; t.N = NUP; t.k0 = 64 * kb; t.n0 = n0;
        t.ns0 = cc < 128 ? 128 * tj + cc : DFF + 128 * tj + (cc - 128); return t; } r -= I_UP;
    { const int kb = r / 32, nb = r % 32; t.W = A->ffn_down + (size_t)l * DFF * DM; t.WT = (bf16_t*)(ws + WS_WDN) + (size_t)l * DM * DFF; t.K = DFF; t.N = DM; t.k0 = 64 * kb; t.n0 = 32 * nb; t.ns0 = 32 * nb; return t; }
}
DI void tr_load(const TrItem& t, int lane, f32x4 (&v)[8]) {
    const float* p = t.W + (size_t)(t.k0 + (lane >> 3)) * t.N + t.ns0 + 4 * (lane & 7);
#pragma unroll
    for (int i = 0; i < 8; ++i) v[i] = *(const f32x4*)(p + (size_t)(8 * i) * t.N);
}
DI void tr_store(const TrItem& t, int lane, const f32x4 (&v)[8], LAS float* scr) {
#pragma unroll
    for (int i = 0; i < 8; ++i) { LAS float* d = scr + (8 * i + (lane >> 3)) * 33 + 4 * (lane & 7); d[0] = v[i].x; d[1] = v[i].y; d[2] = v[i].z; d[3] = v[i].w; }
    LDS_WAIT(); asm volatile("" ::: "memory");
    const int c = lane & 7;
#pragma unroll
    for (int j = 0; j < 4; ++j) { const int n = (lane >> 3) + 8 * j; const LAS float* sp = scr + (8 * c) * 33 + n;
        u32x4 o; o.x = pkbf(sp[0 * 33], sp[1 * 33]); o.y = pkbf(sp[2 * 33], sp[3 * 33]); o.z = pkbf(sp[4 * 33], sp[5 * 33]); o.w = pkbf(sp[6 * 33], sp[7 * 33]);
        *(u32x4*)(t.WT + (size_t)(t.n0 + n) * t.K + t.k0 + 8 * c) = o; }
    LDS_WAIT(); asm volatile("" ::: "memory");
}
DI void tr_run(KArgs A, int first, int end, int stride, LAS float* scr, int lane) {
    if (first >= end) return;
    f32x4 va[8], vb[8];
    TrItem ta = tr_decode(A, first), tb = ta; tr_load(ta, lane, va);
    for (int it = first; it < end; it += 2 * stride) {
        const bool hb = it + stride < end;
        if (hb) { tb = tr_decode(A, it + stride); tr_load(tb, lane, vb); }
        tr_store(ta, lane, va, scr);
        if (!hb) break;
        const bool ha = it + 2 * stride < end;
        if (ha) { ta = tr_decode(A, it + 2 * stride); tr_load(ta, lane, va); }
        tr_store(tb, lane, vb, scr);
    }
}
constexpr int TR_FIRST = 16 * 128;
constexpr int TR_TOTAL = 2 * (16 * 128 + 16 * 32 + 16 * 176 + 44 * 32);
constexpr int TR_PER_BLOCK_ITEM = 32;
constexpr int TR_QITEMS = (TR_TOTAL - TR_FIRST + TR_PER_BLOCK_ITEM - 1) / TR_PER_BLOCK_ITEM;

DI void phase_p0a(KArgs A, lds_t* lds) {
    const int tid = threadIdx.x, lane = tid & 63, wave = __builtin_amdgcn_readfirstlane(tid >> 6), G = gridDim.x, bx = blockIdx.x;
    unsigned char* ws = A->ws;
    float* MOD = (float*)(ws + WS_CTL) + CW_MOD;
    float* HYABS = (float*)(ws + WS_CTL) + CW_HYABS;
    if (bx == 0) {
        float* LBT = (float*)(ws + WS_LBT);
        for (int i = tid; i < 1024; i += 512) { const int dir = i >> 9, c = i & 511; const float* p = dir ? A->hg_lb_bwd : A->hg_lb_fwd;
            const float p0 = p[c], p1 = p[512 + c], mx = fmaxf(p0, p1), e0 = __expf(p0 - mx), e1 = __expf(p1 - mx);
            LBT[0 * 1024 + dir * 512 + c] = 0.f; LBT[1 * 1024 + dir * 512 + c] = e1 / (e0 + e1); }
    }
    for (int rnd = 0; rnd < 2; ++rnd) {
        const int un = (G == 256) ? (bx < 160 ? (rnd == 0 ? bx : 999) : 160 + 2 * (bx - 160) + rnd) : bx + rnd * G;
        if (un >= 352) continue;
        if (un < 160) {
            const int l = un / 80, r = un % 80, cs = r < 16 ? 0 : 1, pb = cs ? r - 16 : r, L = cs ? 1024 : 256, p0 = pb * 16;
            LAS float* FE = (LAS float*)lds;
            LAS float* H1 = FE + 16 * 33;
            LAS float* H2 = H1 + 16 * 64;
            LAS float* W1 = H2 + 16 * 64;
            LAS float* W2 = W1 + 33 * 64;
            LAS float* PR = W2 + 64 * 64;
            for (int i = tid; i < 33 * 64; i += 512) W1[i] = A->hy_w1[l * 33 * 64 + i];
            for (int i = tid; i < 64 * 64; i += 512) W2[i] = A->hy_w2[l * 64 * 64 + i];
            if (tid < 256) { const int q = tid >> 6, o = tid & 63; const float* src = q == 0 ? A->hy_b1 : (q == 1 ? A->hy_f1 : (q == 2 ? A->hy_b2 : A->hy_f2)); PR[tid] = src[l * 64 + o]; }
            for (int i = tid; i < 16 * 33; i += 512) { const int p = i / 33, e = i % 33, pos = p0 + p; float v;
                if (e == 0) v = (float)pos / (float)(L - 1);
                else { const int k = (e - 1) & 15; const float band = 1e-4f + (float)k * ((15.0f - 1e-4f) / 15.0f); const float ang = 6.283185307179586f * (float)pos * band / (float)L; v = (e <= 16) ? cosf(ang) : sinf(ang); }
                FE[i] = v; }
            __syncthreads();
            for (int i = tid; i < 16 * 64; i += 512) { const int p = i >> 6, o = i & 63; float sm = PR[o];
#pragma unroll
                for (int e = 0; e < 33; ++e) sm += FE[p * 33 + e] * W1[e * 64 + o];
                H1[i] = sinf(PR[64 + o] * sm); }
            __syncthreads();
            for (int i = tid; i < 16 * 64; i += 512) { const int p = i >> 6, o = i & 63; float sm = PR[128 + o];
#pragma unroll
                for (int k4 = 0; k4 < 16; ++k4) { const f32x4 h = *(const LAS f32x4*)(H1 + p * 64 + 4 * k4); sm += (h.x * W2[(4 * k4) * 64 + o] + h.y * W2[(4 * k4 + 1) * 64 + o]) + (h.z * W2[(4 * k4 + 2) * 64 + o] + h.w * W2[(4 * k4 + 3) * 64 + o]); }
                H2[i] = sinf(PR[192 + o] * sm); }
            __syncthreads();
            float af[16], ab[16];
#pragma unroll
            for (int p = 0; p < 16; ++p) { af[p] = 0.f; ab[p] = 0.f; }
            const float* w3 = A->hy_w3 + (size_t)l * 64 * 1024;
#pragma unroll 1
            for (int kb = 0; kb < 64; kb += 16) {
                float wf[16], wb[16];
#pragma unroll
                for (int k = 0; k < 16; ++k) { wf[k] = w3[(kb + k) * 1024 + tid]; wb[k] = w3[(kb + k) * 1024 + 512 + tid]; }
#pragma unroll
                for (int p = 0; p < 16; ++p)
#pragma unroll
                    for (int k4 = 0; k4 < 4; ++k4) { const f32x4 h = *(const LAS f32x4*)(H2 + p * 64 + kb + 4 * k4);
                        af[p] += (h.x * wf[4 * k4] + h.y * wf[4 * k4 + 1]) + (h.z * wf[4 * k4 + 2] + h.w * wf[4 * k4 + 3]);
                        ab[p] += (h.x * wb[4 * k4] + h.y * wb[4 * k4 + 1]) + (h.z * wb[4 * k4 + 2] + h.w * wb[4 * k4 + 3]); }
            }
            const float mind = -3.0701134573253944f, maxd = -15.350567286626973f;
            const float delta = fabsf(mind + (float)tid * ((maxd - mind) / 511.0f));
            bf16_t* GF = (bf16_t*)(ws + WS_GF + (size_t)l * GF_LSTRIDE + (cs ? GF_SAMPLE_OFF : 0)) + (size_t)tid * (2 * L);
            float asum = 0.f;
#pragma unroll
            for (int p = 0; p < 16; ++p) { const int pos = p0 + p; const float tt = (float)pos / (float)(L - 1), dec = __expf(-tt * delta);
                const float hf = af[p] * dec, hb = ab[p] * dec;
                GF[L + pos] = (bf16_t)(pkbf(hf, 0.f) & 0xffffu); asum += fabsf(hf);
                if (pos >= 1) { GF[L - pos] = (bf16_t)(pkbf(hb, 0.f) & 0xffffu); asum += fabsf(hb); } else GF[0] = 0; }
            atomicAdd(&HYABS[(l * 2 + cs) * 512 + tid], asum);
            __syncthreads();
        } else {
            const int v = un - 160, l = v / 96, r = v % 96, jb = r >> 2, kq = r & 3;
            LAS float* SC = (LAS float*)lds;
            LAS float* PA = SC + 9 * 256;
            for (int i = tid; i < 9 * 256; i += 512) { const int cid = i >> 8, k = kq * 256 + (i & 255); const float cvv = cid == 0 ? A->c_ctx[k] : A->c[(cid - 1) * DM + k]; SC[i] = silu_f(cvv); }
            __syncthreads();
            f32x4 ac[9];
#pragma unroll
            for (int q = 0; q < 9; ++q) ac[q] = (f32x4){0.f, 0.f, 0.f, 0.f};
            const float* wp = A->ada_w + ((size_t)l * DM + kq * 256 + wave * 32) * NMOD + jb * 256 + 4 * lane;
#pragma unroll 1
            for (int kb = 0; kb < 32; kb += 16) { f32x4 wv[16];
#pragma unroll
                for (int kk = 0; kk < 16; ++kk) wv[kk] = *(const f32x4*)(wp + (size_t)(kb + kk) * NMOD);
#pragma unroll
                for (int kk = 0; kk < 16; ++kk)
#pragma unroll
                    for (int q = 0; q < 9; ++q) ac[q] += SC[q * 256 + wave * 32 + kb + kk] * wv[kk]; }
#pragma unroll
            for (int q = 0; q < 9; ++q) *(LAS f32x4*)(PA + (wave * 9 + q) * 256 + 4 * lane) = ac[q];
            __syncthreads();
            for (int i = tid; i < 9 * 256; i += 512) { float s = 0.f;
#pragma unroll
                for (int w = 0; w < 8; ++w) s += PA[w * 9 * 256 + i];
                const int cid = i >> 8, j = jb * 256 + (i & 255);
                if (kq == 0) s += A->ada_b[l * NMOD + j];
                atomicAdd(&MOD[(l * 9 + cid) * NMOD + j], s); }
            __syncthreads();
        }
    }
    tr_run(A, bx * 8 + wave, TR_FIRST, G * 8, (LAS float*)(lds + wave * 16384), lane);
}

DI void bias_tables(KArgs A, lds_t* lds, int seg_lo, int seg_hi) {
    const int tid = ltid(), lane = tid & 63, wave = __builtin_amdgcn_readfirstlane(tid >> 6), gw = blockIdx.x * 8 + wave, NGW = gridDim.x * 8;
    const float* MOD = (const float*)(A->ws + WS_CTL) + CW_MOD;
    constexpr int SHS = 2064, SHI = 16 * SHS;
    __syncthreads();
    for (int seg = seg_lo; seg < seg_hi; ++seg) {
        const int sl = seg - seg_lo; const float* shp = MOD + (size_t)(seg >> 1) * 9 * NMOD + ((seg & 1) ? 3072 : 0) + 2 * tid;
        f32x2_t sv[9];
#pragma unroll
        for (int rw = 0; rw < 9; ++rw) sv[rw] = *(const f32x2_t*)(shp + rw * NMOD);
#pragma unroll
        for (int rw = 0; rw < 16; ++rw) *(LAS unsigned*)(lds + sl * SHI + rw * SHS + 4 * tid) = rw < 9 ? pkbf(sv[rw < 9 ? rw : 0].x, sv[rw < 9 ? rw : 0].y) : 0u;
    }
    __syncthreads();
    const int i16 = lane & 15, q4 = lane >> 4;
    constexpr int G_IN = NIN / 16, G_UP = NUP / 16;
    int gbase = 0;
    for (int seg = seg_lo; seg < seg_hi; ++seg) {
        const int l = seg >> 1, which = seg & 1, nrows = which ? NUP : NIN, ng = which ? G_UP : G_IN, sl = seg - seg_lo;
        const bf16_t* W = which ? (const bf16_t*)(A->ws + WS_WUP) + (size_t)l * NUP * DM : (const bf16_t*)(A->ws + WS_WIN) + (size_t)l * NIN * DM;
        float* bo = (float*)(A->ws + WS_BIAS + (which ? BIAS2_OFF : 0)) + (size_t)l * 9 * nrows;
        for (int g = (gw + NGW - (gbase % NGW)) % NGW; g < ng; g += NGW) {
            const bf16_t* wrow = W + (size_t)(16 * g + i16) * DM + 8 * q4;
            f32x4 ac = (f32x4){0.f, 0.f, 0.f, 0.f};
#pragma unroll
            for (int kh = 0; kh < 2; ++kh) {
                bf16x8 fb[16];
#pragma unroll
                for (int ks = 0; ks < 16; ++ks) fb[ks] = *(const bf16x8*)(wrow + 32 * (16 * kh + ks));
#pragma unroll
                for (int ks = 0; ks < 16; ++ks) { const bf16x8 fa = *(const LAS bf16x8*)(lds + sl * SHI + i16 * SHS + 2 * (32 * (16 * kh + ks) + 8 * q4)); ac = __builtin_amdgcn_mfma_f32_16x16x32_bf16(fa, fb[ks], ac, 0, 0, 0); }
            }
#pragma unroll
            for (int rg = 0; rg < 4; ++rg) { const int cidx = 4 * q4 + rg; if (cidx < 9) bo[(size_t)cidx * nrows + 16 * g + i16] = ac[rg]; }
        }
        gbase += ng;
    }
    __syncthreads();
}

DI void phase_p0b(KArgs A, lds_t* lds) {
    const int tid = ltid(), lane = tid & 63, wave = __builtin_amdgcn_readfirstlane(tid >> 6), gw = blockIdx.x * 8 + wave, NGW = gridDim.x * 8;
    const float* MOD = (const float*)(A->ws + WS_CTL) + CW_MOD;
    bf16_t* H = (bf16_t*)(A->ws + WS_H); float* RSP = (float*)(A->ws + WS_RSP);
    for (int mb = gw; mb < TT; mb += 3 * NGW) {
        f32x4 v[3][4];
#pragma unroll
        for (int rI = 0; rI < 3; ++rI) { const int m = mb + rI * NGW;
            if (m < TT) { const float* xr = (m < TP) ? A->x_prompt + (size_t)m * DM : A->x_sample + (size_t)(m - TP) * DM;
#pragma unroll
                for (int j = 0; j < 4; ++j) v[rI][j] = *(const f32x4*)(xr + 4 * lane + 256 * j); } }
#pragma unroll
        for (int rI = 0; rI < 3; ++rI) { const int m = mb + rI * NGW;
            if (m < TT) { const float* md = MOD + cid_of_row(m) * NMOD; float sm = 0.f;
#pragma unroll
                for (int j = 0; j < 4; ++j) sm += (v[rI][j].x * v[rI][j].x + v[rI][j].y * v[rI][j].y) + (v[rI][j].z * v[rI][j].z + v[rI][j].w * v[rI][j].w);
                sm = wave_sum(sm);
                if (lane < 4) RSP[(size_t)m * 4 + lane] = lane == 0 ? sm : 0.f;
#pragma unroll
                for (int j = 0; j < 4; ++j) { const int c = 4 * lane + 256 * j; const f32x4 w = *(const f32x4*)(A->norm1_w + c), sc = *(const f32x4*)(md + 1024 + c);
                    const f32x4 o = v[rI][j] * w * (1.0f + sc);
                    u32x2 pk; pk.x = pkbf(o.x, o.y); pk.y = pkbf(o.z, o.w); *(u32x2*)(H + (size_t)m * DM + c) = pk; } } }
    }
    bias_tables(A, lds, 0, 1);
}
DI void phase_final_norm(KArgs A) {
    const int tid = ltid(), lane = tid & 63, wave = __builtin_amdgcn_readfirstlane(tid >> 6), gw = blockIdx.x * 8 + wave, NGW = gridDim.x * 8;
    for (int m = gw; m < TT; m += NGW) {
        float* xr = A->out + (size_t)m * DM;
        f32x4 v[4]; float s = 0.f;
#pragma unroll
        for (int j = 0; j < 4; ++j) { v[j] = *(const f32x4*)(xr + 4 * lane + 256 * j); s += (v[j].x * v[j].x + v[j].y * v[j].y) + (v[j].z * v[j].z + v[j].w * v[j].w); }
        const float r = 1.0f / sqrtf(wave_sum(s) * (1.0f / DM) + EPS);
#pragma unroll
        for (int j = 0; j < 4; ++j) { const int c = 4 * lane + 256 * j; const f32x4 w = *(const f32x4*)(A->final_norm_w + c); *(f32x4*)(xr + c) = v[j] * r * w; }
    }
}

struct HyRaw { u32x4 v[3]; u32x4 h; };
DI void hyprep_load(const bf16_t* P, int un, int tid, HyRaw& q) {
    const int tb = un >> 3, cb = un & 7, m0 = 64 * tb, row = tid >> 3, ch = tid & 7;
    const bool pr = m0 < TP, has_prev = pr && ((m0 & 255) != 0), has_next = pr && (((m0 + 64) & 255) != 0);
#pragma unroll
    for (int a = 0; a < 3; ++a) q.v[a] = *(const u32x4*)(P + (size_t)(m0 + row) * NIN + 2560 + a * 512 + cb * 64 + ch * 8);
    q.h = (u32x4){0u, 0u, 0u, 0u};
    if (tid < 48) { const int a = tid >> 4, which = (tid >> 3) & 1, chh = tid & 7; const bool valid = which ? has_next : has_prev; const int mrow = which ? m0 + 64 : m0 - 1;
        if (valid) q.h = *(const u32x4*)(P + (size_t)mrow * NIN + 2560 + a * 512 + cb * 64 + chh * 8); }
}
DI void phase_hyprep(KArgs A, int l, lds_t* lds) {
    const int tid = ltid();
    const bf16_t* P = (const bf16_t*)(A->ws + WS_P);
    bf16_t* UT = (bf16_t*)(A->ws + WS_UT); bf16_t* X2T = (bf16_t*)(A->ws + WS_X2T);
    constexpr int RS = 144;
    const int NU = 192 * 8, G = gridDim.x;
    HyRaw cur, nxt;
    if ((int)blockIdx.x < NU) hyprep_load(P, blockIdx.x, tid, cur);
    for (int un = blockIdx.x; un < NU; un += G) {
        const int tb = un >> 3, cb = un & 7, m0 = 64 * tb;
        {
            const int row = tid >> 3, ch = tid & 7;
#pragma unroll
            for (int a = 0; a < 3; ++a) *(LAS u32x4*)(lds + a * 66 * RS + (row + 1) * RS + ch * 16) = cur.v[a];
            if (tid < 48) { const int a = tid >> 4, which = (tid >> 3) & 1, chh = tid & 7; *(LAS u32x4*)(lds + a * 66 * RS + (which ? 65 : 0) * RS + chh * 16) = cur.h; }
        }
        if (un + G < NU) hyprep_load(P, un + G, tid, nxt);
        BAR_LDS();
        {
            const int ch = tid >> 3, tq = tid & 7, cg = cb * 64 + ch;
            float w[3][3];
#pragma unroll
            for (int a = 0; a < 3; ++a)
#pragma unroll
                for (int j = 0; j < 3; ++j) w[a][j] = A->hy_conv_w[(l * 3 + j) * 1536 + a * 512 + cg];
            float uu[8], xx[8];
#pragma unroll
            for (int i = 0; i < 8; ++i) { const int rr = 8 * tq + i + 1; float val[3];
#pragma unroll
                for (int a = 0; a < 3; ++a) { const lds_t* bp = lds + a * 66 * RS + 2 * ch;
                    const float xm = bf1(*(const LAS bf16_t*)(bp + (rr - 1) * RS)), x0 = bf1(*(const LAS bf16_t*)(bp + rr * RS)), xp = bf1(*(const LAS bf16_t*)(bp + (rr + 1) * RS));
                    val[a] = w[a][0] * xm + w[a][1] * x0 + w[a][2] * xp; }
                uu[i] = val[1] * val[0]; xx[i] = val[2]; }
            u32x4 o; o.x = pkbf(uu[0], uu[1]); o.y = pkbf(uu[2], uu[3]); o.z = pkbf(uu[4], uu[5]); o.w = pkbf(uu[6], uu[7]);
            *(u32x4*)(UT + (size_t)cg * TT + m0 + 8 * tq) = o;
            o.x = pkbf(xx[0], xx[1]); o.y = pkbf(xx[2], xx[3]); o.z = pkbf(xx[4], xx[5]); o.w = pkbf(xx[6], xx[7]);
            *(u32x4*)(X2T + (size_t)cg * TT + m0 + 8 * tq) = o;
        }
        BAR_LDS();
        cur = nxt;
    }
}

constexpr int S_QE = 0, S_QS = 17408, S_KS = 34816, S_QB = 52224, S_KB = 60928, S_KT = 69632, S_VT = 88064, S_PP = 106496, S_ST = 115712, S_GT = 150528, S_DEC = 154624;
static_assert(S_DEC + 512 <= MISC_OFF, "scan lds");
DI void scan_item(KArgs A, int l, int seq, int head, int dir, lds_t* lds, bool prb) {
    const int tid = ltid(), lane = tid & 63, w = __builtin_amdgcn_readfirstlane(tid >> 6);
    const bool samp = seq >= 16;
    const int L = samp ? 1024 : 256, mbase = samp ? TP + (seq - 16) * 1024 : seq * 256, nch = L >> 6;
    const bf16_t* P = (const bf16_t*)(A->ws + WS_P);
    const bf16_t* Pq = P + (size_t)mbase * NIN + head * 128;
    const bf16_t* Pf = Pq + 512 + dir * 512;
    const bf16_t* Pv = Pq + 1536;
    bf16_t* Oo = (bf16_t*)(A->ws + WS_H) + (size_t)dir * TT * 512 + (size_t)mbase * 512 + head * 128;
    const int a = w >> 2, jv = w & 3, r = lane & 31, hh = lane >> 5;
    f32x16 Sa[2];
    if (samp) {
        const float* st = A->state + ((((size_t)(seq - 16) * 2 + l) * 2 + dir) * 4 + head) * 16384;
#pragma unroll
        for (int ii = 0; ii < 2; ++ii)
#pragma unroll
            for (int rg = 0; rg < 16; ++rg) Sa[ii][rg] = st[(size_t)(32 * (2 * a + ii) + crow(rg, hh)) * 128 + 32 * jv + r];
    } else {
#pragma unroll
        for (int ii = 0; ii < 2; ++ii)
#pragma unroll
            for (int rg = 0; rg < 16; ++rg) Sa[ii][rg] = 0.f;
    }
#pragma unroll
    for (int ii = 0; ii < 2; ++ii)
#pragma unroll
        for (int q4 = 0; q4 < 4; ++q4) { u32x2 pk; pk.x = pkbf(Sa[ii][4 * q4], Sa[ii][4 * q4 + 1]); pk.y = pkbf(Sa[ii][4 * q4 + 2], Sa[ii][4 * q4 + 3]);
            *(LAS u32x2*)(lds + S_ST + (32 * jv + r) * 272 + 2 * (32 * (2 * a + ii) + 8 * q4 + 4 * hh)) = pk; }
    unsigned rq[8], rf[8], rv[8];
    const long tstep = dir ? -(long)NIN : (long)NIN;
    const size_t off0 = (size_t)(dir ? L - 1 - 8 * w : 8 * w) * NIN + 2 * lane;
#pragma unroll
    for (int i = 0; i < 8; ++i) { const long off = (long)off0 + i * tstep; rq[i] = *(const unsigned*)(Pq + off); rf[i] = *(const unsigned*)(Pf + off); rv[i] = *(const unsigned*)(Pv + off); }
#pragma unroll
    for (int i = 0; i < 8; ++i) asm volatile("" :: "v"(rq[i]), "v"(rf[i]), "v"(rv[i]));
    lds_t* OT = lds + S_QS + w * 2560;
#define STG(k) do { if (PROBE_PH == 110 + (k) && prb && tid == 0) { const unsigned long long t_ = __builtin_amdgcn_s_memrealtime(); volatile LAS unsigned long long* a_ = (volatile LAS unsigned long long*)(lds + MISC_OFF + 136); volatile LAS unsigned long long* l_ = (volatile LAS unsigned long long*)(lds + MISC_OFF + 144); *a_ = *a_ + (t_ - *l_); } \
        if (PROBE_PH >= 110 && PROBE_PH <= 113 && prb && tid == 0) *(volatile LAS unsigned long long*)(lds + MISC_OFF + 144) = __builtin_amdgcn_s_memrealtime(); } while (0)
    if (PROBE_PH >= 110 && PROBE_PH <= 113 && prb && tid == 0) { *(volatile LAS unsigned long long*)(lds + MISC_OFF + 128) = 0ull; *(volatile LAS unsigned long long*)(lds + MISC_OFF + 136) = 0ull; *(volatile LAS unsigned long long*)(lds + MISC_OFF + 144) = __builtin_amdgcn_s_memrealtime(); }
    if (PROBE_PH == 114 && prb && tid == 0) *(volatile LAS unsigned long long*)(lds + MISC_OFF + 128) = __builtin_amdgcn_s_memrealtime();
    for (int ch = 0; ch < nch; ++ch) {
        STG(3);
        unsigned nq[8], nf[8], nv[8];
        if (ch + 1 < nch) {
            const long offc = (long)off0 + (long)(64 * (ch + 1)) * tstep;
#pragma unroll
            for (int i = 0; i < 8; ++i) { const long off = offc + i * tstep; nq[i] = *(const unsigned*)(Pq + off); nf[i] = *(const unsigned*)(Pf + off); nv[i] = *(const unsigned*)(Pv + off); }
        } else {
#pragma unroll
            for (int i = 0; i < 8; ++i) { nq[i] = 0u; nf[i] = 0u; nv[i] = 0u; }
        }
        { float s0 = 0.f, s1 = 0.f;
#pragma unroll
          for (int i = 0; i < 8; ++i) { s0 += bflo(rf[i]); s1 += bfhi(rf[i]); }
          *(LAS f32x2_t*)(lds + S_GT + (w * 128 + 2 * lane) * 4) = (f32x2_t){s0, s1}; }
        BAR_LDS();
        STG(0);
        {
            float my0 = 0.f, my1 = 0.f, p2_0 = 0.f, p2_1 = 0.f, p4_0 = 0.f, p4_1 = 0.f, p6_0 = 0.f, p6_1 = 0.f, run0 = 0.f, run1 = 0.f;
#pragma unroll
            for (int g = 0; g < 8; ++g) {
                if (g == 2) { p2_0 = run0; p2_1 = run1; } if (g == 4) { p4_0 = run0; p4_1 = run1; } if (g == 6) { p6_0 = run0; p6_1 = run1; }
                if (g == w) { my0 = run0; my1 = run1; }
                const f32x2_t gt = *(const LAS f32x2_t*)(lds + S_GT + (g * 128 + 2 * lane) * 4); run0 += gt.x; run1 += gt.y; }
            const float p8_0 = run0, p8_1 = run1;
            const float rd0 = (w < 4) ? p2_0 : p6_0, rd1 = (w < 4) ? p2_1 : p6_1;
            if (w == 0) *(LAS f32x2_t*)(lds + S_DEC + 8 * lane) = (f32x2_t){__expf(p8_0), __expf(p8_1)};
            float G0 = __expf(fminf(my0 - rd0, 80.f)), G1 = __expf(fminf(my1 - rd1, 80.f));
            const float crd0 = __expf(rd0), crd1 = __expf(rd1), cend0 = __expf(fminf(p8_0 - rd0, 0.f)), cend1 = __expf(fminf(p8_1 - rd1, 0.f));
            const float c40 = __expf(fminf((w < 4) ? p4_0 - p2_0 : p6_0 - p4_0, 0.f)), c41 = __expf(fminf((w < 4) ? p4_1 - p2_1 : p6_1 - p4_1, 0.f));
            unsigned kt0[4], kt1[4], vt0[4], vt1[4];
            float kprev0 = 0.f, kprev1 = 0.f, vprev0 = 0.f, vprev1 = 0.f;
            lds_t* rowp = lds + (8 * w) * 272 + 4 * lane;
#pragma unroll
            for (int i = 0; i < 8; ++i) {
                const float q0 = bflo(rq[i]), q1 = bfhi(rq[i]), F0 = __expf(bflo(rf[i])), F1 = __expf(bfhi(rf[i])), v0 = bflo(rv[i]), v1 = bfhi(rv[i]);
                const float k0 = 1.0f - F0, k1 = 1.0f - F1;
                G0 *= F0; G1 *= F1;
                const float ig0 = __builtin_amdgcn_rcpf(fmaxf(G0, 1e-30f)), ig1 = __builtin_amdgcn_rcpf(fmaxf(G1, 1e-30f));
                const float qs0 = q0 * G0, qs1 = q1 * G1, ks0 = k0 * ig0, ks1 = k1 * ig1;
                *(LAS unsigned*)(rowp + S_QS + i * 272) = pkbf(qs0, qs1);
                *(LAS unsigned*)(rowp + S_KS + i * 272) = pkbf(ks0, ks1);
                *(LAS unsigned*)(rowp + S_QE + i * 272) = pkbf(qs0 * crd0, qs1 * crd1);
                if (w >= 4) *(LAS unsigned*)(rowp + S_QB - 32 * 272 + i * 272) = pkbf(qs0 * c40, qs1 * c41);
                else        *(LAS unsigned*)(rowp + S_KB + i * 272) = pkbf(ks0 * c40, ks1 * c41);
                const float kk0 = ks0 * cend0, kk1 = ks1 * cend1;
                if (i & 1) { kt0[i >> 1] = pkbf(kprev0, kk0); kt1[i >> 1] = pkbf(kprev1, kk1); vt0[i >> 1] = pkbf(vprev0, v0); vt1[i >> 1] = pkbf(vprev1, v1); }
                else { kprev0 = kk0; kprev1 = kk1; vprev0 = v0; vprev1 = v1; }
            }
            *(LAS u32x4*)(lds + S_KT + (2 * lane) * 144 + 16 * w) = (u32x4){kt0[0], kt0[1], kt0[2], kt0[3]};
            *(LAS u32x4*)(lds + S_KT + (2 * lane + 1) * 144 + 16 * w) = (u32x4){kt1[0], kt1[1], kt1[2], kt1[3]};
            *(LAS u32x4*)(lds + S_VT + (2 * lane) * 144 + 16 * w) = (u32x4){vt0[0], vt0[1], vt0[2], vt0[3]};
            *(LAS u32x4*)(lds + S_VT + (2 * lane + 1) * 144 + 16 * w) = (u32x4){vt1[0], vt1[1], vt1[2], vt1[3]};
        }
        BAR_LDS();
        STG(1);
        if (w < 3) {
            const lds_t* Ab = lds + (w == 2 ? S_QB : (w == 1 ? S_QS + 32 * 272 : S_QS));
            const lds_t* Bb = lds + (w == 2 ? S_KB : (w == 1 ? S_KS + 32 * 272 : S_KS));
            const int prow0 = w == 0 ? 0 : 32, pcol0 = w == 1 ? 32 : 0; const bool mask = w != 2;
            f32x16 sc;
#pragma unroll
            for (int rg = 0; rg < 16; ++rg) sc[rg] = 0.f;
            { bf16x8 fa[8], fb[8];
#pragma unroll
              for (int s = 0; s < 8; ++s) { fa[s] = *(const LAS bf16x8*)(Ab + r * 272 + 32 * s + 16 * hh); fb[s] = *(const LAS bf16x8*)(Bb + r * 272 + 32 * s + 16 * hh); }
              __builtin_amdgcn_sched_barrier(0);
#pragma unroll
              for (int s = 0; s < 8; ++s) sc = MFMA32(fa[s], fb[s], sc); }
#pragma unroll
            for (int rg = 0; rg < 16; ++rg) { const int jl = crow(rg, hh); const float val = (mask && r > jl) ? 0.f : sc[rg];
                *(LAS bf16_t*)(lds + S_PP + (prow0 + jl) * 144 + 2 * (pcol0 + r)) = (bf16_t)(pkbf(val, 0.f) & 0xffffu); }
        }
        f32x16 oacc;
#pragma unroll
        for (int rg = 0; rg < 16; ++rg) oacc[rg] = 0.f;
        { bf16x8 fa[8], fb[8];
#pragma unroll
          for (int s = 0; s < 8; ++s) { fa[s] = *(const LAS bf16x8*)(lds + S_QE + (32 * a + r) * 272 + 32 * s + 16 * hh); fb[s] = *(const LAS bf16x8*)(lds + S_ST + (32 * jv + r) * 272 + 32 * s + 16 * hh); }
          __builtin_amdgcn_sched_barrier(0);
#pragma unroll
          for (int s = 0; s < 8; ++s) oacc = MFMA32(fa[s], fb[s], oacc); }
        { bf16x8 fa[2][4], fb[4]; f32x4 dv[2][4];
#pragma unroll
          for (int s = 0; s < 4; ++s) fb[s] = *(const LAS bf16x8*)(lds + S_VT + (32 * jv + r) * 144 + 32 * s + 16 * hh);
#pragma unroll
          for (int ii = 0; ii < 2; ++ii) { const int dkb = 32 * (2 * a + ii);
#pragma unroll
              for (int q4 = 0; q4 < 4; ++q4) dv[ii][q4] = *(const LAS f32x4*)(lds + S_DEC + 4 * (dkb + 8 * q4 + 4 * hh));
#pragma unroll
              for (int s = 0; s < 4; ++s) fa[ii][s] = *(const LAS bf16x8*)(lds + S_KT + (dkb + r) * 144 + 32 * s + 16 * hh); }
          __builtin_amdgcn_sched_barrier(0);
#pragma unroll
          for (int ii = 0; ii < 2; ++ii)
#pragma unroll
              for (int q4 = 0; q4 < 4; ++q4) { Sa[ii][4 * q4] *= dv[ii][q4].x; Sa[ii][4 * q4 + 1] *= dv[ii][q4].y; Sa[ii][4 * q4 + 2] *= dv[ii][q4].z; Sa[ii][4 * q4 + 3] *= dv[ii][q4].w; }
#pragma unroll
          for (int s = 0; s < 4; ++s) { Sa[0] = MFMA32(fa[0][s], fb[s], Sa[0]); Sa[1] = MFMA32(fa[1][s], fb[s], Sa[1]); } }
        BAR_LDS();
        STG(2);
        { bf16x8 fa[4], fb[4];
#pragma unroll
          for (int s = 0; s < 4; ++s) { if (s < 2 || a == 1) { fa[s] = *(const LAS bf16x8*)(lds + S_PP + (32 * a + r) * 144 + 32 * s + 16 * hh); fb[s] = *(const LAS bf16x8*)(lds + S_VT + (32 * jv + r) * 144 + 32 * s + 16 * hh); } }
          __builtin_amdgcn_sched_barrier(0);
#pragma unroll
          for (int s = 0; s < 4; ++s) { if (s < 2 || a == 1) oacc = MFMA32(fa[s], fb[s], oacc); } }
#pragma unroll
        for (int rg = 0; rg < 16; ++rg) *(LAS bf16_t*)(OT + crow(rg, hh) * 80 + 2 * r) = (bf16_t)(pkbf(oacc[rg], 0.f) & 0xffffu);
#pragma unroll
        for (int ii = 0; ii < 2; ++ii)
#pragma unroll
            for (int q4 = 0; q4 < 4; ++q4) { u32x2 pk; pk.x = pkbf(Sa[ii][4 * q4], Sa[ii][4 * q4 + 1]); pk.y = pkbf(Sa[ii][4 * q4 + 2], Sa[ii][4 * q4 + 3]);
                *(LAS u32x2*)(lds + S_ST + (32 * jv + r) * 272 + 2 * (32 * (2 * a + ii) + 8 * q4 + 4 * hh)) = pk; }
        { const int tl = lane >> 1, hf = lane & 1, tau = 64 * ch + 32 * a + tl, t = dir ? L - 1 - tau : tau;
          const u32x4 o0 = *(const LAS u32x4*)(OT + tl * 80 + 32 * hf), o1 = *(const LAS u32x4*)(OT + tl * 80 + 32 * hf + 16);
          bf16_t* op = Oo + (size_t)t * 512 + 32 * jv + 16 * hf; *(u32x4*)op = o0; *(u32x4*)(op + 8) = o1; }
#pragma unroll
        for (int i = 0; i < 8; ++i) { rq[i] = nq[i]; rf[i] = nf[i]; rv[i] = nv[i]; }
    }
    if (PROBE_PH == 114 && prb && tid == 0) *(volatile LAS unsigned long long*)(lds + MISC_OFF + 136) = __builtin_amdgcn_s_memrealtime();
    if (!samp) {
        float* ns = A->out + (size_t)TT * DM + ((((size_t)seq * 2 + l) * 2 + dir) * 4 + head) * 16384;
#pragma unroll
        for (int ii = 0; ii < 2; ++ii)
#pragma unroll
            for (int rg = 0; rg < 16; ++rg) ns[(size_t)(32 * (2 * a + ii) + crow(rg, hh)) * 128 + 32 * jv + r] = Sa[ii][rg];
    }
    BAR_LDS();
}

constexpr int H_CST = 4112, H_CP = 0, H_UP = 33024, H_UPBYTES = 61440, H_GST = H_UP + H_UPBYTES;
DI void hyena_item(KArgs A, int l, int cs, int c, bool zero_pads, lds_t* lds) {
    const int tid = ltid(), lane = tid & 63, w = __builtin_amdgcn_readfirstlane(tid >> 6);
    const int L = cs ? 1024 : 256, NB = L >> 5, nseq = cs ? 8 : 16, m0 = cs ? TP : 0, SEQST = 3 * NB * 80;
    bf16_t* UT = (bf16_t*)(A->ws + WS_UT) + (size_t)c * TT + m0;
    const bf16_t* X2T = (const bf16_t*)(A->ws + WS_X2T) + (size_t)c * TT + m0;
    const bf16_t* GF = (const bf16_t*)(A->ws + WS_GF + (size_t)l * GF_LSTRIDE + (cs ? GF_SAMPLE_OFF : 0)) + (size_t)c * (2 * L);
    if (zero_pads) { for (int i = tid; i < H_UPBYTES / 16; i += 512) *(LAS u32x4*)(lds + H_UP + 16 * i) = (u32x4){0u, 0u, 0u, 0u}; BAR_LDS(); }
    { const int nchunk = nseq * L / 8, cps = L / 8;
      for (int q = tid; q < nchunk; q += 512) { const int sq = q / cps, s = 8 * (q % cps); const u32x4 v = *(const u32x4*)(UT + (size_t)sq * L + s);
          *(LAS u32x4*)(lds + H_UP + sq * SEQST + (NB + (s >> 5)) * 80 + 2 * (s & 31)) = v; }
      for (int q = tid; q < 2 * L / 8; q += 512) *(LAS u32x4*)(lds + H_GST + 16 * q) = *(const u32x4*)(GF + 8 * q); }
    BAR_LDS();
    for (int e = tid; e < 16 * L; e += 512) { const int m = e / (2 * L), p = e % (2 * L), idx = 2 * L + m - p;
        bf16_t v = 0; if (idx < 2 * L) v = *(const LAS bf16_t*)(lds + H_GST + 2 * idx);
        *(LAS bf16_t*)(lds + H_CP + m * H_CST + 2 * p) = v; }
    BAR_LDS();
    const int r = lane & 31, hh = lane >> 5;
    const bool active = cs ? true : (w < 4);
    if (active) {
        const int sq = cs ? w : 4 * w + (r >> 3), ab = cs ? r : (r & 7);
        const lds_t* ub = lds + H_UP + sq * SEQST + (NB + ab) * 80 + 16 * hh;
        const lds_t* cb = lds + H_CP + (r & 7) * H_CST + 2 * (L - 8 * (r >> 3) + 8 * hh);
        f32x16 z;
#pragma unroll
        for (int rg = 0; rg < 16; ++rg) z[rg] = 0.f;
        bf16x8 fa0, fa1, fb0, fb1, ga0, ga1, gb0, gb1;
        int d = -(NB - 1);
        fa0 = *(const LAS bf16x8*)(cb - 64 * d); fa1 = *(const LAS bf16x8*)(cb - 64 * d + 32); fb0 = *(const LAS bf16x8*)(ub - 80 * d); fb1 = *(const LAS bf16x8*)(ub - 80 * d + 32);
        for (; d + 1 <= NB - 1; d += 2) {
            ga0 = *(const LAS bf16x8*)(cb - 64 * (d + 1)); ga1 = *(const LAS bf16x8*)(cb - 64 * (d + 1) + 32); gb0 = *(const LAS bf16x8*)(ub - 80 * (d + 1)); gb1 = *(const LAS bf16x8*)(ub - 80 * (d + 1) + 32);
            __builtin_amdgcn_sched_barrier(0);
            z = MFMA32(fa0, fb0, z); z = MFMA32(fa1, fb1, z);
            __builtin_amdgcn_sched_barrier(0);
            fa0 = *(const LAS bf16x8*)(cb - 64 * (d + 2)); fa1 = *(const LAS bf16x8*)(cb - 64 * (d + 2) + 32); fb0 = *(const LAS bf16x8*)(ub - 80 * (d + 2)); fb1 = *(const LAS bf16x8*)(ub - 80 * (d + 2) + 32);
            __builtin_amdgcn_sched_barrier(0);
            z = MFMA32(ga0, gb0, z); z = MFMA32(ga1, gb1, z);
            __builtin_amdgcn_sched_barrier(0);
        }
        z = MFMA32(fa0, fb0, z); z = MFMA32(fa1, fb1, z);
        const float invn = 1.0f / (((const float*)(A->ws + WS_CTL))[CW_HYABS + (l * 2 + cs) * 512 + c] + EPS), dd = A->hy_d[l * 512 + c];
#pragma unroll
        for (int q4 = 0; q4 < 4; ++q4) { const int t0 = 32 * ab + 8 * q4 + 4 * hh;
            const u32x2 uu = *(const LAS u32x2*)(lds + H_UP + sq * SEQST + (NB + ab) * 80 + 2 * (8 * q4 + 4 * hh));
            const u32x2 x2 = *(const u32x2*)(X2T + (size_t)sq * L + t0);
            const float y0 = bflo(x2.x) * (invn * z[4 * q4 + 0] + dd * bflo(uu.x)), y1 = bfhi(x2.x) * (invn * z[4 * q4 + 1] + dd * bfhi(uu.x));
            const float y2 = bflo(x2.y) * (invn * z[4 * q4 + 2] + dd * bflo(uu.y)), y3 = bfhi(x2.y) * (invn * z[4 * q4 + 3] + dd * bfhi(uu.y));
            u32x2 o; o.x = pkbf(y0, y1); o.y = pkbf(y2, y3);
            *(u32x2*)(UT + (size_t)sq * L + t0) = o; }
    }
    BAR_LDS();
}

DI void phase_mixer(KArgs A, int l, lds_t* lds) {
    unsigned* qhead = (unsigned*)(A->ws + WS_CTL) + CW_QUEUE + 64 * l;
    volatile LAS unsigned* bc = (volatile LAS unsigned*)(lds + MISC_OFF) + 16;
    int last_kind = -1;
    int n_items = 0;
    if ((PROBE_PH == 100 || PROBE_PH == 101) && l == 1 && threadIdx.x == 0) *(volatile LAS unsigned long long*)(lds + MISC_OFF + 128) = __builtin_amdgcn_s_memrealtime();
    for (;;) {
        BAR_LDS();
        if (threadIdx.x == 0) *bc = __hip_atomic_fetch_add(qhead, 1u, __ATOMIC_RELAXED, __HIP_MEMORY_SCOPE_AGENT);
        BAR_LDS();
        const int it = (int)*bc;
        if (PROBE_PH == 100 && l == 1 && n_items == 1 && threadIdx.x == 0) *(volatile LAS unsigned long long*)(lds + MISC_OFF + 136) = __builtin_amdgcn_s_memrealtime();
        ++n_items;
        if (it >= 1216 + (l == 0 ? TR_QITEMS : 0)) break;
        if (it >= 1216) {
            const int w = __builtin_amdgcn_readfirstlane(threadIdx.x >> 6), base = TR_FIRST + (it - 1216) * TR_PER_BLOCK_ITEM;
            const int e = base + TR_PER_BLOCK_ITEM < TR_TOTAL ? base + TR_PER_BLOCK_ITEM : TR_TOTAL;
            tr_run(A, base + w, e, 8, (LAS float*)(lds + w * 16384), threadIdx.x & 63); last_kind = -1; continue; }
        const bool is_scan = it < 64 || (it >= 576 && it < 704);
        if (is_scan) { const int i2 = it < 64 ? it : it - 576, sq = (it < 64 ? 16 : 0) + (i2 >> 3); const bool prb_ = (l == 1 && it == 0); if (PROBE_PH >= 110 && prb_ && threadIdx.x == 0) *(volatile LAS unsigned*)(lds + MISC_OFF + 160) = 1u; scan_item(A, l, sq, (i2 >> 1) & 3, i2 & 1, lds, prb_); last_kind = -1; }
        else { const int cs = it < 576 ? 1 : 0, c = cs ? it - 64 : it - 704; hyena_item(A, l, cs, c, last_kind != cs, lds); last_kind = cs; }
    }
    if (PROBE_PH == 101 && l == 1 && threadIdx.x == 0) *(volatile LAS unsigned long long*)(lds + MISC_OFF + 136) = __builtin_amdgcn_s_memrealtime();
}

DI void phase_merge(KArgs A, int l, lds_t* lds) {
    const int tid = threadIdx.x;
    if (l == 0) bias_tables(A, lds, 1, 4);
    const bf16_t* P = (const bf16_t*)(A->ws + WS_P);
    const bf16_t* OF = (const bf16_t*)(A->ws + WS_H); const bf16_t* OB = OF + (size_t)TT * 512;
    const bf16_t* YT = (const bf16_t*)(A->ws + WS_UT);
    bf16_t* MG = (bf16_t*)(A->ws + WS_MERGED);
    constexpr int RS = 1040;
    for (int un = blockIdx.x; un < TT / 32; un += gridDim.x) {
        const int m0 = 32 * un;
        const int j = tid >> 4, sub = tid & 15, m = m0 + j, cbase = 32 * sub;
        u32x4 yv[4], fv[4], bv[4], gv[4];
        { const bf16_t* yp = YT + (size_t)tid * TT + m0;
#pragma unroll
          for (int q = 0; q < 4; ++q) { yv[q] = *(const u32x4*)(yp + 8 * q); fv[q] = *(const u32x4*)(OF + (size_t)m * 512 + cbase + 8 * q); bv[q] = *(const u32x4*)(OB + (size_t)m * 512 + cbase + 8 * q);
              gv[q] = *(const u32x4*)(P + (size_t)m * NIN + 2048 + cbase + 8 * q); } }
#pragma unroll
        for (int q = 0; q < 4; ++q) { const unsigned vv[4] = {yv[q].x, yv[q].y, yv[q].z, yv[q].w};
#pragma unroll
            for (int e = 0; e < 4; ++e) { *(LAS bf16_t*)(lds + (8 * q + 2 * e) * RS + 2 * tid) = (bf16_t)(vv[e] & 0xffffu); *(LAS bf16_t*)(lds + (8 * q + 2 * e + 1) * RS + 2 * tid) = (bf16_t)(vv[e] >> 16); } }
        {
            float o[32]; float ss = 0.f;
#pragma unroll
            for (int q = 0; q < 4; ++q) { const unsigned ff[4] = {fv[q].x, fv[q].y, fv[q].z, fv[q].w}, bb[4] = {bv[q].x, bv[q].y, bv[q].z, bv[q].w};
#pragma unroll
                for (int e = 0; e < 4; ++e) { const float a0 = bflo(ff[e]) + bflo(bb[e]), a1 = bfhi(ff[e]) + bfhi(bb[e]); o[8 * q + 2 * e] = a0; o[8 * q + 2 * e + 1] = a1; ss += a0 * a0 + a1 * a1; } }
            ss += __shfl_xor(ss, 1); ss += __shfl_xor(ss, 2);
            const float rr = 1.0f / sqrtf(ss * (1.0f / 128.0f) + EPS);
#pragma unroll
            for (int q = 0; q < 4; ++q) { const unsigned gg[4] = {gv[q].x, gv[q].y, gv[q].z, gv[q].w};
                const f32x4 w0 = *(const f32x4*)(A->hg_norm_w + l * 512 + cbase + 8 * q), w1 = *(const f32x4*)(A->hg_norm_w + l * 512 + cbase + 8 * q + 4);
                const float ww[8] = {w0.x, w0.y, w0.z, w0.w, w1.x, w1.y, w1.z, w1.w};
                unsigned pk[4];
#pragma unroll
                for (int e = 0; e < 4; ++e) pk[e] = pkbf(o[8 * q + 2 * e] * rr * ww[2 * e] * bflo(gg[e]), o[8 * q + 2 * e + 1] * rr * ww[2 * e + 1] * bfhi(gg[e]));
                *(u32x4*)(MG + (size_t)m * DM + cbase + 8 * q) = (u32x4){pk[0], pk[1], pk[2], pk[3]}; }
        }
        BAR_LDS();
        {
            float y[32]; float ss = 0.f;
#pragma unroll
            for (int q = 0; q < 4; ++q) { const u32x4 v = *(const LAS u32x4*)(lds + j * RS + 2 * (cbase + 8 * q)); const unsigned vv[4] = {v.x, v.y, v.z, v.w};
#pragma unroll
                for (int e = 0; e < 4; ++e) { const float a0 = bflo(vv[e]), a1 = bfhi(vv[e]); y[8 * q + 2 * e] = a0; y[8 * q + 2 * e + 1] = a1; ss += a0 * a0 + a1 * a1; } }
            ss += __shfl_xor(ss, 1); ss += __shfl_xor(ss, 2); ss += __shfl_xor(ss, 4); ss += __shfl_xor(ss, 8);
            const float rr = 1.0f / sqrtf(ss * (1.0f / 512.0f) + EPS);
#pragma unroll
            for (int q = 0; q < 4; ++q) { const f32x4 w0 = *(const f32x4*)(A->hy_norm_w + l * 512 + cbase + 8 * q), w1 = *(const f32x4*)(A->hy_norm_w + l * 512 + cbase + 8 * q + 4);
                const float ww[8] = {w0.x, w0.y, w0.z, w0.w, w1.x, w1.y, w1.z, w1.w};
                unsigned pk[4];
#pragma unroll
                for (int e = 0; e < 4; ++e) pk[e] = pkbf(y[8 * q + 2 * e] * rr * ww[2 * e], y[8 * q + 2 * e + 1] * rr * ww[2 * e + 1]);
                *(u32x4*)(MG + (size_t)m * DM + 512 + cbase + 8 * q) = (u32x4){pk[0], pk[1], pk[2], pk[3]}; }
        }
        BAR_LDS();
    }
}

__global__ void __launch_bounds__(512, 2) mk_fwd(Args KP) {
    extern __shared__ __attribute__((aligned(16))) unsigned char lds_raw[];
    lds_t* lds = (lds_t*)lds_raw;
    const int tid = threadIdx.x;
    volatile LAS unsigned* MISC = (volatile LAS unsigned*)(lds + MISC_OFF);
    if (tid < 64) MISC[tid] = 0u;
    __syncthreads();
    if (MK_N_LAUNCHES == 1) (void)xcd_barrier_post((unsigned*)(KP.ws + WS_CTL) + CW_BAR, MISC + 8);
    const int lo = KP.ph_lo, hi = KP.ph_hi;
    if (PROBE_PH == 0 && threadIdx.x == 0) *(volatile LAS unsigned long long*)(lds + MISC_OFF + 128) = __builtin_amdgcn_s_memrealtime();
#define IN(k) (lo <= (k) && (k) < hi)
#define SEAM(k) do { PSTAMP(k); } while (0)
#define SEAM_(k) do { if (IN(k) && IN((k) + 1)) { KArgs A_ = kargs(); XcdBarrier b_; b_.bar = (unsigned*)(A_->ws + WS_CTL) + CW_BAR; b_.x = xb_xcc_id(); b_.st = (volatile LAS unsigned*)(lds + MISC_OFF) + 8; xcd_barrier(b_); } } while (0)
#define PSTAMP(k) do { SEAM_(k); if (PROBE_PH == (k) + 1 && threadIdx.x == 0) *(volatile LAS unsigned long long*)(lds + MISC_OFF + 128) = __builtin_amdgcn_s_memrealtime(); if (PROBE_PH == (k) && threadIdx.x == 0) *(volatile LAS unsigned long long*)(lds + MISC_OFF + 136) = __builtin_amdgcn_s_memrealtime(); } while (0)
#define MODP(A) ((const float*)((A)->ws + WS_CTL) + CW_MOD)
#define HP(A) ((bf16_t*)((A)->ws + WS_H))

    if (IN(0)) { KArgs A = kargs(); phase_p0a(A, lds); } SEAM(0);
    if (IN(1)) { KArgs A = kargs(); phase_p0b(A, lds); } SEAM(1);
#define LAYER_BODY(l) do { \
        const int pb = 2 + 7 * l; \
        if (IN(pb + 0)) { \
            KArgs A = kargs(); \
            pg8::Gemm g{HP(A), (const bf16_t*)(A->ws + WS_WIN) + (size_t)l * NIN * DM, TT, NIN, DM}; pg8::StaticOrder S; S.init(TT, NIN, gridDim.x, blockIdx.x); \
            pg8::EpiProj E{(bf16_t*)(A->ws + WS_P), (const float*)(A->ws + WS_LBT) + l * 1024, (const float*)(A->ws + WS_RSP), (const float*)(A->ws + WS_BIAS) + (size_t)l * 9 * NIN, (LAS float*)(lds + XCH_OFF + 8192)}; \
            pg8::gemm_phase<pg8::EpiProj, pg8::StaticOrder, true, true>(lds, g, S, E); \
        } SEAM(pb + 0); \
        if (IN(pb + 1)) { KArgs A = kargs(); phase_hyprep(A, l, lds); } SEAM(pb + 1); \
        if (IN(pb + 2)) { KArgs A = kargs(); phase_mixer(A, l, lds); } SEAM(pb + 2); \
        if (IN(pb + 3)) { KArgs A = kargs(); phase_merge(A, l, lds); } SEAM(pb + 3); \
        if (IN(pb + 4)) { \
            KArgs A = kargs(); bf16_t* XB = (bf16_t*)(A->ws + WS_XB); \
            pg8::Gemm g{(const bf16_t*)(A->ws + WS_MERGED), (const bf16_t*)(A->ws + WS_WOUT) + (size_t)l * DM * DM, TT, DM, DM}; pg8::StaticOrder S; S.init(TT, DM, gridDim.x, blockIdx.x, 192); \
            if (l == 0) { pg8::EpiResid<false, true, 3> E{A->x_prompt, A->x_sample, nullptr, nullptr, XB, MODP(A) + 2048, \
                            HP(A), A->norm2_w, MODP(A) + 4096, (float*)(A->ws + WS_RSP), (LAS float*)(lds + XCH_OFF)}; \
                pg8::gemm_phase<pg8::EpiResid<false, true, 3>, pg8::StaticOrder, true, true, 3>(lds, g, S, E); } \
            else { pg8::EpiResid<true, true, 3> E{nullptr, nullptr, XB, nullptr, XB, MODP(A) + (size_t)9 * NMOD + 2048, \
                            HP(A), A->norm2_w + DM, MODP(A) + (size_t)9 * NMOD + 4096, (float*)(A->ws + WS_RSP), (LAS float*)(lds + XCH_OFF)}; \
                pg8::gemm_phase<pg8::EpiResid<true, true, 3>, pg8::StaticOrder, true, true, 3>(lds, g, S, E); } \
        } SEAM(pb + 4); \
        if (IN(pb + 5)) { \
            KArgs A = kargs(); \
            pg8::Gemm g{HP(A), (const bf16_t*)(A->ws + WS_WUP) + (size_t)l * NUP * DM, TT, NUP, DM}; pg8::StaticOrder S; S.init(TT, NUP, gridDim.x, blockIdx.x); \
            pg8::EpiFfn E{(bf16_t*)(A->ws + WS_P), A->ffn_conv_w + (size_t)l * 3 * NUP, (LAS float*)(lds + XCH_OFF), (const float*)(A->ws + WS_RSP), (const float*)(A->ws + WS_BIAS + BIAS2_OFF) + (size_t)l * 9 * NUP, (LAS float*)(lds + XCH_OFF + 8192)}; \
            pg8::gemm_phase<pg8::EpiFfn, pg8::StaticOrder, true, true>(lds, g, S, E); \
        } SEAM(pb + 5); \
        if (IN(pb + 6)) { \
            KArgs A = kargs(); bf16_t* XB = (bf16_t*)(A->ws + WS_XB); \
            pg8::Gemm g{(const bf16_t*)(A->ws + WS_P), (const bf16_t*)(A->ws + WS_WDN) + (size_t)l * DM * DFF, TT, DM, DFF}; pg8::StaticOrder S; S.init(TT, DM, gridDim.x, blockIdx.x, 192); \
            if (l == 0) { pg8::EpiResid<true, true, 3> E{nullptr, nullptr, XB, nullptr, XB, MODP(A) + 5120, \
                            HP(A), A->norm1_w + DM, MODP(A) + (size_t)9 * NMOD + 1024, (float*)(A->ws + WS_RSP), (LAS float*)(lds + XCH_OFF)}; \
                pg8::gemm_phase<pg8::EpiResid<true, true, 3>, pg8::StaticOrder, true, true, 3>(lds, g, S, E); } \
            else { pg8::EpiResid<true, false, 3> E{nullptr, nullptr, XB, A->out, nullptr, MODP(A) + (size_t)9 * NMOD + 5120, \
                            nullptr, nullptr, nullptr, nullptr, (LAS float*)(lds + XCH_OFF)}; \
                pg8::gemm_phase<pg8::EpiResid<true, false, 3>, pg8::StaticOrder, true, true, 3>(lds, g, S, E); } \
        } SEAM(pb + 6); \
    } while (0)
    LAYER_BODY(0);
    LAYER_BODY(1);
#undef LAYER_BODY
    if (IN(16)) { KArgs A = kargs(); phase_final_norm(A); }
    if (PROBE_PH >= 0) { if (PROBE_PH == NPH - 1 && threadIdx.x == 0) *(volatile LAS unsigned long long*)(lds + MISC_OFF + 136) = __builtin_amdgcn_s_memrealtime();
        if ((PROBE_PH >= 110 ? *(volatile LAS unsigned*)(lds + MISC_OFF + 160) != 0u : blockIdx.x == 0) && threadIdx.x == 0) { const unsigned long long pt0 = *(volatile LAS unsigned long long*)(lds + MISC_OFF + 128), pt1 = *(volatile LAS unsigned long long*)(lds + MISC_OFF + 136); const unsigned long long t_end = __builtin_amdgcn_s_memrealtime(), w = 8ull * (pt1 - pt0); while (__builtin_amdgcn_s_memrealtime() - t_end < w) __builtin_amdgcn_s_sleep(32); } }
#undef IN
#undef SEAM
}

extern "C" void kernel_launch(void* const* d_in, const int* in_sizes, int n_in, void* d_out, int out_size, void* d_ws, size_t ws_size, hipStream_t stream) {
    static int grid = 0;
    if (grid == 0) {
        if (n_in != 28 || ws_size < WS_END) { fprintf(stderr, "kernel_launch: unexpected inputs (n_in %d, ws %zu)\n", n_in, ws_size); grid = -1; return; }
        int dev = 0, cus = 0;
        if (hipGetDevice(&dev) != hipSuccess || hipDeviceGetAttribute(&cus, hipDeviceAttributeMultiprocessorCount, dev) != hipSuccess) { grid = -1; return; }
        if (hipFuncSetAttribute((const void*)mk_fwd, hipFuncAttributeMaxDynamicSharedMemorySize, LDS_BYTES) != hipSuccess) { fprintf(stderr, "kernel_launch: hipFuncSetAttribute failed\n"); grid = -1; return; }
        int per_cu = 0;
        if (hipOccupancyMaxActiveBlocksPerMultiprocessor(&per_cu, (const void*)mk_fwd, 512, LDS_BYTES) != hipSuccess || per_cu < 1) fprintf(stderr, "kernel_launch: occupancy query reports %d\n", per_cu);
        (void)hipGetLastError();
        grid = cus;
    }
    if (grid < 0) return;
    (void)hipMemsetAsync((char*)d_ws + WS_CTL, 0, CTL_BYTES, stream);
    Args a{};
    const float** ap = (const float**)&a;
    for (int i = 0; i < 28; ++i) ap[i] = (const float*)d_in[i];
    a.out = (float*)d_out; a.ws = (unsigned char*)d_ws;
    if (MK_N_LAUNCHES == 1) { a.ph_lo = 0; a.ph_hi = NPH; hipLaunchKernelGGL(mk_fwd, dim3(grid), dim3(512), LDS_BYTES, stream, a); }
    else { for (int p = 0; p < NPH; ++p) { a.ph_lo = p; a.ph_hi = p + 1; hipLaunchKernelGGL(mk_fwd, dim3(grid), dim3(512), LDS_BYTES, stream, a); } }
}
```

```cpp
#include <hip/hip_runtime.h>
#include <cstdio>
#include <cstdint>

#define DI __device__ __forceinline__
#define LAS __attribute__((address_space(3)))
#define GAS __attribute__((address_space(1)))
typedef unsigned short bf16_t;
typedef short bf16x8 __attribute__((ext_vector_type(8)));
typedef float f32x4 __attribute__((ext_vector_type(4)));
typedef float f32x16 __attribute__((ext_vector_type(16)));
typedef unsigned u32x4 __attribute__((ext_vector_type(4)));
typedef unsigned u32x2 __attribute__((ext_vector_type(2)));
typedef float f32x2_t __attribute__((ext_vector_type(2)));
typedef __bf16 bf16x2_t __attribute__((ext_vector_type(2)));
typedef LAS unsigned char lds_t;

#ifndef PROBE_PH
#define PROBE_PH (-1)
#endif
#ifndef MK_N_LAUNCHES
#define MK_N_LAUNCHES 1
#endif

constexpr int DM = 1024, TP = 4096, TS = 8192, TT = 12288, NIN = 4096, DFF = 2816, NUP = 5632, NMOD = 6144;
constexpr int NPH = 15;
constexpr float EPS = 1e-6f;

constexpr size_t MiB = 1u << 20;
constexpr size_t WS_CTL = 0, CTL_BYTES = 1 * MiB;
constexpr size_t WS_LBT = 1 * MiB;
constexpr size_t WS_BIAS = 1 * MiB + 64 * 1024;
constexpr size_t BIAS2_OFF = 2 * 9 * 4096 * 4;
constexpr size_t WS_RSP = 2 * MiB;
constexpr size_t WS_GF = 3 * MiB;
constexpr size_t GF_LSTRIDE = 2560 * 1024, GF_SAMPLE_OFF = 512 * 1024;
constexpr size_t WS_WIN = 10 * MiB, WS_WOUT = 26 * MiB, WS_WUP = 30 * MiB, WS_WDN = 52 * MiB;
constexpr size_t WS_H = 64 * MiB;
constexpr size_t WS_MERGED = 88 * MiB;
constexpr size_t WS_P = 112 * MiB;
constexpr size_t WS_UT = 208 * MiB, WS_X2T = 220 * MiB;
constexpr size_t WS_XB = 232 * MiB;
constexpr size_t WS_END = 256 * MiB;
constexpr int CW_BAR = 4096;
constexpr int CW_QUEUE = 8192;
constexpr int CW_HYABS = 9216;
constexpr int CW_MOD = 16384;
static_assert((CW_MOD + 2 * 9 * NMOD) * 4 <= (int)CTL_BYTES, "ctl");

constexpr int LDS_BYTES = 163840;
constexpr int RING_BYTES = 131072;
constexpr int XCH_OFF = 131072;
constexpr int MISC_OFF = 163840 - 256;

DI unsigned pkbf(float lo, float hi) { f32x2_t v = {lo, hi}; bf16x2_t b = __builtin_convertvector(v, bf16x2_t); return __builtin_bit_cast(unsigned, b); }
DI float bflo(unsigned u) { return __uint_as_float(u << 16); }
DI float bfhi(unsigned u) { return __uint_as_float(u & 0xffff0000u); }
DI float bf1(bf16_t h) { return __uint_as_float(((unsigned)h) << 16); }
DI float silu_f(float x) { return x * __builtin_amdgcn_rcpf(1.0f + __expf(-x)); }
DI float wave_sum(float v) {
#pragma unroll
    for (int o = 1; o < 64; o <<= 1) v += __shfl_xor(v, o);
    return v;
}
DI int ltid() { int t = threadIdx.x; asm volatile("" : "+v"(t)); return t; }
DI int crow(int reg, int hh) { return (reg & 3) + 8 * (reg >> 2) + 4 * hh; }
DI int cid_of_tile(int pm) { return pm < 16 ? 0 : 1 + ((pm - 16) >> 2); }
DI int cid_of_row(int m) { return m < TP ? 0 : 1 + ((m - TP) >> 10); }
#define MFMA32(a, b, c) __builtin_amdgcn_mfma_f32_32x32x16_bf16((a), (b), (c), 0, 0, 0)
#define LDS_WAIT() asm volatile("s_waitcnt lgkmcnt(0)" ::: "memory")
#define VM_WAIT() asm volatile("s_waitcnt vmcnt(0)" ::: "memory")
#define BAR_LDS() do { asm volatile("s_waitcnt lgkmcnt(0)" ::: "memory"); __builtin_amdgcn_s_barrier(); asm volatile("" ::: "memory"); } while (0)

namespace pg8 {
#define PG8_LAS __attribute__((address_space(3)))
constexpr int BM = 256, BK = 64, HALF = 128, HTB = HALF * BK * 2, STAGE_BYTES = 8 * HTB, NXCD = 8, WGM = 8;
__host__ __device__ __forceinline__ int lds_byte(int r, int c) { const int st = (r >> 4) * 2 + (c >> 5), rr = r & 15, cc = c & 31, ob = rr * 64 + cc * 2; return st * 1024 + (ob ^ (((ob >> 9) & 1) << 5)); }
__host__ __device__ __forceinline__ void stage_rc(int b, int& R, int& C) { const int st = b / 1024, sb = b % 1024, swz = sb ^ (((sb >> 9) & 1) << 5); R = (st >> 1) * 16 + swz / 64; C = (st & 1) * 32 + (swz % 64) / 2; }
__host__ __device__ __forceinline__ int perm32(int rho) { const int n = rho >> 4, i = rho & 15; return 8 * (i >> 2) + 4 * n + (i & 3); }
struct Unit { int pm, pn; };
struct Gemm { const bf16_t* A; const bf16_t* Bt; int M, N, K; };
struct StaticOrder {
    int nM, nN, nwg, G, c;
    __host__ __device__ void init(int M, int N, int G_, int c_, int bm = BM) { nM = M / bm; nN = N / BM; nwg = nM * nN; G = G_; c = c_; }
    __host__ __device__ bool next(int i, Unit& u) const {
        const long L = (long)i * G + c; if (L >= nwg) return false;
        int wgid = (int)L; { const int q = nwg / NXCD, r = nwg % NXCD, xcd = wgid % NXCD, off = wgid / NXCD; wgid = (xcd < r ? xcd * (q + 1) : r * (q + 1) + (xcd - r) * q) + off; }
        const int nig = WGM * nN, gid = wgid / nig, fm = gid * WGM, gsz = (nM - fm) < WGM ? (nM - fm) : WGM;
        u.pm = fm + ((wgid % nig) % gsz); u.pn = (wgid % nig) / gsz; return true;
    }
    __device__ __forceinline__ void a_ready(const Unit&) const {}
    __device__ __forceinline__ void done(const Unit&) const {}
};


struct RNext { f32x4 a; };
__device__ __forceinline__ void rnext_load(RNext& q, const float* rsp, int pm, int tid, bool on) {
    q.a = (f32x4){0.f, 0.f, 0.f, 0.f};
    if (on) q.a = *(const f32x4*)(rsp + (size_t)(pm * BM + (tid & 255)) * 4);
}
__device__ __forceinline__ void rnext_store(const RNext& q, PG8_LAS float* R, int par, int tid, bool on) {
    if (on) { const float sm = (q.a.x + q.a.y) + (q.a.z + q.a.w); R[par * 256 + (tid & 255)] = 1.0f / sqrtf(sm * (1.0f / 1024.0f) + 1e-6f); }
}
struct EpiProj {
    static constexpr bool PERM = true, AFTER_DRAIN = false;
    bf16_t* P; const float* lbt; const float* rsp; const float* bias; PG8_LAS float* R;
    const float* hcw; bf16_t* UT; bf16_t* X2T; PG8_LAS float* X;
    __device__ __forceinline__ void first(const Unit& u) const { const int tid = threadIdx.x; RNext q; rnext_load(q, rsp, u.pm, tid, tid < 256); rnext_store(q, R, 0, tid, tid < 256); }
    __device__ __forceinline__ void operator()(f32x4 (&acc)[2][2][4][2], const Unit& u, int wr, int wc, int fr, int fq, const Unit& nx, bool has_next, int ui) const {
        const int tid = (wr * 4 + wc) * 64 + fq * 16 + fr; const bool pre = has_next && wr == 0;
        RNext rq; rnext_load(rq, rsp, nx.pm, tid, pre);
        PG8_LAS const float* Rc = R + (ui & 1) * 256;
        if (u.pn >= 10) {
            const bool prompt = u.pm < 16, pair = u.pn < 14;
            const int lane = fq * 16 + fr, cc0 = wc * 32 + 8 * fq;
            const int src_prev = (lane & 48) | ((fr + 15) & 15), src_next = (lane & 48) | ((fr + 1) & 15);
            { const float* bp = bias + cid_of_tile(u.pm) * NIN + u.pn * BM + cc0;
#pragma unroll
              for (int bj = 0; bj < 2; ++bj)
#pragma unroll
                  for (int n = 0; n < 2; ++n) { const f32x4 bv = *(const f32x4*)(bp + bj * HALF + 4 * n);
#pragma unroll
                      for (int ai = 0; ai < 2; ++ai)
#pragma unroll
                          for (int m = 0; m < 4; ++m) acc[ai][bj][m][n] = acc[ai][bj][m][n] * Rc[ai * HALF + wr * 64 + m * 16 + fr] + bv; } }
            if (prompt) {
#pragma unroll
                for (int ai = 0; ai < 2; ++ai) { const int slab = 2 * ai + wr;
#pragma unroll
                    for (int bj = 0; bj < 2; ++bj)
#pragma unroll
                        for (int n = 0; n < 2; ++n) {
                            if (fr == 0) *(PG8_LAS f32x4*)(X + (slab * 2 + 0) * 256 + bj * HALF + cc0 + 4 * n) = acc[ai][bj][0][n];
                            if (fr == 15) *(PG8_LAS f32x4*)(X + (slab * 2 + 1) * 256 + bj * HALF + cc0 + 4 * n) = acc[ai][bj][3][n];
                        } }
                asm volatile("s_waitcnt lgkmcnt(0)" ::: "memory"); __builtin_amdgcn_s_barrier(); asm volatile("" ::: "memory");
            }
#pragma unroll
            for (int n = 0; n < 2; ++n) {
                const int ch0 = pair ? 128 * (u.pn - 10) + cc0 + 4 * n : 256 * (u.pn - 14) + cc0 + 4 * n;
                const int ch1 = pair ? ch0 : ch0 + HALF;
                f32x4 w0[3], w1[3];
#pragma unroll
                for (int j = 0; j < 3; ++j) { w0[j] = *(const f32x4*)(hcw + j * 1536 + (pair ? 0 : 1024) + ch0); w1[j] = *(const f32x4*)(hcw + j * 1536 + (pair ? 512 : 1024) + ch1); }
#pragma unroll
                for (int ai = 0; ai < 2; ++ai) {
                    const int slab = 2 * ai + wr;
                    f32x4 hp[2], hn[2];
#pragma unroll
                    for (int bj = 0; bj < 2; ++bj) { hp[bj] = (f32x4){0.f, 0.f, 0.f, 0.f}; hn[bj] = (f32x4){0.f, 0.f, 0.f, 0.f}; }
                    if (prompt) {
#pragma unroll
                        for (int bj = 0; bj < 2; ++bj) {
                            if (fr == 0 && slab > 0) hp[bj] = *(PG8_LAS f32x4*)(X + ((slab - 1) * 2 + 1) * 256 + bj * HALF + cc0 + 4 * n);
                            if (fr == 15 && slab < 3) hn[bj] = *(PG8_LAS f32x4*)(X + ((slab + 1) * 2 + 0) * 256 + bj * HALF + cc0 + 4 * n);
                        }
                    }
#pragma unroll
                    for (int m = 0; m < 4; ++m) {
                        float cvl[2][4];
#pragma unroll
                        for (int bj = 0; bj < 2; ++bj)
#pragma unroll
                            for (int e = 0; e < 4; ++e) {
                                const float c = acc[ai][bj][m][n][e];
                                const float r1 = __shfl(c, src_prev), r15 = __shfl(c, src_next);
                                float pm1, pn1;
                                if (m > 0) pm1 = __shfl(acc[ai][bj][m > 0 ? m - 1 : 0][n][e], src_prev); else pm1 = hp[bj][e];
                                if (m < 3) pn1 = __shfl(acc[ai][bj][m < 3 ? m + 1 : 3][n][e], src_next); else pn1 = hn[bj][e];
                                const float p = (fr == 0) ? pm1 : r1, nx = (fr == 15) ? pn1 : r15;
                                const float wa = bj ? w1[0][e] : w0[0][e], wb = bj ? w1[1][e] : w0[1][e], wcc = bj ? w1[2][e] : w0[2][e];
                                cvl[bj][e] = wa * p + wb * c + wcc * nx;
                            }
                        const size_t row = (size_t)(u.pm * BM + ai * HALF + wr * 64 + m * 16 + fr);
                        if (pair) {
#pragma unroll
                            for (int e = 0; e < 4; ++e) UT[(size_t)(ch0 + e) * TT + row] = (bf16_t)(pkbf(cvl[1][e] * cvl[0][e], 0.f) & 0xffffu);
                        } else {
#pragma unroll
                            for (int e = 0; e < 4; ++e) { X2T[(size_t)(ch0 + e) * TT + row] = (bf16_t)(pkbf(cvl[0][e], 0.f) & 0xffffu); X2T[(size_t)(ch1 + e) * TT + row] = (bf16_t)(pkbf(cvl[1][e], 0.f) & 0xffffu); }
                        }
                    }
                }
            }
            rnext_store(rq, R, (ui + 1) & 1, tid, pre);
            return;
        }
        const int row0 = u.pm * BM + wr * 64 + fr, typ = u.pn >> 1, col0 = u.pn * BM + wc * 32 + 8 * fq;
        const float* bp = bias + cid_of_tile(u.pm) * NIN + col0;
        float rr[2][4];
#pragma unroll
        for (int ai = 0; ai < 2; ++ai)
#pragma unroll
            for (int m = 0; m < 4; ++m) rr[ai][m] = Rc[ai * HALF + wr * 64 + m * 16 + fr];
#pragma unroll
        for (int bj = 0; bj < 2; ++bj) {
            float lb[8], bs[8];
            { const f32x4 b0 = *(const f32x4*)(bp + bj * HALF), b1 = *(const f32x4*)(bp + bj * HALF + 4); bs[0] = b0.x; bs[1] = b0.y; bs[2] = b0.z; bs[3] = b0.w; bs[4] = b1.x; bs[5] = b1.y; bs[6] = b1.z; bs[7] = b1.w; }
#pragma unroll
            for (int i = 0; i < 8; ++i) lb[i] = 0.f;
            if (typ == 1 || typ == 2) {
                const float* lp = lbt + (typ - 1) * 512 + (col0 + bj * HALF - 512 * typ);
#pragma unroll
                for (int i = 0; i < 8; ++i) lb[i] = lp[i];
            }
#pragma unroll
            for (int ai = 0; ai < 2; ++ai)
#pragma unroll
                for (int m = 0; m < 4; ++m) {
                    float x[8];
#pragma unroll
                    for (int n = 0; n < 2; ++n)
#pragma unroll
                        for (int e = 0; e < 4; ++e) x[4 * n + e] = acc[ai][bj][m][n][e] * rr[ai][m] + bs[4 * n + e];
                    if (typ == 0) {
#pragma unroll
                        for (int i = 0; i < 8; ++i) x[i] = silu_f(x[i]) * 0.08838834764831845f;
                    } else if (typ == 1 || typ == 2) {
#pragma unroll
                        for (int i = 0; i < 8; ++i) { const float sg = __builtin_amdgcn_rcpf(1.0f + __expf(-x[i])); x[i] = __logf(lb[i] + (1.0f - lb[i]) * sg); }
                    } else if (typ == 4) {
#pragma unroll
                        for (int i = 0; i < 8; ++i) x[i] = silu_f(x[i]);
                    }
                    u32x4 w; w.x = pkbf(x[0], x[1]); w.y = pkbf(x[2], x[3]); w.z = pkbf(x[4], x[5]); w.w = pkbf(x[6], x[7]);
                    *(u32x4*)(P + (size_t)(row0 + ai * HALF + m * 16) * NIN + col0 + bj * HALF) = w;
                }
        }
        rnext_store(rq, R, (ui + 1) & 1, tid, pre);
    }
};

template <bool BASE_BF16, bool OUT_BF16, int MT> struct EpiResid {
    static constexpr bool PERM = false, AFTER_DRAIN = false;
    static constexpr int BMU = 64 * MT, RH = 32 * MT;
    const float* bp; const float* bs; const bf16_t* xb; float* outf; bf16_t* outb; const float* gate;
    bf16_t* Hn; const float* nw; const float* sc; float* rsp; PG8_LAS float* PS;
    __device__ __forceinline__ void first(const Unit&) const {}
    __device__ __forceinline__ void operator()(f32x4 (&acc)[2][2][MT][2], const Unit& u, int wr, int wc, int fr, int fq, const Unit&, bool, int) const {
        const int rowt = u.pm * BMU + wr * (16 * MT), col0 = u.pn * BM + wc * 32 + 4 * fq;
        f32x4 gv[2][2], cv[2][2]; int cur_cid = -1;
        constexpr int MB = (BASE_BF16 && MT == 4) ? 2 : 1;
#pragma unroll
        for (int ai = 0; ai < 2; ++ai)
#pragma unroll
        for (int mh = 0; mh < MT; mh += MB) {
            const int rowg = rowt + ai * RH + mh * 16, cid = cid_of_row(rowg);
            const float* base = (rowg < TP) ? bp : (bs - (size_t)TP * DM);
            if (cid != cur_cid) { cur_cid = cid;
#pragma unroll
                for (int bj = 0; bj < 2; ++bj)
#pragma unroll
                    for (int n = 0; n < 2; ++n) { gv[bj][n] = *(const f32x4*)(gate + cid * NMOD + col0 + bj * HALF + n * 16);
                        cv[bj][n] = (f32x4){0.f, 0.f, 0.f, 0.f};
                        if (Hn) cv[bj][n] = *(const f32x4*)(nw + col0 + bj * HALF + n * 16) * (1.0f + *(const f32x4*)(sc + cid * NMOD + col0 + bj * HALF + n * 16)); } }
            f32x4 bf[MB][2][2]; u32x2 bb[MB][2][2];
#pragma unroll
            for (int mi = 0; mi < MB; ++mi) { const size_t off = (size_t)(rowg + mi * 16 + fr) * DM + col0;
#pragma unroll
                for (int bj = 0; bj < 2; ++bj)
#pragma unroll
                    for (int n = 0; n < 2; ++n) { if constexpr (BASE_BF16) bb[mi][bj][n] = *(const u32x2*)(xb + off + bj * HALF + n * 16); else bf[mi][bj][n] = *(const f32x4*)(base + off + bj * HALF + n * 16); } }
#pragma unroll
            for (int mi = 0; mi < MB; ++mi) { const int m = mh + mi, row = rowg + mi * 16 + fr; const size_t off = (size_t)row * DM + col0; float ps = 0.f;
#pragma unroll
                for (int bj = 0; bj < 2; ++bj)
#pragma unroll
                    for (int n = 0; n < 2; ++n) {
                        f32x4 b;
                        if constexpr (BASE_BF16) { const u32x2 q = bb[mi][bj][n]; b = (f32x4){bflo(q.x), bfhi(q.x), bflo(q.y), bfhi(q.y)}; } else b = bf[mi][bj][n];
                        const f32x4 o = b + gv[bj][n] * acc[ai][bj][m][n];
                        if constexpr (OUT_BF16) { u32x2 pk; pk.x = pkbf(o.x, o.y); pk.y = pkbf(o.z, o.w); *(u32x2*)(outb + off + bj * HALF + n * 16) = pk; } else *(f32x4*)(outf + off + bj * HALF + n * 16) = o;
                        if (Hn) { ps += (o.x * o.x + o.y * o.y) + (o.z * o.z + o.w * o.w); const f32x4 a = o * cv[bj][n]; u32x2 pk; pk.x = pkbf(a.x, a.y); pk.y = pkbf(a.z, a.w); *(u32x2*)(Hn + off + bj * HALF + n * 16) = pk; } }
                if (Hn) { ps += __shfl_xor(ps, 16); ps += __shfl_xor(ps, 32); if (fq == 0) PS[wc * 256 + ai * RH + wr * (16 * MT) + m * 16 + fr] = ps; } }
        }
        if (Hn) {
            asm volatile("s_waitcnt lgkmcnt(0)" ::: "memory"); __builtin_amdgcn_s_barrier(); asm volatile("" ::: "memory");
            const int tid = (wr * 4 + wc) * 64 + fq * 16 + fr;
            if (tid < BMU) rsp[(size_t)(u.pm * BMU + tid) * 4 + u.pn] = (PS[tid] + PS[256 + tid]) + (PS[512 + tid] + PS[768 + tid]);
        }
    }
};

struct EpiFfn {
    static constexpr bool PERM = true, AFTER_DRAIN = false;
    bf16_t* ACT; const float* cw; PG8_LAS float* X; const float* rsp; const float* bias; PG8_LAS float* R;
    __device__ __forceinline__ void first(const Unit& u) const { const int tid = threadIdx.x; RNext q; rnext_load(q, rsp, u.pm, tid, tid < 256); rnext_store(q, R, 0, tid, tid < 256); }
    __device__ __forceinline__ void operator()(f32x4 (&acc)[2][2][4][2], const Unit& u, int wr, int wc, int fr, int fq, const Unit& nx, bool has_next, int ui) const {
        const bool prompt = u.pm < 16;
        const int lane = fq * 16 + fr;
        const int cc0 = wc * 32 + 8 * fq, fbase = u.pn * HALF + cc0;
        const int tid = (wr * 4 + wc) * 64 + lane; const bool pre = has_next && wr == 0;
        RNext rq; rnext_load(rq, rsp, nx.pm, tid, pre);
        PG8_LAS const float* Rc = R + (ui & 1) * 256;
        {
            const float* bp = bias + cid_of_tile(u.pm) * NUP + u.pn * BM + cc0;
#pragma unroll
            for (int bj = 0; bj < 2; ++bj)
#pragma unroll
                for (int n = 0; n < 2; ++n) { const f32x4 bv = *(const f32x4*)(bp + bj * HALF + 4 * n);
#pragma unroll
                    for (int ai = 0; ai < 2; ++ai)
#pragma unroll
                        for (int m = 0; m < 4; ++m) acc[ai][bj][m][n] = acc[ai][bj][m][n] * Rc[ai * HALF + wr * 64 + m * 16 + fr] + bv; }
        }
        const int src_prev = (lane & 48) | ((fr + 15) & 15), src_next = (lane & 48) | ((fr + 1) & 15);
        if (prompt) {
#pragma unroll
            for (int ai = 0; ai < 2; ++ai) { const int slab = 2 * ai + wr;
#pragma unroll
                for (int bj = 0; bj < 2; ++bj)
#pragma unroll
                    for (int n = 0; n < 2; ++n) {
                        if (fr == 0) *(PG8_LAS f32x4*)(X + (slab * 2 + 0) * 256 + bj * HALF + cc0 + 4 * n) = acc[ai][bj][0][n];
                        if (fr == 15) *(PG8_LAS f32x4*)(X + (slab * 2 + 1) * 256 + bj * HALF + cc0 + 4 * n) = acc[ai][bj][3][n];
                    } }
            asm volatile("s_waitcnt lgkmcnt(0)" ::: "memory"); __builtin_amdgcn_s_barrier(); asm volatile("" ::: "memory");
        }
#pragma unroll
        for (int n = 0; n < 2; ++n) {
            f32x4 wg[3], wv[3];
#pragma unroll
            for (int j = 0; j < 3; ++j) { wg[j] = *(const f32x4*)(cw + j * NUP + fbase + 4 * n); wv[j] = *(const f32x4*)(cw + j * NUP + DFF + fbase + 4 * n); }
#pragma unroll
            for (int ai = 0; ai < 2; ++ai) {
                const int slab = 2 * ai + wr;
                f32x4 hp[2], hn[2];
#pragma unroll
                for (int bj = 0; bj < 2; ++bj) { hp[bj] = (f32x4){0.f, 0.f, 0.f, 0.f}; hn[bj] = (f32x4){0.f, 0.f, 0.f, 0.f}; }
                if (prompt) {
#pragma unroll
                    for (int bj = 0; bj < 2; ++bj) {
                        if (fr == 0 && slab > 0) hp[bj] = *(PG8_LAS f32x4*)(X + ((slab - 1) * 2 + 1) * 256 + bj * HALF + cc0 + 4 * n);
                        if (fr == 15 && slab < 3) hn[bj] = *(PG8_LAS f32x4*)(X + ((slab + 1) * 2 + 0) * 256 + bj * HALF + cc0 + 4 * n);
                    }
                }
#pragma unroll
                for (int m = 0; m < 4; ++m) {
                    float cv[2][4];
#pragma unroll
                    for (int bj = 0; bj < 2; ++bj)
#pragma unroll
                        for (int e = 0; e < 4; ++e) {
                            const float c = acc[ai][bj][m][n][e];
                            const float r1 = __shfl(c, src_prev), r15 = __shfl(c, src_next);
                            float pm1, pn1;
                            if (m > 0) pm1 = __shfl(acc[ai][bj][m > 0 ? m - 1 : 0][n][e], src_prev); else pm1 = hp[bj][e];
                            if (m < 3) pn1 = __shfl(acc[ai][bj][m < 3 ? m + 1 : 3][n][e], src_next); else pn1 = hn[bj][e];
                            const float p = (fr == 0) ? pm1 : r1, nx = (fr == 15) ? pn1 : r15;
                            const float w0 = bj ? wv[0][e] : wg[0][e], w1 = bj ? wv[1][e] : wg[1][e], w2 = bj ? wv[2][e] : wg[2][e];
                            cv[bj][e] = w0 * p + w1 * c + w2 * nx;
                        }
                    u32x2 w; w.x = pkbf(silu_f(cv[0][0]) * cv[1][0], silu_f(cv[0][1]) * cv[1][1]); w.y = pkbf(silu_f(cv[0][2]) * cv[1][2], silu_f(cv[0][3]) * cv[1][3]);
                    *(u32x2*)(ACT + (size_t)(u.pm * BM + ai * HALF + wr * 64 + m * 16 + fr) * DFF + fbase + 4 * n) = w;
                }
            }
        }
        rnext_store(rq, R, (ui + 1) & 1, tid, pre);
    }
};

template <class Epi, class Sched, bool ALIGN_EPI = false, bool SP2 = false, int MT = 4>
__device__ __forceinline__ void gemm_phase(PG8_LAS unsigned char* lds, const Gemm g, const Sched& S, const Epi& E) {
    const int tid = ltid(), wid = __builtin_amdgcn_readfirstlane(tid >> 6), lane = tid & 63, wr = wid >> 2, wc = wid & 3, fr = lane & 15, fq = lane >> 4;
    const int K = g.K, nt = K / BK;
    unsigned voffA[2], voffB[2];
#pragma unroll
    for (int i = 0; i < 2; ++i) { int R, C; stage_rc(tid * 16 + i * 8192, R, C); const int Rb = Epi::PERM ? ((R & ~31) + perm32(R & 31)) : R;
        voffA[i] = (unsigned)(R * K + C) * 2u; voffB[i] = (unsigned)(Rb * K + C) * 2u; }
    const size_t kstep = (size_t)(BK * 2);
    const size_t hstep = (size_t)HALF * K * 2;
    const size_t tstep = 2 * hstep;
    const size_t hstepA = (size_t)(32 * MT) * K * 2;
    const size_t tstepA = 2 * hstepA;
    const unsigned ldsw = (unsigned)wid * 1024u;
    const int aoff = lds_byte(wr * (16 * MT) + fr, fq * 8), boff = lds_byte(wc * 32 + fr, fq * 8);
#define PG8_SA(b, h) (((b) * 2 + (h)) * HTB)
#define PG8_SB(b, h) ((4 + (b) * 2 + (h)) * HTB)
#define PG8_STAGE(bufoff, gbase, voff) do { _Pragma("unroll") for (int _i = 0; _i < 2; ++_i) \
        __builtin_amdgcn_global_load_lds((const unsigned*)((const char*)(gbase) + (voff)[_i]), (PG8_LAS unsigned*)(lds + (bufoff) + ldsw + _i * 8192), 16, 0, 0); } while (0)
#define PG8_LDA(dst, b, h) do { _Pragma("unroll") for (int m = 0; m < MT; ++m) _Pragma("unroll") for (int k = 0; k < 2; ++k) dst[m][k] = *(const PG8_LAS bf16x8*)(lds + PG8_SA(b, h) + aoff + m * 2048 + k * 1024); } while (0)
#define PG8_LDB(dst, b, h) do { _Pragma("unroll") for (int n = 0; n < 2; ++n) _Pragma("unroll") for (int k = 0; k < 2; ++k) dst[n][k] = *(const PG8_LAS bf16x8*)(lds + PG8_SB(b, h) + boff + n * 2048 + k * 1024); } while (0)
#define PG8_MMA(ai, bj, At, Bt) do { __builtin_amdgcn_s_setprio(1); _Pragma("unroll") for (int m = 0; m < MT; ++m) _Pragma("unroll") for (int n = 0; n < 2; ++n) _Pragma("unroll") for (int k = 0; k < 2; ++k) \
        acc[ai][bj][m][n] = __builtin_amdgcn_mfma_f32_16x16x32_bf16(Bt[n][k], At[m][k], acc[ai][bj][m][n], 0, 0, 0); __builtin_amdgcn_s_setprio(0); } while (0)
#define PG8_WAIT_V(n) asm volatile("s_waitcnt vmcnt(" #n ")" ::: "memory")
#define PG8_WAIT_L(n) asm volatile("s_waitcnt lgkmcnt(" #n ")" ::: "memory")
#define PG8_BAR __builtin_amdgcn_s_barrier()
#define PG8_SCHED __builtin_amdgcn_sched_barrier(0)
    Unit cur, nxt; int ui = 0;
    if (!S.next(0, cur)) return;
    f32x4 acc[2][2][MT][2];
#pragma unroll
    for (int a = 0; a < 2; ++a)
#pragma unroll
        for (int b = 0; b < 2; ++b)
#pragma unroll
            for (int m = 0; m < MT; ++m)
#pragma unroll
                for (int n = 0; n < 2; ++n) acc[a][b][m][n] = (f32x4){0.f, 0.f, 0.f, 0.f};
    bf16x8 At[MT][2], B0[2][2], B1[2][2];
    const char* cA = (const char*)g.A + (size_t)cur.pm * tstepA; const char* cB = (const char*)g.Bt + (size_t)cur.pn * tstep;
    S.a_ready(cur);
    E.first(cur);
    if constexpr (SP2) {
        PG8_STAGE(PG8_SB(0, 0), cB, voffB); PG8_STAGE(PG8_SB(0, 1), cB + hstep, voffB); PG8_STAGE(PG8_SA(0, 0), cA, voffA); PG8_STAGE(PG8_SA(0, 1), cA + hstepA, voffA);
        if (wr == 1) PG8_BAR;
        PG8_WAIT_V(2); PG8_BAR;
        PG8_STAGE(PG8_SB(1, 0), cB + kstep, voffB); PG8_STAGE(PG8_SA(1, 0), cA + kstep, voffA); PG8_STAGE(PG8_SB(1, 1), cB + hstep + kstep, voffB);
        PG8_WAIT_V(6); PG8_BAR;
    } else {
        PG8_STAGE(PG8_SB(0, 0), cB, voffB); PG8_STAGE(PG8_SA(0, 0), cA, voffA); PG8_STAGE(PG8_SB(0, 1), cB + hstep, voffB); PG8_STAGE(PG8_SA(0, 1), cA + hstepA, voffA);
        if (wr == 1) PG8_BAR;
        PG8_WAIT_V(4); PG8_BAR;
        PG8_STAGE(PG8_SB(1, 0), cB + kstep, voffB); PG8_STAGE(PG8_SA(1, 0), cA + kstep, voffA); PG8_STAGE(PG8_SB(1, 1), cB + hstep + kstep, voffB);
        PG8_WAIT_V(6); PG8_BAR;
    }
    for (;;) {
        const bool has_next = S.next(ui + 1, nxt);
        const char* nA = has_next ? (const char*)g.A + (size_t)nxt.pm * tstepA : cA; const char* nB = has_next ? (const char*)g.Bt + (size_t)nxt.pn * tstep : cB;
        for (int t = 0; t < nt; t += 2) {
            const bool last = (t == nt - 2);
            const char* a1 = cA + (size_t)(t + 1) * kstep;
            const char* a2 = last ? nA : cA + (size_t)(t + 2) * kstep; const char* b2 = last ? nB : cB + (size_t)(t + 2) * kstep;
            const char* a3 = a2 + kstep; const char* b3 = b2 + kstep;
            if (last && has_next) S.a_ready(nxt);
            if constexpr (SP2) {
            PG8_LDB(B0, 0, 0); PG8_LDB(B1, 0, 1); PG8_SCHED; PG8_LDA(At, 0, 0); PG8_STAGE(PG8_SA(1, 1), a1 + hstepA, voffA);
            PG8_WAIT_V(8); PG8_WAIT_L(0); PG8_BAR; PG8_MMA(0, 0, At, B0); PG8_MMA(0, 1, At, B1); PG8_BAR; PG8_SCHED;
            PG8_LDA(At, 0, 1); PG8_STAGE(PG8_SB(0, 0), b2, voffB); PG8_STAGE(PG8_SB(0, 1), b2 + hstep, voffB); PG8_STAGE(PG8_SA(0, 0), a2, voffA);
            PG8_WAIT_V(8); PG8_WAIT_L(0); PG8_BAR; PG8_MMA(1, 0, At, B0); PG8_MMA(1, 1, At, B1); PG8_BAR; PG8_SCHED;
            PG8_LDB(B0, 1, 0); PG8_LDB(B1, 1, 1); PG8_SCHED; PG8_LDA(At, 1, 0); PG8_STAGE(PG8_SA(0, 1), a2 + hstepA, voffA);
            PG8_WAIT_V(8); PG8_WAIT_L(0); PG8_BAR; PG8_MMA(0, 0, At, B0); PG8_MMA(0, 1, At, B1); PG8_BAR; PG8_SCHED;
            PG8_LDA(At, 1, 1); PG8_STAGE(PG8_SB(1, 0), b3, voffB); PG8_STAGE(PG8_SB(1, 1), b3 + hstep, voffB); PG8_STAGE(PG8_SA(1, 0), a3, voffA);
            PG8_WAIT_V(8); PG8_WAIT_L(0); PG8_BAR; PG8_MMA(1, 0, At, B0); PG8_MMA(1, 1, At, B1); PG8_BAR; PG8_SCHED;
            } else {
            PG8_LDB(B0, 0, 0); PG8_SCHED; PG8_LDA(At, 0, 0); PG8_STAGE(PG8_SA(1, 1), a1 + hstepA, voffA);
            PG8_WAIT_L(8); PG8_BAR; PG8_WAIT_L(0); PG8_MMA(0, 0, At, B0); PG8_BAR; PG8_SCHED;
            PG8_LDB(B1, 0, 1); PG8_STAGE(PG8_SB(0, 0), b2, voffB);
            PG8_BAR; PG8_WAIT_L(0); PG8_MMA(0, 1, At, B1); PG8_BAR;
            PG8_LDA(At, 0, 1); PG8_STAGE(PG8_SA(0, 0), a2, voffA);
            PG8_BAR; PG8_WAIT_L(0); PG8_MMA(1, 0, At, B0); PG8_BAR; PG8_SCHED;
            PG8_STAGE(PG8_SB(0, 1), b2 + hstep, voffB);
            PG8_WAIT_V(6); PG8_BAR; PG8_MMA(1, 1, At, B1); PG8_BAR;
            PG8_LDB(B0, 1, 0); PG8_SCHED; PG8_LDA(At, 1, 0); PG8_STAGE(PG8_SA(0, 1), a2 + hstepA, voffA);
            PG8_WAIT_L(8); PG8_BAR; PG8_WAIT_L(0); PG8_MMA(0, 0, At, B0); PG8_BAR; PG8_SCHED;
            PG8_LDB(B1, 1, 1); PG8_STAGE(PG8_SB(1, 0), b3, voffB);
            PG8_BAR; PG8_WAIT_L(0); PG8_MMA(0, 1, At, B1); PG8_BAR;
            PG8_LDA(At, 1, 1); PG8_STAGE(PG8_SA(1, 0), a3, voffA);
            PG8_BAR; PG8_WAIT_L(0); PG8_MMA(1, 0, At, B0); PG8_BAR; PG8_SCHED;
            PG8_STAGE(PG8_SB(1, 1), b3 + hstep, voffB);
            PG8_WAIT_V(6); PG8_BAR; PG8_MMA(1, 1, At, B1); PG8_BAR;
            }
        }
        if constexpr (ALIGN_EPI) { if (wr == 0) PG8_BAR; }
        if constexpr (!Epi::AFTER_DRAIN) { E(acc, cur, wr, wc, fr, fq, nxt, has_next, ui); S.done(cur); }
        if (!has_next) break;
#pragma unroll
        for (int a = 0; a < 2; ++a)
#pragma unroll
            for (int b = 0; b < 2; ++b)
#pragma unroll
                for (int m = 0; m < MT; ++m)
#pragma unroll
                    for (int n = 0; n < 2; ++n) acc[a][b][m][n] = (f32x4){0.f, 0.f, 0.f, 0.f};
        cur = nxt; cA = nA; cB = nB; ++ui;
        if constexpr (ALIGN_EPI) { if (wr == 1) PG8_BAR; }
    }
    PG8_WAIT_V(0);
    if constexpr (!ALIGN_EPI) { if (wr == 0) PG8_BAR; }
    PG8_BAR;
#undef PG8_SA
#undef PG8_SB
#undef PG8_STAGE
#undef PG8_LDA
#undef PG8_LDB
#undef PG8_MMA
#undef PG8_WAIT_V
#undef PG8_WAIT_L
#undef PG8_BAR
#undef PG8_SCHED
}
}

#define XB_TMO      128
#define XB_XCNT(j)  (256  + 64 * (j))
#define XB_XSUB(j)  (1280 + 64 * (j))
#define XB_XGEN(j)  (2304 + 64 * (j))
#define XB_TOP      3328
#define XB_TOPGEN   3392
#define XCD_BAR_WORDS 3456
#define XB_SPIN_CAP (1u << 18)
DI unsigned xb_ld(unsigned* p)              { return __hip_atomic_load(p, __ATOMIC_RELAXED, __HIP_MEMORY_SCOPE_AGENT); }
DI unsigned xb_add(unsigned* p, unsigned v) { return __hip_atomic_fetch_add(p, v, __ATOMIC_RELAXED, __HIP_MEMORY_SCOPE_AGENT); }
DI unsigned xb_xcc_id() { return (unsigned)__builtin_amdgcn_s_getreg((3 << 11) | 20) & 0xFu; }
#define XB_SPIN(cond, bar) do { unsigned _sp = 0; while (cond) { __builtin_amdgcn_s_sleep(1); \
    if ((++_sp & 255u) == 0u) { if (xb_ld(&(bar)[XB_TMO])) break; if (_sp > XB_SPIN_CAP) { atomicAdd(&(bar)[XB_TMO], 1u); break; } } } } while (0)
struct XcdBarrier { unsigned* bar; unsigned x; volatile LAS unsigned* st; };
DI XcdBarrier xcd_barrier_post(unsigned* bar, volatile LAS unsigned* st) {
    XcdBarrier b; b.bar = bar; b.x = xb_xcc_id(); b.st = st;
    if (threadIdx.x == 0) (void)xb_add(&bar[XB_XCNT(b.x)], 1u);
    return b;
}
DI void xcd_barrier_complete(unsigned* bar, unsigned x, unsigned& nloc, unsigned& nx) {
    const unsigned G = gridDim.x * gridDim.y * gridDim.z;
    unsigned sum, cnt, mine, sp = 0u;
    for (;;) {
        sum = 0u; cnt = 0u; mine = 0u;
#pragma unroll
        for (unsigned j = 0; j < 16; ++j) { const unsigned c = xb_ld(&bar[XB_XCNT(j)]); sum += c; cnt += (c > 0u) ? 1u : 0u; mine = (j == x) ? c : mine; }
        if (sum == G) break;
        __builtin_amdgcn_s_sleep(1);
        if ((++sp & 255u) == 0u) { if (xb_ld(&bar[XB_TMO])) break; if (sp > XB_SPIN_CAP) { atomicAdd(&bar[XB_TMO], 1u); break; } }
    }
    nloc = mine > 0u ? mine : 1u; nx = cnt > 0u ? cnt : 1u;
}
DI void xcd_barrier(const XcdBarrier& b) {
    asm volatile("s_waitcnt vmcnt(0)" ::: "memory");
    __syncthreads();
    if (threadIdx.x == 0) {
        unsigned* bar = b.bar;
        __builtin_amdgcn_s_waitcnt(0);
        unsigned nloc = b.st[0], nx = b.st[1];
        if (nloc == 0u) { xcd_barrier_complete(bar, b.x, nloc, nx); b.st[0] = nloc; b.st[1] = nx; }
        const unsigned old = xb_add(&bar[XB_XSUB(b.x)], 1u);
        const unsigned gen = old / nloc;
        if (old + 1u == (gen + 1u) * nloc) {
            __builtin_amdgcn_fence(__ATOMIC_RELEASE, "agent");
            asm volatile("s_waitcnt vmcnt(0)" ::: "memory");
            const unsigned og = xb_add(&bar[XB_TOP], 1u);
            const unsigned tg = og / nx;
            if (og + 1u == (tg + 1u) * nx) xb_add(&bar[XB_TOPGEN], 1u);
            else XB_SPIN(xb_ld(&bar[XB_TOPGEN]) == tg, bar);
            __builtin_amdgcn_fence(__ATOMIC_ACQUIRE, "agent");
            xb_add(&bar[XB_XGEN(b.x)], 1u);
            asm volatile("s_waitcnt vmcnt(0)" ::: "memory");
        } else {
            XB_SPIN(xb_ld(&bar[XB_XGEN(b.x)]) == gen, bar);
            __builtin_amdgcn_fence(__ATOMIC_ACQUIRE, "agent");
            asm volatile("s_waitcnt vmcnt(0)" ::: "memory");
        }
    }
    __syncthreads();
}

struct Args {
    const float* x_prompt; const float* x_sample; const float* state; const float* c; const float* c_ctx;
    const float* w_in; const float* w_out; const float* ada_w; const float* ada_b; const float* norm1_w; const float* norm2_w;
    const float* hg_lb_fwd; const float* hg_lb_bwd; const float* hg_norm_w; const float* hy_conv_w;
    const float* hy_w1; const float* hy_b1; const float* hy_f1; const float* hy_w2; const float* hy_b2; const float* hy_f2; const float* hy_w3; const float* hy_d; const float* hy_norm_w;
    const float* ffn_up; const float* ffn_conv_w; const float* ffn_down; const float* final_norm_w;
    float* out; unsigned char* ws; int ph_lo, ph_hi;
};

typedef const __attribute__((address_space(4))) Args* KArgs;
DI KArgs kargs() { unsigned long long p = (unsigned long long)__builtin_amdgcn_kernarg_segment_ptr(); asm volatile("" : "+s"(p)); return (KArgs)p; }

struct TrItem { const float* W; bf16_t* WT; int K, N, k0, n0, ns0; };
DI TrItem tr_decode(KArgs A, int it) {
    constexpr int I_IN = 16 * 128, I_OUT = 16 * 32, I_UP = 16 * 176, I_DN = 44 * 32, I_L = I_IN + I_OUT + I_UP + I_DN;
    const int l = it / I_L; int r = it % I_L; TrItem t; unsigned char* ws = A->ws;
    if (r < I_IN) { const int kb = r / 128, nb = r % 128, n0 = 32 * nb; t.W = A->w_in + (size_t)l * DM * NIN; t.WT = (bf16_t*)(ws + WS_WIN) + (size_t)l * NIN * DM; t.K = DM; t.N = NIN; t.k0 = 64 * kb; t.n0 = n0; t.ns0 = n0;
        if (n0 >= 2560 && n0 < 3584) { const int j = (n0 - 2560) >> 8, cc = (n0 - 2560) & 255; t.ns0 = cc < 128 ? 2560 + 128 * j + cc : 3072 + 128 * j + (cc - 128); }
        return t; } r -= I_IN;
    if (r < I_OUT) { const int kb = r / 32, nb = r % 32; t.W = A->w_out + (size_t)l * DM * DM; t.WT = (bf16_t*)(ws + WS_WOUT) + (size_t)l * DM * DM; t.K = DM; t.N = DM; t.k0 = 64 * kb; t.n0 = 32 * nb; t.ns0 = 32 * nb; return t; } r -= I_OUT;
    if (r < I_UP) { const int kb = r / 176, nb = r % 176, n0 = 32 * nb, tj = n0 >> 8, cc = n0 & 255; t.W = A->ffn_up + (size_t)l * DM * NUP; t.WT = (bf16_t*)(ws + WS_WUP) + (size_t)l * NUP * DM; t.K = DM; t.N = NUP; t.k0 = 64 * kb; t.n0 = n0;
        t.ns0 = cc < 128 ? 128 * tj + cc : DFF + 128 * tj + (cc - 128); return t; } r -= I_UP;
    { const int kb = r / 32, nb = r % 32; t.W = A->ffn_down + (size_t)l * DFF * DM; t.WT = (bf16_t*)(ws + WS_WDN) + (size_t)l * DM * DFF; t.K = DFF; t.N = DM; t.k0 = 64 * kb; t.n0 = 32 * nb; t.ns0 = 32 * nb; return t; }
}
DI void tr_load(const TrItem& t, int lane, f32x4 (&v)[8]) {
    const float* p = t.W + (size_t)(t.k0 + (lane >> 3)) * t.N + t.ns0 + 4 * (lane & 7);
#pragma unroll
    for (int i = 0; i < 8; ++i) v[i] = *(const f32x4*)(p + (size_t)(8 * i) * t.N);
}
DI void tr_store(const TrItem& t, int lane, const f32x4 (&v)[8], LAS float* scr) {
#pragma unroll
    for (int i = 0; i < 8; ++i) { LAS float* d = scr + (8 * i + (lane >> 3)) * 33 + 4 * (lane & 7); d[0] = v[i].x; d[1] = v[i].y; d[2] = v[i].z; d[3] = v[i].w; }
    LDS_WAIT(); asm volatile("" ::: "memory");
    const int c = lane & 7;
#pragma unroll
    for (int j = 0; j < 4; ++j) { const int n = (lane >> 3) + 8 * j; const LAS float* sp = scr + (8 * c) * 33 + n;
        u32x4 o; o.x = pkbf(sp[0 * 33], sp[1 * 33]); o.y = pkbf(sp[2 * 33], sp[3 * 33]); o.z = pkbf(sp[4 * 33], sp[5 * 33]); o.w = pkbf(sp[6 * 33], sp[7 * 33]);
        *(u32x4*)(t.WT + (size_t)(t.n0 + n) * t.K + t.k0 + 8 * c) = o; }
    LDS_WAIT(); asm volatile("" ::: "memory");
}
DI void tr_run(KArgs A, int first, int end, int stride, LAS float* scr, int lane) {
    if (first >= end) return;
    f32x4 va[8], vb[8];
    TrItem ta = tr_decode(A, first), tb = ta; tr_load(ta, lane, va);
    for (int it = first; it < end; it += 2 * stride) {
        const bool hb = it + stride < end;
        if (hb) { tb = tr_decode(A, it + stride); tr_load(tb, lane, vb); }
        tr_store(ta, lane, va, scr);
        if (!hb) break;
        const bool ha = it + 2 * stride < end;
        if (ha) { ta = tr_decode(A, it + 2 * stride); tr_load(ta, lane, va); }
        tr_store(tb, lane, vb, scr);
    }
}
constexpr int TR_FIRST = 16 * 128;
constexpr int TR_TOTAL = 2 * (16 * 128 + 16 * 32 + 16 * 176 + 44 * 32);
constexpr int TR_PER_BLOCK_ITEM = 32;
constexpr int TR_QITEMS = (TR_TOTAL - TR_FIRST + TR_PER_BLOCK_ITEM - 1) / TR_PER_BLOCK_ITEM;

DI void phase_p0a(KArgs A, lds_t* lds) {
    const int tid = threadIdx.x, lane = tid & 63, wave = __builtin_amdgcn_readfirstlane(tid >> 6), G = gridDim.x, bx = blockIdx.x;
    unsigned char* ws = A->ws;
    float* MOD = (float*)(ws + WS_CTL) + CW_MOD;
    float* HYABS = (float*)(ws + WS_CTL) + CW_HYABS;
    if (bx == 0) {
        float* LBT = (float*)(ws + WS_LBT);
        for (int i = tid; i < 1024; i += 512) { const int dir = i >> 9, c = i & 511; const float* p = dir ? A->hg_lb_bwd : A->hg_lb_fwd;
            const float p0 = p[c], p1 = p[512 + c], mx = fmaxf(p0, p1), e0 = __expf(p0 - mx), e1 = __expf(p1 - mx);
            LBT[0 * 1024 + dir * 512 + c] = 0.f; LBT[1 * 1024 + dir * 512 + c] = e1 / (e0 + e1); }
    }
    for (int rnd = 0; rnd < 2; ++rnd) {
        const int un = (G == 256) ? (bx < 160 ? (rnd == 0 ? bx : 999) : 160 + 2 * (bx - 160) + rnd) : bx + rnd * G;
        if (un >= 352) continue;
        if (un < 160) {
            const int l = un / 80, r = un % 80, cs = r < 16 ? 0 : 1, pb = cs ? r - 16 : r, L = cs ? 1024 : 256, p0 = pb * 16;
            LAS float* FE = (LAS float*)lds;
            LAS float* H1 = FE + 16 * 33;
            LAS float* H2 = H1 + 16 * 64;
            LAS float* W1 = H2 + 16 * 64;
            LAS float* W2 = W1 + 33 * 64;
            LAS float* PR = W2 + 64 * 64;
            for (int i = tid; i < 33 * 64; i += 512) W1[i] = A->hy_w1[l * 33 * 64 + i];
            for (int i = tid; i < 64 * 64; i += 512) W2[i] = A->hy_w2[l * 64 * 64 + i];
            if (tid < 256) { const int q = tid >> 6, o = tid & 63; const float* src = q == 0 ? A->hy_b1 : (q == 1 ? A->hy_f1 : (q == 2 ? A->hy_b2 : A->hy_f2)); PR[tid] = src[l * 64 + o]; }
            for (int i = tid; i < 16 * 33; i += 512) { const int p = i / 33, e = i % 33, pos = p0 + p; float v;
                if (e == 0) v = (float)pos / (float)(L - 1);
                else { const int k = (e - 1) & 15; const float band = 1e-4f + (float)k * ((15.0f - 1e-4f) / 15.0f); const float ang = 6.283185307179586f * (float)pos * band / (float)L; v = (e <= 16) ? cosf(ang) : sinf(ang); }
                FE[i] = v; }
            __syncthreads();
            for (int i = tid; i < 16 * 64; i += 512) { const int p = i >> 6, o = i & 63; float sm = PR[o];
#pragma unroll
                for (int e = 0; e < 33; ++e) sm += FE[p * 33 + e] * W1[e * 64 + o];
                H1[i] = sinf(PR[64 + o] * sm); }
            __syncthreads();
            for (int i = tid; i < 16 * 64; i += 512) { const int p = i >> 6, o = i & 63; float sm = PR[128 + o];
#pragma unroll
                for (int k4 = 0; k4 < 16; ++k4) { const f32x4 h = *(const LAS f32x4*)(H1 + p * 64 + 4 * k4); sm += (h.x * W2[(4 * k4) * 64 + o] + h.y * W2[(4 * k4 + 1) * 64 + o]) + (h.z * W2[(4 * k4 + 2) * 64 + o] + h.w * W2[(4 * k4 + 3) * 64 + o]); }
                H2[i] = sinf(PR[192 + o] * sm); }
            __syncthreads();
            float af[16], ab[16];
#pragma unroll
            for (int p = 0; p < 16; ++p) { af[p] = 0.f; ab[p] = 0.f; }
            const float* w3 = A->hy_w3 + (size_t)l * 64 * 1024;
#pragma unroll 1
            for (int kb = 0; kb < 64; kb += 16) {
                float wf[16], wb[16];
#pragma unroll
                for (int k = 0; k < 16; ++k) { wf[k] = w3[(kb + k) * 1024 + tid]; wb[k] = w3[(kb + k) * 1024 + 512 + tid]; }
#pragma unroll
                for (int p = 0; p < 16; ++p)
#pragma unroll
                    for (int k4 = 0; k4 < 4; ++k4) { const f32x4 h = *(const LAS f32x4*)(H2 + p * 64 + kb + 4 * k4);
                        af[p] += (h.x * wf[4 * k4] + h.y * wf[4 * k4 + 1]) + (h.z * wf[4 * k4 + 2] + h.w * wf[4 * k4 + 3]);
                        ab[p] += (h.x * wb[4 * k4] + h.y * wb[4 * k4 + 1]) + (h.z * wb[4 * k4 + 2] + h.w * wb[4 * k4 + 3]); }
            }
            const float mind = -3.0701134573253944f, maxd = -15.350567286626973f;
            const float delta = fabsf(mind + (float)tid * ((maxd - mind) / 511.0f));
            bf16_t* GF = (bf16_t*)(ws + WS_GF + (size_t)l * GF_LSTRIDE + (cs ? GF_SAMPLE_OFF : 0)) + (size_t)tid * (2 * L);
            float asum = 0.f;
#pragma unroll
            for (int p = 0; p < 16; ++p) { const int pos = p0 + p; const float tt = (float)pos / (float)(L - 1), dec = __expf(-tt * delta);
                const float hf = af[p] * dec, hb = ab[p] * dec;
                GF[L - pos] = (bf16_t)(pkbf(hf, 0.f) & 0xffffu); asum += fabsf(hf);
                if (pos >= 1) { GF[L + pos] = (bf16_t)(pkbf(hb, 0.f) & 0xffffu); asum += fabsf(hb); } else GF[0] = 0; }
            atomicAdd(&HYABS[(l * 2 + cs) * 512 + tid], asum);
            __syncthreads();
        } else {
            const int v = un - 160, l = v / 96, r = v % 96, jb = r >> 2, kq = r & 3;
            LAS float* SC = (LAS float*)lds;
            LAS float* PA = SC + 9 * 256;
            for (int i = tid; i < 9 * 256; i += 512) { const int cid = i >> 8, k = kq * 256 + (i & 255); const float cvv = cid == 0 ? A->c_ctx[k] : A->c[(cid - 1) * DM + k]; SC[i] = silu_f(cvv); }
            __syncthreads();
            f32x4 ac[9];
#pragma unroll
            for (int q = 0; q < 9; ++q) ac[q] = (f32x4){0.f, 0.f, 0.f, 0.f};
            const float* wp = A->ada_w + ((size_t)l * DM + kq * 256 + wave * 32) * NMOD + jb * 256 + 4 * lane;
#pragma unroll 1
            for (int kb = 0; kb < 32; kb += 16) { f32x4 wv[16];
#pragma unroll
                for (int kk = 0; kk < 16; ++kk) wv[kk] = *(const f32x4*)(wp + (size_t)(kb + kk) * NMOD);
#pragma unroll
                for (int kk = 0; kk < 16; ++kk)
#pragma unroll
                    for (int q = 0; q < 9; ++q) ac[q] += SC[q * 256 + wave * 32 + kb + kk] * wv[kk]; }
#pragma unroll
            for (int q = 0; q < 9; ++q) *(LAS f32x4*)(PA + (wave * 9 + q) * 256 + 4 * lane) = ac[q];
            __syncthreads();
            for (int i = tid; i < 9 * 256; i += 512) { float s = 0.f;
#pragma unroll
                for (int w = 0; w < 8; ++w) s += PA[w * 9 * 256 + i];
                const int cid = i >> 8, j = jb * 256 + (i & 255);
                if (kq == 0) s += A->ada_b[l * NMOD + j];
                atomicAdd(&MOD[(l * 9 + cid) * NMOD + j], s); }
            __syncthreads();
        }
    }
    tr_run(A, bx * 8 + wave, TR_FIRST, G * 8, (LAS float*)(lds + wave * 16384), lane);
}

DI void bias_tables(KArgs A, lds_t* lds, int seg_lo, int seg_hi) {
    const int tid = ltid(), lane = tid & 63, wave = __builtin_amdgcn_readfirstlane(tid >> 6), gw = blockIdx.x * 8 + wave, NGW = gridDim.x * 8;
    const float* MOD = (const float*)(A->ws + WS_CTL) + CW_MOD;
    constexpr int SHS = 2064, SHI = 16 * SHS;
    __syncthreads();
    for (int seg = seg_lo; seg < seg_hi; ++seg) {
        const int sl = seg - seg_lo; const float* shp = MOD + (size_t)(seg >> 1) * 9 * NMOD + ((seg & 1) ? 3072 : 0) + 2 * tid;
        f32x2_t sv[9];
#pragma unroll
        for (int rw = 0; rw < 9; ++rw) sv[rw] = *(const f32x2_t*)(shp + rw * NMOD);
#pragma unroll
        for (int rw = 0; rw < 16; ++rw) *(LAS unsigned*)(lds + sl * SHI + rw * SHS + 4 * tid) = rw < 9 ? pkbf(sv[rw < 9 ? rw : 0].x, sv[rw < 9 ? rw : 0].y) : 0u;
    }
    __syncthreads();
    const int i16 = lane & 15, q4 = lane >> 4;
    constexpr int G_IN = NIN / 16, G_UP = NUP / 16;
    int gbase = 0;
    for (int seg = seg_lo; seg < seg_hi; ++seg) {
        const int l = seg >> 1, which = seg & 1, nrows = which ? NUP : NIN, ng = which ? G_UP : G_IN, sl = seg - seg_lo;
        const bf16_t* W = which ? (const bf16_t*)(A->ws + WS_WUP) + (size_t)l * NUP * DM : (const bf16_t*)(A->ws + WS_WIN) + (size_t)l * NIN * DM;
        float* bo = (float*)(A->ws + WS_BIAS + (which ? BIAS2_OFF : 0)) + (size_t)l * 9 * nrows;
        for (int g = (gw + NGW - (gbase % NGW)) % NGW; g < ng; g += NGW) {
            const bf16_t* wrow = W + (size_t)(16 * g + i16) * DM + 8 * q4;
            f32x4 ac = (f32x4){0.f, 0.f, 0.f, 0.f};
#pragma unroll
            for (int kh = 0; kh < 2; ++kh) {
                bf16x8 fb[16];
#pragma unroll
                for (int ks = 0; ks < 16; ++ks) fb[ks] = *(const bf16x8*)(wrow + 32 * (16 * kh + ks));
#pragma unroll
                for (int ks = 0; ks < 16; ++ks) { const bf16x8 fa = *(const LAS bf16x8*)(lds + sl * SHI + i16 * SHS + 2 * (32 * (16 * kh + ks) + 8 * q4)); ac = __builtin_amdgcn_mfma_f32_16x16x32_bf16(fa, fb[ks], ac, 0, 0, 0); }
            }
#pragma unroll
            for (int rg = 0; rg < 4; ++rg) { const int cidx = 4 * q4 + rg; if (cidx < 9) bo[(size_t)cidx * nrows + 16 * g + i16] = ac[rg]; }
        }
        gbase += ng;
    }
    __syncthreads();
}

DI void phase_p0b(KArgs A, lds_t* lds) {
    const int tid = ltid(), lane = tid & 63, wave = __builtin_amdgcn_readfirstlane(tid >> 6), gw = blockIdx.x * 8 + wave, NGW = gridDim.x * 8;
    const float* MOD = (const float*)(A->ws + WS_CTL) + CW_MOD;
    bf16_t* H = (bf16_t*)(A->ws + WS_H); float* RSP = (float*)(A->ws + WS_RSP);
    for (int mb = gw; mb < TT; mb += 3 * NGW) {
        f32x4 v[3][4];
#pragma unroll
        for (int rI = 0; rI < 3; ++rI) { const int m = mb + rI * NGW;
            if (m < TT) { const float* xr = (m < TP) ? A->x_prompt + (size_t)m * DM : A->x_sample + (size_t)(m - TP) * DM;
#pragma unroll
                for (int j = 0; j < 4; ++j) v[rI][j] = *(const f32x4*)(xr + 4 * lane + 256 * j); } }
#pragma unroll
        for (int rI = 0; rI < 3; ++rI) { const int m = mb + rI * NGW;
            if (m < TT) { const float* md = MOD + cid_of_row(m) * NMOD; float sm = 0.f;
#pragma unroll
                for (int j = 0; j < 4; ++j) sm += (v[rI][j].x * v[rI][j].x + v[rI][j].y * v[rI][j].y) + (v[rI][j].z * v[rI][j].z + v[rI][j].w * v[rI][j].w);
                sm = wave_sum(sm);
                if (lane < 4) RSP[(size_t)m * 4 + lane] = lane == 0 ? sm : 0.f;
#pragma unroll
                for (int j = 0; j < 4; ++j) { const int c = 4 * lane + 256 * j; const f32x4 w = *(const f32x4*)(A->norm1_w + c), sc = *(const f32x4*)(md + 1024 + c);
                    const f32x4 o = v[rI][j] * w * (1.0f + sc);
                    u32x2 pk; pk.x = pkbf(o.x, o.y); pk.y = pkbf(o.z, o.w); *(u32x2*)(H + (size_t)m * DM + c) = pk; } } }
    }
    bias_tables(A, lds, 0, 1);
}
DI void phase_final_norm(KArgs A) {
    const int tid = ltid(), lane = tid & 63, wave = __builtin_amdgcn_readfirstlane(tid >> 6), gw = blockIdx.x * 8 + wave, NGW = gridDim.x * 8;
    for (int m = gw; m < TT; m += NGW) {
        float* xr = A->out + (size_t)m * DM;
        f32x4 v[4]; float s = 0.f;
#pragma unroll
        for (int j = 0; j < 4; ++j) { v[j] = *(const f32x4*)(xr + 4 * lane + 256 * j); s += (v[j].x * v[j].x + v[j].y * v[j].y) + (v[j].z * v[j].z + v[j].w * v[j].w); }
        const float r = 1.0f / sqrtf(wave_sum(s) * (1.0f / DM) + EPS);
#pragma unroll
        for (int j = 0; j < 4; ++j) { const int c = 4 * lane + 256 * j; const f32x4 w = *(const f32x4*)(A->final_norm_w + c); *(f32x4*)(xr + c) = v[j] * r * w; }
    }
}

struct HyRaw { u32x4 v[3]; u32x4 h; };
DI void hyprep_load(const bf16_t* P, int un, int tid, HyRaw& q) {
    const int tb = un >> 3, cb = un & 7, m0 = 64 * tb, row = tid >> 3, ch = tid & 7;
    const bool pr = m0 < TP, has_prev = pr && ((m0 & 255) != 0), has_next = pr && (((m0 + 64) & 255) != 0);
#pragma unroll
    for (int a = 0; a < 3; ++a) q.v[a] = *(const u32x4*)(P + (size_t)(m0 + row) * NIN + 2560 + a * 512 + cb * 64 + ch * 8);
    q.h = (u32x4){0u, 0u, 0u, 0u};
    if (tid < 48) { const int a = tid >> 4, which = (tid >> 3) & 1, chh = tid & 7; const bool valid = which ? has_next : has_prev; const int mrow = which ? m0 + 64 : m0 - 1;
        if (valid) q.h = *(const u32x4*)(P + (size_t)mrow * NIN + 2560 + a * 512 + cb * 64 + chh * 8); }
}
DI void phase_hyprep(KArgs A, int l, lds_t* lds) {
    const int tid = ltid();
    const bf16_t* P = (const bf16_t*)(A->ws + WS_P);
    bf16_t* UT = (bf16_t*)(A->ws + WS_UT); bf16_t* X2T = (bf16_t*)(A->ws + WS_X2T);
    constexpr int RS = 144;
    const int NU = 192 * 8, G = gridDim.x;
    HyRaw cur, nxt;
    if ((int)blockIdx.x < NU) hyprep_load(P, blockIdx.x, tid, cur);
    for (int un = blockIdx.x; un < NU; un += G) {
        const int tb = un >> 3, cb = un & 7, m0 = 64 * tb;
        {
            const int row = tid >> 3, ch = tid & 7;
#pragma unroll
            for (int a = 0; a < 3; ++a) *(LAS u32x4*)(lds + a * 66 * RS + (row + 1) * RS + ch * 16) = cur.v[a];
            if (tid < 48) { const int a = tid >> 4, which = (tid >> 3) & 1, chh = tid & 7; *(LAS u32x4*)(lds + a * 66 * RS + (which ? 65 : 0) * RS + chh * 16) = cur.h; }
        }
        if (un + G < NU) hyprep_load(P, un + G, tid, nxt);
        BAR_LDS();
        {
            const int ch = tid >> 3, tq = tid & 7, cg = cb * 64 + ch;
            float w[3][3];
#pragma unroll
            for (int a = 0; a < 3; ++a)
#pragma unroll
                for (int j = 0; j < 3; ++j) w[a][j] = A->hy_conv_w[(l * 3 + j) * 1536 + a * 512 + cg];
            float uu[8], xx[8], cvv[3][8];
#pragma unroll
            for (int a = 0; a < 3; ++a) { const lds_t* bp = lds + a * 66 * RS + 2 * ch + (8 * tq) * RS; float win[10];
#pragma unroll
                for (int i = 0; i < 10; ++i) win[i] = bf1(*(const LAS bf16_t*)(bp + i * RS));
#pragma unroll
                for (int i = 0; i < 8; ++i) cvv[a][i] = w[a][0] * win[i] + w[a][1] * win[i + 1] + w[a][2] * win[i + 2]; }
#pragma unroll
            for (int i = 0; i < 8; ++i) { uu[i] = cvv[1][i] * cvv[0][i]; xx[i] = cvv[2][i]; }
            u32x4 o; o.x = pkbf(uu[0], uu[1]); o.y = pkbf(uu[2], uu[3]); o.z = pkbf(uu[4], uu[5]); o.w = pkbf(uu[6], uu[7]);
            *(u32x4*)(UT + (size_t)cg * TT + m0 + 8 * tq) = o;
            o.x = pkbf(xx[0], xx[1]); o.y = pkbf(xx[2], xx[3]); o.z = pkbf(xx[4], xx[5]); o.w = pkbf(xx[6], xx[7]);
            *(u32x4*)(X2T + (size_t)cg * TT + m0 + 8 * tq) = o;
        }
        BAR_LDS();
        cur = nxt;
    }
}

constexpr int S_QE = 0, S_QS = 17408, S_KS = 34816, S_QB = 52224, S_KB = 60928, S_KT = 69632, S_VT = 88064, S_PP = 106496, S_ST = 115712, S_GT = 150528, S_DEC = 154624;
static_assert(S_DEC + 512 <= MISC_OFF, "scan lds");
DI void scan_item(KArgs A, int l, int seq, int head, int dir, lds_t* lds, bool prb) {
    const int tid = ltid(), lane = tid & 63, w = __builtin_amdgcn_readfirstlane(tid >> 6);
    const bool samp = seq >= 16;
    const int L = samp ? 1024 : 256, mbase = samp ? TP + (seq - 16) * 1024 : seq * 256, nch = L >> 6;
    const bf16_t* P = (const bf16_t*)(A->ws + WS_P);
    const bf16_t* Pq = P + (size_t)mbase * NIN + head * 128;
    const bf16_t* Pf = Pq + 512 + dir * 512;
    const bf16_t* Pv = Pq + 1536;
    bf16_t* Oo = (bf16_t*)(A->ws + WS_H) + (size_t)dir * TT * 512 + (size_t)mbase * 512 + head * 128;
    const int a = w >> 2, jv = w & 3, r = lane & 31, hh = lane >> 5;
    f32x16 Sa[2];
    if (samp) {
        const float* st = A->state + ((((size_t)(seq - 16) * 2 + l) * 2 + dir) * 4 + head) * 16384;
#pragma unroll
        for (int ii = 0; ii < 2; ++ii)
#pragma unroll
            for (int rg = 0; rg < 16; ++rg) Sa[ii][rg] = st[(size_t)(32 * (2 * a + ii) + crow(rg, hh)) * 128 + 32 * jv + r];
    } else {
#pragma unroll
        for (int ii = 0; ii < 2; ++ii)
#pragma unroll
            for (int rg = 0; rg < 16; ++rg) Sa[ii][rg] = 0.f;
    }
#pragma unroll
    for (int ii = 0; ii < 2; ++ii)
#pragma unroll
        for (int q4 = 0; q4 < 4; ++q4) { u32x2 pk; pk.x = pkbf(Sa[ii][4 * q4], Sa[ii][4 * q4 + 1]); pk.y = pkbf(Sa[ii][4 * q4 + 2], Sa[ii][4 * q4 + 3]);
            *(LAS u32x2*)(lds + S_ST + (32 * jv + r) * 272 + 2 * (32 * (2 * a + ii) + 8 * q4 + 4 * hh)) = pk; }
    unsigned rq[8], rf[8], rv[8];
    const long tstep = dir ? -(long)NIN : (long)NIN;
    const size_t off0 = (size_t)(dir ? L - 1 - 8 * w : 8 * w) * NIN + 2 * lane;
#pragma unroll
    for (int i = 0; i < 8; ++i) { const long off = (long)off0 + i * tstep; rq[i] = *(const unsigned*)(Pq + off); rf[i] = *(const unsigned*)(Pf + off); rv[i] = *(const unsigned*)(Pv + off); }
#pragma unroll
    for (int i = 0; i < 8; ++i) asm volatile("" :: "v"(rq[i]), "v"(rf[i]), "v"(rv[i]));
    lds_t* OT = lds + S_QS + w * 2560;
#define STG(k) do { if (PROBE_PH == 110 + (k) && prb && tid == 0) { const unsigned long long t_ = __builtin_amdgcn_s_memrealtime(); volatile LAS unsigned long long* a_ = (volatile LAS unsigned long long*)(lds + MISC_OFF + 136); volatile LAS unsigned long long* l_ = (volatile LAS unsigned long long*)(lds + MISC_OFF + 144); *a_ = *a_ + (t_ - *l_); } \
        if (PROBE_PH >= 110 && PROBE_PH <= 113 && prb && tid == 0) *(volatile LAS unsigned long long*)(lds + MISC_OFF + 144) = __builtin_amdgcn_s_memrealtime(); } while (0)
    if (PROBE_PH >= 110 && PROBE_PH <= 113 && prb && tid == 0) { *(volatile LAS unsigned long long*)(lds + MISC_OFF + 128) = 0ull; *(volatile LAS unsigned long long*)(lds + MISC_OFF + 136) = 0ull; *(volatile LAS unsigned long long*)(lds + MISC_OFF + 144) = __builtin_amdgcn_s_memrealtime(); }
    if (PROBE_PH == 114 && prb && tid == 0) *(volatile LAS unsigned long long*)(lds + MISC_OFF + 128) = __builtin_amdgcn_s_memrealtime();
    for (int ch = 0; ch < nch; ++ch) {
        STG(3);
        unsigned nq[8], nf[8], nv[8];
        if (ch + 1 < nch) {
            const long offc = (long)off0 + (long)(64 * (ch + 1)) * tstep;
#pragma unroll
            for (int i = 0; i < 8; ++i) { const long off = offc + i * tstep; nq[i] = *(const unsigned*)(Pq + off); nf[i] = *(const unsigned*)(Pf + off); nv[i] = *(const unsigned*)(Pv + off); }
        } else {
#pragma unroll
            for (int i = 0; i < 8; ++i) { nq[i] = 0u; nf[i] = 0u; nv[i] = 0u; }
        }
        { float s0 = 0.f, s1 = 0.f;
#pragma unroll
          for (int i = 0; i < 8; ++i) { s0 += bflo(rf[i]); s1 += bfhi(rf[i]); }
          *(LAS f32x2_t*)(lds + S_GT + (w * 128 + 2 * lane) * 4) = (f32x2_t){s0, s1}; }
        BAR_LDS();
        STG(0);
        {
            float my0 = 0.f, my1 = 0.f, p2_0 = 0.f, p2_1 = 0.f, p4_0 = 0.f, p4_1 = 0.f, p6_0 = 0.f, p6_1 = 0.f, run0 = 0.f, run1 = 0.f;
#pragma unroll
            for (int g = 0; g < 8; ++g) {
                if (g == 2) { p2_0 = run0; p2_1 = run1; } if (g == 4) { p4_0 = run0; p4_1 = run1; } if (g == 6) { p6_0 = run0; p6_1 = run1; }
                if (g == w) { my0 = run0; my1 = run1; }
                const f32x2_t gt = *(const LAS f32x2_t*)(lds + S_GT + (g * 128 + 2 * lane) * 4); run0 += gt.x; run1 += gt.y; }
            const float p8_0 = run0, p8_1 = run1;
            const float rd0 = (w < 4) ? p2_0 : p6_0, rd1 = (w < 4) ? p2_1 : p6_1;
            if (w == 0) *(LAS f32x2_t*)(lds + S_DEC + 8 * lane) = (f32x2_t){__expf(p8_0), __expf(p8_1)};
            float G0 = __expf(fminf(my0 - rd0, 80.f)), G1 = __expf(fminf(my1 - rd1, 80.f));
            const float crd0 = __expf(rd0), crd1 = __expf(rd1), cend0 = __expf(fminf(p8_0 - rd0, 0.f)), cend1 = __expf(fminf(p8_1 - rd1, 0.f));
            const float c40 = __expf(fminf((w < 4) ? p4_0 - p2_0 : p6_0 - p4_0, 0.f)), c41 = __expf(fminf((w < 4) ? p4_1 - p2_1 : p6_1 - p4_1, 0.f));
            unsigned kt0[4], kt1[4], vt0[4], vt1[4];
            float kprev0 = 0.f, kprev1 = 0.f, vprev0 = 0.f, vprev1 = 0.f;
            lds_t* rowp = lds + (8 * w) * 272 + 4 * lane;
#pragma unroll
            for (int i = 0; i < 8; ++i) {
                const float q0 = bflo(rq[i]), q1 = bfhi(rq[i]), F0 = __expf(bflo(rf[i])), F1 = __expf(bfhi(rf[i])), v0 = bflo(rv[i]), v1 = bfhi(rv[i]);
                const float k0 = 1.0f - F0, k1 = 1.0f - F1;
                G0 *= F0; G1 *= F1;
                const float ig0 = __builtin_amdgcn_rcpf(fmaxf(G0, 1e-30f)), ig1 = __builtin_amdgcn_rcpf(fmaxf(G1, 1e-30f));
                const float qs0 = q0 * G0, qs1 = q1 * G1, ks0 = k0 * ig0, ks1 = k1 * ig1;
                *(LAS unsigned*)(rowp + S_QS + i * 272) = pkbf(qs0, qs1);
                *(LAS unsigned*)(rowp + S_KS + i * 272) = pkbf(ks0, ks1);
                *(LAS unsigned*)(rowp + S_QE + i * 272) = pkbf(qs0 * crd0, qs1 * crd1);
                if (w >= 4) *(LAS unsigned*)(rowp + S_QB - 32 * 272 + i * 272) = pkbf(qs0 * c40, qs1 * c41);
                else        *(LAS unsigned*)(rowp + S_KB + i * 272) = pkbf(ks0 * c40, ks1 * c41);
                const float kk0 = ks0 * cend0, kk1 = ks1 * cend1;
                if (i & 1) { kt0[i >> 1] = pkbf(kprev0, kk0); kt1[i >> 1] = pkbf(kprev1, kk1); vt0[i >> 1] = pkbf(vprev0, v0); vt1[i >> 1] = pkbf(vprev1, v1); }
                else { kprev0 = kk0; kprev1 = kk1; vprev0 = v0; vprev1 = v1; }
            }
            *(LAS u32x4*)(lds + S_KT + (2 * lane) * 144 + 16 * w) = (u32x4){kt0[0], kt0[1], kt0[2], kt0[3]};
            *(LAS u32x4*)(lds + S_KT + (2 * lane + 1) * 144 + 16 * w) = (u32x4){kt1[0], kt1[1], kt1[2], kt1[3]};
            *(LAS u32x4*)(lds + S_VT + (2 * lane) * 144 + 16 * w) = (u32x4){vt0[0], vt0[1], vt0[2], vt0[3]};
            *(LAS u32x4*)(lds + S_VT + (2 * lane + 1) * 144 + 16 * w) = (u32x4){vt1[0], vt1[1], vt1[2], vt1[3]};
        }
        BAR_LDS();
        STG(1);
        if (w < 3) {
            const lds_t* Ab = lds + (w == 2 ? S_QB : (w == 1 ? S_QS + 32 * 272 : S_QS));
            const lds_t* Bb = lds + (w == 2 ? S_KB : (w == 1 ? S_KS + 32 * 272 : S_KS));
            const int prow0 = w == 0 ? 0 : 32, pcol0 = w == 1 ? 32 : 0; const bool mask = w != 2;
            f32x16 sc;
#pragma unroll
            for (int rg = 0; rg < 16; ++rg) sc[rg] = 0.f;
            { bf16x8 fa[8], fb[8];
#pragma unroll
              for (int s = 0; s < 8; ++s) { fa[s] = *(const LAS bf16x8*)(Ab + r * 272 + 32 * s + 16 * hh); fb[s] = *(const LAS bf16x8*)(Bb + r * 272 + 32 * s + 16 * hh); }
              __builtin_amdgcn_sched_barrier(0);
#pragma unroll
              for (int s = 0; s < 8; ++s) sc = MFMA32(fa[s], fb[s], sc); }
#pragma unroll
            for (int rg = 0; rg < 16; ++rg) { const int jl = crow(rg, hh); const float val = (mask && r > jl) ? 0.f : sc[rg];
                *(LAS bf16_t*)(lds + S_PP + (prow0 + jl) * 144 + 2 * (pcol0 + r)) = (bf16_t)(pkbf(val, 0.f) & 0xffffu); }
        }
        f32x16 oacc;
#pragma unroll
        for (int rg = 0; rg < 16; ++rg) oacc[rg] = 0.f;
        { bf16x8 fa[8], fb[8];
#pragma unroll
          for (int s = 0; s < 8; ++s) { fa[s] = *(const LAS bf16x8*)(lds + S_QE + (32 * a + r) * 272 + 32 * s + 16 * hh); fb[s] = *(const LAS bf16x8*)(lds + S_ST + (32 * jv + r) * 272 + 32 * s + 16 * hh); }
          __builtin_amdgcn_sched_barrier(0);
#pragma unroll
          for (int s = 0; s < 8; ++s) oacc = MFMA32(fa[s], fb[s], oacc); }
        { bf16x8 fa[2][4], fb[4]; f32x4 dv[2][4];
#pragma unroll
          for (int s = 0; s < 4; ++s) fb[s] = *(const LAS bf16x8*)(lds + S_VT + (32 * jv + r) * 144 + 32 * s + 16 * hh);
#pragma unroll
          for (int ii = 0; ii < 2; ++ii) { const int dkb = 32 * (2 * a + ii);
#pragma unroll
              for (int q4 = 0; q4 < 4; ++q4) dv[ii][q4] = *(const LAS f32x4*)(lds + S_DEC + 4 * (dkb + 8 * q4 + 4 * hh));
#pragma unroll
              for (int s = 0; s < 4; ++s) fa[ii][s] = *(const LAS bf16x8*)(lds + S_KT + (dkb + r) * 144 + 32 * s + 16 * hh); }
          __builtin_amdgcn_sched_barrier(0);
#pragma unroll
          for (int ii = 0; ii < 2; ++ii)
#pragma unroll
              for (int q4 = 0; q4 < 4; ++q4) { Sa[ii][4 * q4] *= dv[ii][q4].x; Sa[ii][4 * q4 + 1] *= dv[ii][q4].y; Sa[ii][4 * q4 + 2] *= dv[ii][q4].z; Sa[ii][4 * q4 + 3] *= dv[ii][q4].w; }
#pragma unroll
          for (int s = 0; s < 4; ++s) { Sa[0] = MFMA32(fa[0][s], fb[s], Sa[0]); Sa[1] = MFMA32(fa[1][s], fb[s], Sa[1]); } }
        BAR_LDS();
        STG(2);
        { bf16x8 fa[4], fb[4];
#pragma unroll
          for (int s = 0; s < 4; ++s) { if (s < 2 || a == 1) { fa[s] = *(const LAS bf16x8*)(lds + S_PP + (32 * a + r) * 144 + 32 * s + 16 * hh); fb[s] = *(const LAS bf16x8*)(lds + S_VT + (32 * jv + r) * 144 + 32 * s + 16 * hh); } }
          __builtin_amdgcn_sched_barrier(0);
#pragma unroll
          for (int s = 0; s < 4; ++s) { if (s < 2 || a == 1) oacc = MFMA32(fa[s], fb[s], oacc); } }
#pragma unroll
        for (int rg = 0; rg < 16; ++rg) *(LAS bf16_t*)(OT + crow(rg, hh) * 80 + 2 * r) = (bf16_t)(pkbf(oacc[rg], 0.f) & 0xffffu);
#pragma unroll
        for (int ii = 0; ii < 2; ++ii)
#pragma unroll
            for (int q4 = 0; q4 < 4; ++q4) { u32x2 pk; pk.x = pkbf(Sa[ii][4 * q4], Sa[ii][4 * q4 + 1]); pk.y = pkbf(Sa[ii][4 * q4 + 2], Sa[ii][4 * q4 + 3]);
                *(LAS u32x2*)(lds + S_ST + (32 * jv + r) * 272 + 2 * (32 * (2 * a + ii) + 8 * q4 + 4 * hh)) = pk; }
        { const int tl = lane >> 1, hf = lane & 1, tau = 64 * ch + 32 * a + tl, t = dir ? L - 1 - tau : tau;
          const u32x4 o0 = *(const LAS u32x4*)(OT + tl * 80 + 32 * hf), o1 = *(const LAS u32x4*)(OT + tl * 80 + 32 * hf + 16);
          bf16_t* op = Oo + (size_t)t * 512 + 32 * jv + 16 * hf; *(u32x4*)op = o0; *(u32x4*)(op + 8) = o1; }
#pragma unroll
        for (int i = 0; i < 8; ++i) { rq[i] = nq[i]; rf[i] = nf[i]; rv[i] = nv[i]; }
    }
    if (PROBE_PH == 114 && prb && tid == 0) *(volatile LAS unsigned long long*)(lds + MISC_OFF + 136) = __builtin_amdgcn_s_memrealtime();
    if (!samp) {
        float* ns = A->out + (size_t)TT * DM + ((((size_t)seq * 2 + l) * 2 + dir) * 4 + head) * 16384;
#pragma unroll
        for (int ii = 0; ii < 2; ++ii)
#pragma unroll
            for (int rg = 0; rg < 16; ++rg) ns[(size_t)(32 * (2 * a + ii) + crow(rg, hh)) * 128 + 32 * jv + r] = Sa[ii][rg];
    }
    BAR_LDS();
}

constexpr int H_CST = 4112, H_CP = 0, H_UP = 33024, H_UPBYTES = 61440, H_GST = H_UP + H_UPBYTES;
DI void hyena_item(KArgs A, int l, int cs, int c, bool zero_pads, lds_t* lds) {
    const int tid = ltid(), lane = tid & 63, w = __builtin_amdgcn_readfirstlane(tid >> 6);
    const int L = cs ? 1024 : 256, NB = L >> 5, nseq = cs ? 8 : 16, m0 = cs ? TP : 0, SEQST = 3 * NB * 80;
    bf16_t* UT = (bf16_t*)(A->ws + WS_UT) + (size_t)c * TT + m0;
    const bf16_t* X2T = (const bf16_t*)(A->ws + WS_X2T) + (size_t)c * TT + m0;
    const bf16_t* GF = (const bf16_t*)(A->ws + WS_GF + (size_t)l * GF_LSTRIDE + (cs ? GF_SAMPLE_OFF : 0)) + (size_t)c * (2 * L);
    if (zero_pads) { for (int i = tid; i < H_UPBYTES / 16; i += 512) *(LAS u32x4*)(lds + H_UP + 16 * i) = (u32x4){0u, 0u, 0u, 0u}; BAR_LDS(); }
    { const int nchunk = nseq * L / 8, cps = L / 8;
      for (int q = tid; q < nchunk; q += 512) { const int sq = q / cps, s = 8 * (q % cps); const u32x4 v = *(const u32x4*)(UT + (size_t)sq * L + s);
          *(LAS u32x4*)(lds + H_UP + sq * SEQST + (NB + (s >> 5)) * 80 + 2 * (s & 31)) = v; }
      for (int q = tid; q < 2 * L / 8; q += 512) *(LAS u32x4*)(lds + H_GST + 16 * q) = *(const u32x4*)(GF + 8 * q); }
    BAR_LDS();
    { const int nck = (2 * L) >> 3;
      for (int e = tid; e < 8 * nck; e += 512) { const int m = __builtin_amdgcn_readfirstlane(e / nck), q = e % nck;
          const u32x4 hi = *(const LAS u32x4*)(lds + H_GST + 16 * q); u32x4 lo = (u32x4){0u, 0u, 0u, 0u}; if (q > 0) lo = *(const LAS u32x4*)(lds + H_GST + 16 * q - 16);
          const unsigned D[8] = {lo.x, lo.y, lo.z, lo.w, hi.x, hi.y, hi.z, hi.w}; u32x4 o;
          switch (m) {
              case 0: o = hi; break;
              case 1: o = (u32x4){__builtin_amdgcn_alignbyte(D[4], D[3], 2), __builtin_amdgcn_alignbyte(D[5], D[4], 2), __builtin_amdgcn_alignbyte(D[6], D[5], 2), __builtin_amdgcn_alignbyte(D[7], D[6], 2)}; break;
              case 2: o = (u32x4){D[3], D[4], D[5], D[6]}; break;
              case 3: o = (u32x4){__builtin_amdgcn_alignbyte(D[3], D[2], 2), __builtin_amdgcn_alignbyte(D[4], D[3], 2), __builtin_amdgcn_alignbyte(D[5], D[4], 2), __builtin_amdgcn_alignbyte(D[6], D[5], 2)}; break;
              case 4: o = (u32x4){D[2], D[3], D[4], D[5]}; break;
              case 5: o = (u32x4){__builtin_amdgcn_alignbyte(D[2], D[1], 2), __builtin_amdgcn_alignbyte(D[3], D[2], 2), __builtin_amdgcn_alignbyte(D[4], D[3], 2), __builtin_amdgcn_alignbyte(D[5], D[4], 2)}; break;
              case 6: o = (u32x4){D[1], D[2], D[3], D[4]}; break;
              default: o = (u32x4){__builtin_amdgcn_alignbyte(D[1], D[0], 2), __builtin_amdgcn_alignbyte(D[2], D[1], 2), __builtin_amdgcn_alignbyte(D[3], D[2], 2), __builtin_amdgcn_alignbyte(D[4], D[3], 2)}; break;
          }
          *(LAS u32x4*)(lds + H_CP + m * H_CST + 16 * q) = o; } }
    BAR_LDS();
    const int r = lane & 31, hh = lane >> 5;
    const bool active = cs ? true : (w < 4);
    u32x2 x2r[4];
    { const int sq = cs ? w : 4 * w + (r >> 3), ab = cs ? r : (r & 7);
#pragma unroll
      for (int q4 = 0; q4 < 4; ++q4) { x2r[q4] = (u32x2){0u, 0u}; if (active) x2r[q4] = *(const u32x2*)(X2T + (size_t)sq * L + 32 * ab + 8 * q4 + 4 * hh); } }
    if (active) {
        const int sq = cs ? w : 4 * w + (r >> 3), ab = cs ? r : (r & 7);
        const lds_t* ub = lds + H_UP + sq * SEQST + (NB + ab) * 80 + 16 * hh;
        const lds_t* cb = lds + H_CP + (r & 7) * H_CST + 2 * (L - 8 * (r >> 3) + 8 * hh);
        f32x16 z;
#pragma unroll
        for (int rg = 0; rg < 16; ++rg) z[rg] = 0.f;
        bf16x8 fa0, fa1, fb0, fb1, ga0, ga1, gb0, gb1;
        int d = -(NB - 1);
        fa0 = *(const LAS bf16x8*)(cb - 64 * d); fa1 = *(const LAS bf16x8*)(cb - 64 * d + 32); fb0 = *(const LAS bf16x8*)(ub - 80 * d); fb1 = *(const LAS bf16x8*)(ub - 80 * d + 32);
        for (; d + 1 <= NB - 1; d += 2) {
            ga0 = *(const LAS bf16x8*)(cb - 64 * (d + 1)); ga1 = *(const LAS bf16x8*)(cb - 64 * (d + 1) + 32); gb0 = *(const LAS bf16x8*)(ub - 80 * (d + 1)); gb1 = *(const LAS bf16x8*)(ub - 80 * (d + 1) + 32);
            __builtin_amdgcn_sched_barrier(0);
            z = MFMA32(fa0, fb0, z); z = MFMA32(fa1, fb1, z);
            __builtin_amdgcn_sched_barrier(0);
            fa0 = *(const LAS bf16x8*)(cb - 64 * (d + 2)); fa1 = *(const LAS bf16x8*)(cb - 64 * (d + 2) + 32); fb0 = *(const LAS bf16x8*)(ub - 80 * (d + 2)); fb1 = *(const LAS bf16x8*)(ub - 80 * (d + 2) + 32);
            __builtin_amdgcn_sched_barrier(0);
            z = MFMA32(ga0, gb0, z); z = MFMA32(ga1, gb1, z);
            __builtin_amdgcn_sched_barrier(0);
        }
        z = MFMA32(fa0, fb0, z); z = MFMA32(fa1, fb1, z);
        const float invn = 1.0f / (((const float*)(A->ws + WS_CTL))[CW_HYABS + (l * 2 + cs) * 512 + c] + EPS), dd = A->hy_d[l * 512 + c];
#pragma unroll
        for (int q4 = 0; q4 < 4; ++q4) { const int t0 = 32 * ab + 8 * q4 + 4 * hh;
            const u32x2 uu = *(const LAS u32x2*)(lds + H_UP + sq * SEQST + (NB + ab) * 80 + 2 * (8 * q4 + 4 * hh));
            const u32x2 x2 = x2r[q4];
            const float y0 = bflo(x2.x) * (invn * z[4 * q4 + 0] + dd * bflo(uu.x)), y1 = bfhi(x2.x) * (invn * z[4 * q4 + 1] + dd * bfhi(uu.x));
            const float y2 = bflo(x2.y) * (invn * z[4 * q4 + 2] + dd * bflo(uu.y)), y3 = bfhi(x2.y) * (invn * z[4 * q4 + 3] + dd * bfhi(uu.y));
            u32x2 o; o.x = pkbf(y0, y1); o.y = pkbf(y2, y3);
            *(u32x2*)(UT + (size_t)sq * L + t0) = o; }
    }
    BAR_LDS();
}

DI void phase_mixer(KArgs A, int l, lds_t* lds) {
    unsigned* qhead = (unsigned*)(A->ws + WS_CTL) + CW_QUEUE + 64 * l;
    volatile LAS unsigned* bc = (volatile LAS unsigned*)(lds + MISC_OFF) + 16;
    int last_kind = -1;
    int n_items = 0;
    if ((PROBE_PH == 100 || PROBE_PH == 101) && l == 1 && threadIdx.x == 0) *(volatile LAS unsigned long long*)(lds + MISC_OFF + 128) = __builtin_amdgcn_s_memrealtime();
    for (;;) {
        BAR_LDS();
        if (threadIdx.x == 0) *bc = __hip_atomic_fetch_add(qhead, 1u, __ATOMIC_RELAXED, __HIP_MEMORY_SCOPE_AGENT);
        BAR_LDS();
        const int it = (int)*bc;
        if (PROBE_PH == 100 && l == 1 && n_items == 1 && threadIdx.x == 0) *(volatile LAS unsigned long long*)(lds + MISC_OFF + 136) = __builtin_amdgcn_s_memrealtime();
        ++n_items;
        if (it >= 1216 + (l == 0 ? TR_QITEMS : 0)) break;
        if (it >= 1216) {
            const int w = __builtin_amdgcn_readfirstlane(threadIdx.x >> 6), base = TR_FIRST + (it - 1216) * TR_PER_BLOCK_ITEM;
            const int e = base + TR_PER_BLOCK_ITEM < TR_TOTAL ? base + TR_PER_BLOCK_ITEM : TR_TOTAL;
            tr_run(A, base + w, e, 8, (LAS float*)(lds + w * 16384), threadIdx.x & 63); last_kind = -1; continue; }
        const bool is_scan = it < 64 || (it >= 576 && it < 704);
        const bool iprb = l == 1 && ((PROBE_PH == 115 && it == 164) || (PROBE_PH == 116 && it == 576) || (PROBE_PH == 117 && it == 804));
        if (iprb && threadIdx.x == 0) { *(volatile LAS unsigned*)(lds + MISC_OFF + 160) = 1u; *(volatile LAS unsigned long long*)(lds + MISC_OFF + 128) = __builtin_amdgcn_s_memrealtime(); }
        if (is_scan) { const int i2 = it < 64 ? it : it - 576, sq = (it < 64 ? 16 : 0) + (i2 >> 3); const bool prb_ = (l == 1 && it == 0); if (PROBE_PH >= 110 && prb_ && threadIdx.x == 0) *(volatile LAS unsigned*)(lds + MISC_OFF + 160) = 1u; scan_item(A, l, sq, (i2 >> 1) & 3, i2 & 1, lds, prb_); last_kind = -1; }
        else { const int cs = it < 576 ? 1 : 0, c = cs ? it - 64 : it - 704; hyena_item(A, l, cs, c, last_kind != cs, lds); last_kind = cs; }
        if (iprb && threadIdx.x == 0) *(volatile LAS unsigned long long*)(lds + MISC_OFF + 136) = __builtin_amdgcn_s_memrealtime();
    }
    if (PROBE_PH == 101 && l == 1 && threadIdx.x == 0) *(volatile LAS unsigned long long*)(lds + MISC_OFF + 136) = __builtin_amdgcn_s_memrealtime();
}

DI void phase_merge(KArgs A, int l, lds_t* lds) {
    const int tid = threadIdx.x;
    if (l == 0) bias_tables(A, lds, 1, 4);
    const bf16_t* P = (const bf16_t*)(A->ws + WS_P);
    const bf16_t* OF = (const bf16_t*)(A->ws + WS_H); const bf16_t* OB = OF + (size_t)TT * 512;
    const bf16_t* YT = (const bf16_t*)(A->ws + WS_UT);
    bf16_t* MG = (bf16_t*)(A->ws + WS_MERGED);
    constexpr int RS = 1040;
    for (int un = blockIdx.x; un < TT / 32; un += gridDim.x) {
        const int m0 = 32 * un;
        const int j = tid >> 4, sub = tid & 15, m = m0 + j, cbase = 32 * sub;
        u32x4 yv[4], fv[4], bv[4], gv[4];
        { const bf16_t* yp = YT + (size_t)tid * TT + m0;
#pragma unroll
          for (int q = 0; q < 4; ++q) { yv[q] = *(const u32x4*)(yp + 8 * q); fv[q] = *(const u32x4*)(OF + (size_t)m * 512 + cbase + 8 * q); bv[q] = *(const u32x4*)(OB + (size_t)m * 512 + cbase + 8 * q);
              gv[q] = *(const u32x4*)(P + (size_t)m * NIN + 2048 + cbase + 8 * q); } }
#pragma unroll
        for (int q = 0; q < 4; ++q) { const unsigned vv[4] = {yv[q].x, yv[q].y, yv[q].z, yv[q].w};
#pragma unroll
            for (int e = 0; e < 4; ++e) { *(LAS bf16_t*)(lds + (8 * q + 2 * e) * RS + 2 * tid) = (bf16_t)(vv[e] & 0xffffu); *(LAS bf16_t*)(lds + (8 * q + 2 * e + 1) * RS + 2 * tid) = (bf16_t)(vv[e] >> 16); } }
        {
            float o[32]; float ss = 0.f;
#pragma unroll
            for (int q = 0; q < 4; ++q) { const unsigned ff[4] = {fv[q].x, fv[q].y, fv[q].z, fv[q].w}, bb[4] = {bv[q].x, bv[q].y, bv[q].z, bv[q].w};
#pragma unroll
                for (int e = 0; e < 4; ++e) { const float a0 = bflo(ff[e]) + bflo(bb[e]), a1 = bfhi(ff[e]) + bfhi(bb[e]); o[8 * q + 2 * e] = a0; o[8 * q + 2 * e + 1] = a1; ss += a0 * a0 + a1 * a1; } }
            ss += __shfl_xor(ss, 1); ss += __shfl_xor(ss, 2);
            const float rr = 1.0f / sqrtf(ss * (1.0f / 128.0f) + EPS);
#pragma unroll
            for (int q = 0; q < 4; ++q) { const unsigned gg[4] = {gv[q].x, gv[q].y, gv[q].z, gv[q].w};
                const f32x4 w0 = *(const f32x4*)(A->hg_norm_w + l * 512 + cbase + 8 * q), w1 = *(const f32x4*)(A->hg_norm_w + l * 512 + cbase + 8 * q + 4);
                const float ww[8] = {w0.x, w0.y, w0.z, w0.w, w1.x, w1.y, w1.z, w1.w};
                unsigned pk[4];
#pragma unroll
                for (int e = 0; e < 4; ++e) pk[e] = pkbf(o[8 * q + 2 * e] * rr * ww[2 * e] * bflo(gg[e]), o[8 * q + 2 * e + 1] * rr * ww[2 * e + 1] * bfhi(gg[e]));
                *(u32x4*)(MG + (size_t)m * DM + cbase + 8 * q) = (u32x4){pk[0], pk[1], pk[2], pk[3]}; }
        }
        BAR_LDS();
        {
            float y[32]; float ss = 0.f;
#pragma unroll
            for (int q = 0; q < 4; ++q) { const u32x4 v = *(const LAS u32x4*)(lds + j * RS + 2 * (cbase + 8 * q)); const unsigned vv[4] = {v.x, v.y, v.z, v.w};
#pragma unroll
                for (int e = 0; e < 4; ++e) { const float a0 = bflo(vv[e]), a1 = bfhi(vv[e]); y[8 * q + 2 * e] = a0; y[8 * q + 2 * e + 1] = a1; ss += a0 * a0 + a1 * a1; } }
            ss += __shfl_xor(ss, 1); ss += __shfl_xor(ss, 2); ss += __shfl_xor(ss, 4); ss += __shfl_xor(ss, 8);
            const float rr = 1.0f / sqrtf(ss * (1.0f / 512.0f) + EPS);
#pragma unroll
            for (int q = 0; q < 4; ++q) { const f32x4 w0 = *(const f32x4*)(A->hy_norm_w + l * 512 + cbase + 8 * q), w1 = *(const f32x4*)(A->hy_norm_w + l * 512 + cbase + 8 * q + 4);
                const float ww[8] = {w0.x, w0.y, w0.z, w0.w, w1.x, w1.y, w1.z, w1.w};
                unsigned pk[4];
#pragma unroll
                for (int e = 0; e < 4; ++e) pk[e] = pkbf(y[8 * q + 2 * e] * rr * ww[2 * e], y[8 * q + 2 * e + 1] * rr * ww[2 * e + 1]);
                *(u32x4*)(MG + (size_t)m * DM + 512 + cbase + 8 * q) = (u32x4){pk[0], pk[1], pk[2], pk[3]}; }
        }
        BAR_LDS();
    }
}

__global__ void __launch_bounds__(512, 2) mk_fwd(Args KP) {
    extern __shared__ __attribute__((aligned(16))) unsigned char lds_raw[];
    lds_t* lds = (lds_t*)lds_raw;
    const int tid = threadIdx.x;
    volatile LAS unsigned* MISC = (volatile LAS unsigned*)(lds + MISC_OFF);
    if (tid < 64) MISC[tid] = 0u;
    __syncthreads();
    if (MK_N_LAUNCHES == 1) (void)xcd_barrier_post((unsigned*)(KP.ws + WS_CTL) + CW_BAR, MISC + 8);
    const int lo = KP.ph_lo, hi = KP.ph_hi;
    if (PROBE_PH == 0 && threadIdx.x == 0) *(volatile LAS unsigned long long*)(lds + MISC_OFF + 128) = __builtin_amdgcn_s_memrealtime();
#define IN(k) (lo <= (k) && (k) < hi)
#define SEAM(k) do { PSTAMP(k); } while (0)
#define SEAM_(k) do { if (IN(k) && IN((k) + 1)) { KArgs A_ = kargs(); XcdBarrier b_; b_.bar = (unsigned*)(A_->ws + WS_CTL) + CW_BAR; b_.x = xb_xcc_id(); b_.st = (volatile LAS unsigned*)(lds + MISC_OFF) + 8; xcd_barrier(b_); } } while (0)
#define PSTAMP(k) do { SEAM_(k); if (PROBE_PH == (k) + 1 && threadIdx.x == 0) *(volatile LAS unsigned long long*)(lds + MISC_OFF + 128) = __builtin_amdgcn_s_memrealtime(); if (PROBE_PH == (k) && threadIdx.x == 0) *(volatile LAS unsigned long long*)(lds + MISC_OFF + 136) = __builtin_amdgcn_s_memrealtime(); } while (0)
#define MODP(A) ((const float*)((A)->ws + WS_CTL) + CW_MOD)
#define HP(A) ((bf16_t*)((A)->ws + WS_H))

    if (IN(0)) { KArgs A = kargs(); phase_p0a(A, lds); } SEAM(0);
    if (IN(1)) { KArgs A = kargs(); phase_p0b(A, lds); } SEAM(1);
#define LAYER_BODY(l) do { \
        const int pb = 2 + 6 * l; \
        if (IN(pb + 0)) { \
            KArgs A = kargs(); \
            pg8::Gemm g{HP(A), (const bf16_t*)(A->ws + WS_WIN) + (size_t)l * NIN * DM, TT, NIN, DM}; pg8::StaticOrder S; S.init(TT, NIN, gridDim.x, blockIdx.x); \
            pg8::EpiProj E{(bf16_t*)(A->ws + WS_P), (const float*)(A->ws + WS_LBT) + l * 1024, (const float*)(A->ws + WS_RSP), (const float*)(A->ws + WS_BIAS) + (size_t)l * 9 * NIN, (LAS float*)(lds + XCH_OFF + 8192), \
                            A->hy_conv_w + (size_t)l * 3 * 1536, (bf16_t*)(A->ws + WS_UT), (bf16_t*)(A->ws + WS_X2T), (LAS float*)(lds + XCH_OFF)}; \
            pg8::gemm_phase<pg8::EpiProj, pg8::StaticOrder, true, true>(lds, g, S, E); \
        } SEAM(pb + 0); \
        if (IN(pb + 1)) { KArgs A = kargs(); phase_mixer(A, l, lds); } SEAM(pb + 1); \
        if (IN(pb + 2)) { KArgs A = kargs(); phase_merge(A, l, lds); } SEAM(pb + 2); \
        if (IN(pb + 3)) { \
            KArgs A = kargs(); bf16_t* XB = (bf16_t*)(A->ws + WS_XB); \
            pg8::Gemm g{(const bf16_t*)(A->ws + WS_MERGED), (const bf16_t*)(A->ws + WS_WOUT) + (size_t)l * DM * DM, TT, DM, DM}; pg8::StaticOrder S; S.init(TT, DM, gridDim.x, blockIdx.x, 192); \
            if (l == 0) { pg8::EpiResid<false, true, 3> E{A->x_prompt, A->x_sample, nullptr, nullptr, XB, MODP(A) + 2048, \
                            HP(A), A->norm2_w, MODP(A) + 4096, (float*)(A->ws + WS_RSP), (LAS float*)(lds + XCH_OFF)}; \
                pg8::gemm_phase<pg8::EpiResid<false, true, 3>, pg8::StaticOrder, true, true, 3>(lds, g, S, E); } \
            else { pg8::EpiResid<true, true, 3> E{nullptr, nullptr, XB, nullptr, XB, MODP(A) + (size_t)9 * NMOD + 2048, \
                            HP(A), A->norm2_w + DM, MODP(A) + (size_t)9 * NMOD + 4096, (float*)(A->ws + WS_RSP), (LAS float*)(lds + XCH_OFF)}; \
                pg8::gemm_phase<pg8::EpiResid<true, true, 3>, pg8::StaticOrder, true, true, 3>(lds, g, S, E); } \
        } SEAM(pb + 3); \
        if (IN(pb + 4)) { \
            KArgs A = kargs(); \
            pg8::Gemm g{HP(A), (const bf16_t*)(A->ws + WS_WUP) + (size_t)l * NUP * DM, TT, NUP, DM}; pg8::StaticOrder S; S.init(TT, NUP, gridDim.x, blockIdx.x); \
            pg8::EpiFfn E{(bf16_t*)(A->ws + WS_P), A->ffn_conv_w + (size_t)l * 3 * NUP, (LAS float*)(lds + XCH_OFF), (const float*)(A->ws + WS_RSP), (const float*)(A->ws + WS_BIAS + BIAS2_OFF) + (size_t)l * 9 * NUP, (LAS float*)(lds + XCH_OFF + 8192)}; \
            pg8::gemm_phase<pg8::EpiFfn, pg8::StaticOrder, true, true>(lds, g, S, E); \
        } SEAM(pb + 4); \
        if (IN(pb + 5)) { \
            KArgs A = kargs(); bf16_t* XB = (bf16_t*)(A->ws + WS_XB); \
            pg8::Gemm g{(const bf16_t*)(A->ws + WS_P), (const bf16_t*)(A->ws + WS_WDN) + (size_t)l * DM * DFF, TT, DM, DFF}; pg8::StaticOrder S; S.init(TT, DM, gridDim.x, blockIdx.x, 192); \
            if (l == 0) { pg8::EpiResid<true, true, 3> E{nullptr, nullptr, XB, nullptr, XB, MODP(A) + 5120, \
                            HP(A), A->norm1_w + DM, MODP(A) + (size_t)9 * NMOD + 1024, (float*)(A->ws + WS_RSP), (LAS float*)(lds + XCH_OFF)}; \
                pg8::gemm_phase<pg8::EpiResid<true, true, 3>, pg8::StaticOrder, true, true, 3>(lds, g, S, E); } \
            else { pg8::EpiResid<true, false, 3> E{nullptr, nullptr, XB, A->out, nullptr, MODP(A) + (size_t)9 * NMOD + 5120, \
                            nullptr, nullptr, nullptr, nullptr, (LAS float*)(lds + XCH_OFF)}; \
                pg8::gemm_phase<pg8::EpiResid<true, false, 3>, pg8::StaticOrder, true, true, 3>(lds, g, S, E); } \
        } SEAM(pb + 5); \
    } while (0)
    LAYER_BODY(0);
    LAYER_BODY(1);
#undef LAYER_BODY
    if (IN(14)) { KArgs A = kargs(); phase_final_norm(A); }
    if (PROBE_PH >= 0) { if (PROBE_PH == NPH - 1 && threadIdx.x == 0) *(volatile LAS unsigned long long*)(lds + MISC_OFF + 136) = __builtin_amdgcn_s_memrealtime();
        if ((PROBE_PH >= 110 ? *(volatile LAS unsigned*)(lds + MISC_OFF + 160) != 0u : blockIdx.x == 0) && threadIdx.x == 0) { const unsigned long long pt0 = *(volatile LAS unsigned long long*)(lds + MISC_OFF + 128), pt1 = *(volatile LAS unsigned long long*)(lds + MISC_OFF + 136); const unsigned long long t_end = __builtin_amdgcn_s_memrealtime(), w = 8ull * (pt1 - pt0); while (__builtin_amdgcn_s_memrealtime() - t_end < w) __builtin_amdgcn_s_sleep(32); } }
#undef IN
#undef SEAM
}

extern "C" void kernel_launch(void* const* d_in, const int* in_sizes, int n_in, void* d_out, int out_size, void* d_ws, size_t ws_size, hipStream_t stream) {
    static int grid = 0;
    if (grid == 0) {
        if (n_in != 28 || ws_size < WS_END) { fprintf(stderr, "kernel_launch: unexpected inputs (n_in %d, ws %zu)\n", n_in, ws_size); grid = -1; return; }
        int dev = 0, cus = 0;
        if (hipGetDevice(&dev) != hipSuccess || hipDeviceGetAttribute(&cus, hipDeviceAttributeMultiprocessorCount, dev) != hipSuccess) { grid = -1; return; }
        if (hipFuncSetAttribute((const void*)mk_fwd, hipFuncAttributeMaxDynamicSharedMemorySize, LDS_BYTES) != hipSuccess) { fprintf(stderr, "kernel_launch: hipFuncSetAttribute failed\n"); grid = -1; return; }
        int per_cu = 0;
        if (hipOccupancyMaxActiveBlocksPerMultiprocessor(&per_cu, (const void*)mk_fwd, 512, LDS_BYTES) != hipSuccess || per_cu < 1) fprintf(stderr, "kernel_launch: occupancy query reports %d\n", per_cu);
        (void)hipGetLastError();
        grid = cus;
    }
    if (grid < 0) return;
    (void)hipMemsetAsync((char*)d_ws + WS_CTL, 0, CTL_BYTES, stream);
    Args a{};
    const float** ap = (const float**)&a;
    for (int i = 0; i < 28; ++i) ap[i] = (const float*)d_in[i];
    a.out = (float*)d_out; a.ws = (unsigned char*)d_ws;
    if (MK_N_LAUNCHES == 1) { a.ph_lo = 0; a.ph_hi = NPH; hipLaunchKernelGGL(mk_fwd, dim3(grid), dim3(512), LDS_BYTES, stream, a); }
    else { for (int p = 0; p < NPH; ++p) { a.ph_lo = p; a.ph_hi = p + 1; hipLaunchKernelGGL(mk_fwd, dim3(grid), dim3(512), LDS_BYTES, stream, a); } }
}
```
